# Optimizing an MI355X kernel written in HIP

```python
import jax, jax.numpy as jnp
from jax import lax
import numpy as np

D_MODEL = 1024
BATCH = 8
SEQ = 4096
DEPTH = 1
DEC_BATCH = 16
DEC_SEQ = 16
PAST_LEN = 2048

CHUNK = 64
N_MEM = 256
FOX_HEAD_DIM = 64
FOX_HEADS = D_MODEL // 128
FOX_WIDTH = FOX_HEADS * FOX_HEAD_DIM
POOL_WINDOWS = (2, 4, 8, 16)
POOL_GROUPS = 4
POOL_WIDTH = D_MODEL // 2
POOL_GROUP_DIM = POOL_WIDTH // POOL_GROUPS
POOL_HIST = 15
MEM_HEADS = 4
MEM_WIDTH = D_MODEL // 2
MEM_HEAD_DIM = MEM_WIDTH // MEM_HEADS
N_BRANCH = 3
D_FF = 4 * D_MODEL
Q_BLOCK = 128
EPS = 1e-6
FORGET_BIAS = 2.0
SPLIT_SIZES = (FOX_WIDTH, FOX_WIDTH, FOX_WIDTH, FOX_HEADS, POOL_WIDTH, MEM_WIDTH, N_BRANCH * D_MODEL)
IN_DIM = 3 * FOX_WIDTH + FOX_HEADS + POOL_WIDTH + MEM_WIDTH + N_BRANCH * D_MODEL

kernel_name = 'fox_pool_memory_hybrid_stream_step'


def _rmsnorm(x, g):
    xf = x.astype(jnp.float32)
    y = xf * lax.rsqrt(jnp.mean(xf * xf, axis=-1, keepdims=True) + EPS)
    return (y * g.astype(jnp.float32)).astype(x.dtype)


def _split_points():
    return np.cumsum(SPLIT_SIZES)[:-1].tolist()


def _in_proj(x, g, w_in, b_f):
    B, T, _ = x.shape
    z = _rmsnorm(x, g) @ w_in
    q, k, v, f, u, qm, gates = jnp.split(z, _split_points(), axis=-1)
    logf = jax.nn.log_sigmoid((f + b_f).astype(jnp.float32))
    q = q.reshape(B, T, FOX_HEADS, FOX_HEAD_DIM)
    k = k.reshape(B, T, FOX_HEADS, FOX_HEAD_DIM)
    v = v.reshape(B, T, FOX_HEADS, FOX_HEAD_DIM)
    qm = qm.reshape(B, T, MEM_HEADS, MEM_HEAD_DIM)
    return q, k, v, logf, u, qm, gates


def _fox_attend(q, k, v, cq, ck, qpos, kpos):
    scale = FOX_HEAD_DIM ** -0.5
    s = jnp.einsum('bqhd,bkhd->bhqk', q.astype(jnp.float32), k.astype(jnp.float32)) * scale
    s = s + jnp.transpose(cq, (0, 2, 1))[:, :, :, None] - jnp.transpose(ck, (0, 2, 1))[:, :, None, :]
    s = jnp.where(kpos[None, :] <= qpos[:, None], s, -jnp.inf)
    p = jax.nn.softmax(s, axis=-1)
    o = jnp.einsum('bhqk,bkhd->bqhd', p, v.astype(jnp.float32))
    return o.astype(q.dtype)


def _fox_prompt(q, k, v, logf):
    B, S, H, Dh = q.shape
    c = jnp.cumsum(logf, axis=1)
    kpos = jnp.arange(S)

    def block(i):
        start = i * Q_BLOCK
        qb = lax.dynamic_slice_in_dim(q, start, Q_BLOCK, axis=1)
        cqb = lax.dynamic_slice_in_dim(c, start, Q_BLOCK, axis=1)
        qpos = start + jnp.arange(Q_BLOCK)
        return _fox_attend(qb, k, v, cqb, c, qpos, kpos)

    out = lax.map(block, jnp.arange(S // Q_BLOCK))
    return jnp.transpose(out, (1, 0, 2, 3, 4)).reshape(B, S, H, Dh)


def _pool_mix(u_ext, pos0, w_pool, s_pool):
    B, L, _ = u_ext.shape
    T = L - POOL_HIST
    uf = u_ext.astype(jnp.float32).reshape(B, L, POOL_GROUPS, POOL_GROUP_DIM)
    cs = jnp.concatenate([jnp.zeros((B, 1, POOL_GROUPS, POOL_GROUP_DIM), jnp.float32),
                          jnp.cumsum(uf, axis=1)], axis=1)
    end = cs[:, POOL_HIST + 1:]
    pos = pos0 + jnp.arange(T)
    means = []
    for g, w in enumerate(POOL_WINDOWS):
        start = cs[:, POOL_HIST + 1 - w: POOL_HIST + 1 - w + T, g]
        cnt = jnp.minimum(w, pos + 1).astype(jnp.float32)
        means.append((end[:, :, g] - start) / cnt[None, :, None])
    pooled = jnp.stack(means, axis=2) - uf[:, POOL_HIST:]
    mixed = jnp.einsum('btgc,gcd->btgd', pooled, w_pool.astype(jnp.float32))
    mixed = mixed * s_pool.astype(jnp.float32).reshape(POOL_GROUPS, POOL_GROUP_DIM)
    return mixed.reshape(B, T, POOL_WIDTH).astype(u_ext.dtype)


def _mem_kv(mem, g, w_mkv):
    B, M, _ = mem.shape
    kv = _rmsnorm(mem, g) @ w_mkv
    mk, mv = jnp.split(kv, 2, axis=-1)
    return (mk.reshape(B, M, MEM_HEADS, MEM_HEAD_DIM), mv.reshape(B, M, MEM_HEADS, MEM_HEAD_DIM))


def _mem_attend(qm, mk, mv):
    scale = MEM_HEAD_DIM ** -0.5
    s = jnp.einsum('bqhd,bmhd->bhqm', qm.astype(jnp.float32), mk.astype(jnp.float32)) * scale
    p = jax.nn.softmax(s, axis=-1)
    return jnp.einsum('bhqm,bmhd->bqhd', p, mv.astype(jnp.float32)).astype(qm.dtype)


def _merge(x, o_fox, o_pool, o_mem, gates, w_br_fox, w_br_pool, w_br_mem, w_out):
    B, T, _ = x.shape
    g = jax.nn.sigmoid(gates.astype(jnp.float32)).astype(x.dtype).reshape(B, T, N_BRANCH, D_MODEL)
    m = (g[:, :, 0] * (o_fox.reshape(B, T, FOX_WIDTH) @ w_br_fox)
         + g[:, :, 1] * (o_pool @ w_br_pool)
         + g[:, :, 2] * (o_mem.reshape(B, T, MEM_WIDTH) @ w_br_mem))
    return x + m @ w_out


def _ffn(h, g, w_up, w_down):
    a = jax.nn.relu(_rmsnorm(h, g) @ w_up)
    return h + (a * a) @ w_down


def setup_inputs(seed: int = 0) -> dict:
    key = jax.random.key(seed)
    ks = jax.random.split(key, 24)

    def nrm(k, shape, scale=1.0):
        return scale * jax.random.normal(k, shape, jnp.float32)

    D = D_MODEL
    return {
        'x_prompt': nrm(ks[0], (BATCH, SEQ, D)),
        'x_sample': nrm(ks[1], (DEC_BATCH, DEC_SEQ, D)),
        'mem_prompt': nrm(ks[2], (BATCH, N_MEM, D)),
        'cache_fox_k': nrm(ks[3], (DEPTH, DEC_BATCH, PAST_LEN, FOX_HEADS, FOX_HEAD_DIM)),
        'cache_fox_v': nrm(ks[4], (DEPTH, DEC_BATCH, PAST_LEN, FOX_HEADS, FOX_HEAD_DIM)),
        'cache_fox_logf': jax.nn.log_sigmoid(FORGET_BIAS + nrm(ks[5], (DEPTH, DEC_BATCH, PAST_LEN, FOX_HEADS), 0.5)),
        'cache_pool': nrm(ks[6], (DEPTH, DEC_BATCH, POOL_HIST, POOL_WIDTH)),
        'cache_mem_k': nrm(ks[7], (DEPTH, DEC_BATCH, N_MEM, MEM_HEADS, MEM_HEAD_DIM)),
        'cache_mem_v': nrm(ks[8], (DEPTH, DEC_BATCH, N_MEM, MEM_HEADS, MEM_HEAD_DIM)),
        'g_attn': 1.0 + nrm(ks[9], (DEPTH, D), 0.1),
        'w_in': nrm(ks[10], (DEPTH, D, IN_DIM), D ** -0.5),
        'b_f': FORGET_BIAS + nrm(ks[11], (DEPTH, FOX_HEADS), 0.1),
        'w_pool': nrm(ks[12], (DEPTH, POOL_GROUPS, POOL_GROUP_DIM, POOL_GROUP_DIM), POOL_GROUP_DIM ** -0.5),
        's_pool': 1.0 + nrm(ks[13], (DEPTH, POOL_WIDTH), 0.1),
        'g_mem': 1.0 + nrm(ks[14], (DEPTH, D), 0.1),
        'w_mkv': nrm(ks[15], (DEPTH, D, 2 * MEM_WIDTH), D ** -0.5),
        'w_br_fox': nrm(ks[16], (DEPTH, FOX_WIDTH, D), FOX_WIDTH ** -0.5),
        'w_br_pool': nrm(ks[17], (DEPTH, POOL_WIDTH, D), POOL_WIDTH ** -0.5),
        'w_br_mem': nrm(ks[18], (DEPTH, MEM_WIDTH, D), MEM_WIDTH ** -0.5),
        'w_out': nrm(ks[19], (DEPTH, D, D), D ** -0.5),
        'g_mlp': 1.0 + nrm(ks[20], (DEPTH, D), 0.1),
        'w_up': nrm(ks[21], (DEPTH, D, D_FF), D ** -0.5),
        'w_down': nrm(ks[22], (DEPTH, D_FF, D), D_FF ** -0.5),
        'g_final': 1.0 + nrm(ks[23], (D,), 0.1),
    }


def reference(x_prompt, x_sample, mem_prompt, cache_fox_k, cache_fox_v, cache_fox_logf, cache_pool,
              cache_mem_k, cache_mem_v, g_attn, w_in, b_f, w_pool, s_pool, g_mem, w_mkv,
              w_br_fox, w_br_pool, w_br_mem, w_out, g_mlp, w_up, w_down, g_final):
    xp, xs = x_prompt, x_sample
    B = xp.shape[0]
    T = xs.shape[1]
    P = cache_fox_k.shape[2]
    fk_p, fv_p, fl_p, pl_p, mk_p, mv_p = [], [], [], [], [], []
    fk_s, fv_s, fl_s, pl_s = [], [], [], []
    for l in range(DEPTH):
        q, k, v, logf, u, qm, gates = _in_proj(xp, g_attn[l], w_in[l], b_f[l])
        o_fox = _fox_prompt(q, k, v, logf)
        u_ext = jnp.concatenate([jnp.zeros((B, POOL_HIST, POOL_WIDTH), u.dtype), u], axis=1)
        o_pool = _pool_mix(u_ext, 0, w_pool[l], s_pool[l])
        mk, mv = _mem_kv(mem_prompt, g_mem[l], w_mkv[l])
        o_mem = _mem_attend(qm, mk, mv)
        h = _merge(xp, o_fox, o_pool, o_mem, gates, w_br_fox[l], w_br_pool[l], w_br_mem[l], w_out[l])
        xp = _ffn(h, g_mlp[l], w_up[l], w_down[l])
        fk_p.append(k); fv_p.append(v); fl_p.append(logf)
        pl_p.append(u_ext[:, -POOL_HIST:]); mk_p.append(mk); mv_p.append(mv)

        q, k, v, logf, u, qm, gates = _in_proj(xs, g_attn[l], w_in[l], b_f[l])
        k_all = jnp.concatenate([cache_fox_k[l].astype(k.dtype), k], axis=1)
        v_all = jnp.concatenate([cache_fox_v[l].astype(v.dtype), v], axis=1)
        logf_all = jnp.concatenate([cache_fox_logf[l].astype(jnp.float32), logf], axis=1)
        c_all = jnp.cumsum(logf_all, axis=1)
        o_fox = _fox_attend(q, k_all, v_all, c_all[:, P:], c_all, P + jnp.arange(T), jnp.arange(P + T))
        u_ext = jnp.concatenate([cache_pool[l].astype(u.dtype), u], axis=1)
        o_pool = _pool_mix(u_ext, P, w_pool[l], s_pool[l])
        o_mem = _mem_attend(qm, cache_mem_k[l], cache_mem_v[l])
        h = _merge(xs, o_fox, o_pool, o_mem, gates, w_br_fox[l], w_br_pool[l], w_br_mem[l], w_out[l])
        xs = _ffn(h, g_mlp[l], w_up[l], w_down[l])
        fk_s.append(k); fv_s.append(v); fl_s.append(logf); pl_s.append(u_ext[:, -POOL_HIST:])

    y_prompt = _rmsnorm(xp, g_final)
    y_sample = _rmsnorm(xs, g_final)
    new_fox_k_p = jnp.stack(fk_p)
    new_fox_v_p = jnp.stack(fv_p)
    new_fox_logf_p = jnp.stack(fl_p)
    new_pool_p = jnp.stack(pl_p)
    new_mem_k_p = jnp.stack(mk_p)
    new_mem_v_p = jnp.stack(mv_p)
    new_fox_k_s = jnp.stack(fk_s)
    new_fox_v_s = jnp.stack(fv_s)
    new_fox_logf_s = jnp.stack(fl_s)
    new_pool_s = jnp.stack(pl_s)
    return (y_prompt, y_sample, new_fox_k_p, new_fox_v_p, new_fox_logf_p, new_pool_p, new_mem_k_p, new_mem_v_p,
            new_fox_k_s, new_fox_v_s, new_fox_logf_s, new_pool_s)
```

```cpp
#include <hip/hip_runtime.h>
#include <hip/hip_bf16.h>
#include <cstdio>
#include <cstdint>
#include <cmath>
namespace pg8 {
#define PG8_LAS __attribute__((address_space(3)))
typedef unsigned short bf16_t;
typedef short bf16x8 __attribute__((ext_vector_type(8)));
typedef float f32x4 __attribute__((ext_vector_type(4)));
typedef unsigned u32x4 __attribute__((ext_vector_type(4)));
constexpr int BM = 256, BK = 64, HALF = 128, HTB = HALF * BK * 2  , STAGE_BYTES = 8 * HTB, NXCD = 8, WGM = 8;

__host__ __device__ __forceinline__ int lds_byte(int r, int c) { const int st = (r >> 4) * 2 + (c >> 5), rr = r & 15, cc = c & 31, ob = rr * 64 + cc * 2; return st * 1024 + (ob ^ (((ob >> 9) & 1) << 5)); }
__host__ __device__ __forceinline__ void stage_rc(int b, int& R, int& C) { const int st = b / 1024, sb = b % 1024, swz = sb ^ (((sb >> 9) & 1) << 5); R = (st >> 1) * 16 + swz / 64; C = (st & 1) * 32 + (swz % 64) / 2; }
__host__ __device__ __forceinline__ int perm32(int rho) { const int n = rho >> 4, i = rho & 15; return 8 * (i >> 2) + 4 * n + (i & 3); }

struct Unit { int pm, pn; };
struct Gemm { const bf16_t* A; const bf16_t* Bt; int M, N, K; };

struct StaticOrder {
    int nM, nN, nwg, G, c;
    __host__ __device__ void init(int M, int N, int G_, int c_) { nM = M / BM; nN = N / BM; nwg = nM * nN; G = G_; c = c_; }
    __host__ __device__ bool next(int i, Unit& u) const {
        const long L = (long)i * G + c; if (L >= nwg) return false;
        int wgid = (int)L; { const int q = nwg / NXCD, r = nwg % NXCD, xcd = wgid % NXCD, off = wgid / NXCD; wgid = (xcd < r ? xcd * (q + 1) : r * (q + 1) + (xcd - r) * q) + off; }
        const int nig = WGM * nN, gid = wgid / nig, fm = gid * WGM, gsz = (nM - fm) < WGM ? (nM - fm) : WGM;
        u.pm = fm + ((wgid % nig) % gsz); u.pn = (wgid % nig) / gsz; return true;
    }
    __device__ __forceinline__ void a_ready(const Unit&) const {}
    __device__ __forceinline__ void done(const Unit&) const {}
};

typedef float f32x2_t __attribute__((ext_vector_type(2))); typedef __bf16 bf16x2_t __attribute__((ext_vector_type(2)));
__device__ __forceinline__ unsigned cvt_pk_bf16(float lo, float hi) { f32x2_t v = {lo, hi}; bf16x2_t b = __builtin_convertvector(v, bf16x2_t); return __builtin_bit_cast(unsigned, b); }
__device__ __forceinline__ u32x4 pack8(const f32x4 v0, const f32x4 v1) { u32x4 w; w.x = cvt_pk_bf16(v0[0], v0[1]); w.y = cvt_pk_bf16(v0[2], v0[3]); w.z = cvt_pk_bf16(v1[0], v1[1]); w.w = cvt_pk_bf16(v1[2], v1[3]); return w; }
__device__ __forceinline__ float bflo(unsigned w) { return __uint_as_float(w << 16); }
__device__ __forceinline__ float bfhi(unsigned w) { return __uint_as_float(w & 0xffff0000u); }
__device__ __forceinline__ float sigmoid_f(float x) { return __builtin_amdgcn_rcpf(1.0f + __builtin_amdgcn_exp2f(-1.4426950408889634f * x)); }

constexpr int TOK_P = 32768, TOK = 33024;
constexpr size_t O_YP = 0, O_YS = 33554432, O_KP = 33816576, O_VP = 50593792, O_LFP = 67371008, O_PLP = 67633152, O_MKP = 67694592, O_MVP = 68743168,
                 O_KS = 69791744, O_VS = 69922816, O_LFS = 70053888, O_PLS = 70055936, O_END = 70178816;
constexpr float C2F = 0.125f * 1.4426950408889634f;

struct EpiInProj {
    static constexpr bool PERM = true, AFTER_DRAIN = false, HAS_HOOK = false; static constexpr int HOOK_T0 = -1, HOOK_T1 = -1;
    bf16_t *Q, *K, *V, *U, *QM, *G; float* out;
    __device__ __forceinline__ void hook(f32x4 (&)[2][2][4][2], const Unit&, int, int, int, int, int) const {}
    __device__ __forceinline__ void operator()(const f32x4 (&acc)[2][2][4][2], const Unit& u, int wr, int wc, int fr, int fq) const {
        const int pn = u.pn, row0 = u.pm * BM + wr * 64 + fr; const bool samp = u.pm >= TOK_P / BM;
        const int ct = wc * 32 + 8 * fq;
        if (pn >= 10) {
            const int cb = (pn - 10) * 256 + ct;
#pragma unroll
            for (int ai = 0; ai < 2; ++ai)
#pragma unroll
                for (int m = 0; m < 4; ++m) { bf16_t* rowp = G + (size_t)(row0 + ai * HALF + m * 16) * 3072 + cb;
#pragma unroll
                    for (int bj = 0; bj < 2; ++bj) { f32x4 v0 = acc[ai][bj][m][0], v1 = acc[ai][bj][m][1];
#pragma unroll
                        for (int j = 0; j < 4; ++j) { v0[j] = sigmoid_f(v0[j]); v1[j] = sigmoid_f(v1[j]); }
                        *(u32x4*)(rowp + bj * HALF) = pack8(v0, v1); } }
            return;
        }
        const int seg = pn >> 1, cb = (pn & 1) * 256 + ct;
        bf16_t* dst = seg == 0 ? Q : seg == 1 ? K : seg == 2 ? V : seg == 3 ? U : QM;
        const float sc = seg == 0 ? C2F : 1.0f;
        float* fo = nullptr;
        if (seg == 1) fo = out + (samp ? O_KS : O_KP); else if (seg == 2) fo = out + (samp ? O_VS : O_VP);
#pragma unroll
        for (int ai = 0; ai < 2; ++ai)
#pragma unroll
            for (int m = 0; m < 4; ++m) { const int row = row0 + ai * HALF + m * 16; bf16_t* rowp = dst + (size_t)row * 512 + cb;
                const int rowo = samp ? row - TOK_P : row;
                float* pool = nullptr;
                if (seg == 3) { if (!samp) { const int t = row & 4095, b = row >> 12; if (t >= 4096 - 15) pool = out + O_PLP + (size_t)(b * 15 + t - (4096 - 15)) * 512 + cb; }
                                else { const int t = rowo & 15, b = rowo >> 4; if (t >= 1) pool = out + O_PLS + (size_t)(b * 15 + t - 1) * 512 + cb; } }
#pragma unroll
                for (int bj = 0; bj < 2; ++bj) { const f32x4 v0 = acc[ai][bj][m][0], v1 = acc[ai][bj][m][1];
                    *(u32x4*)(rowp + bj * HALF) = pack8(v0 * sc, v1 * sc);
                    if (fo) { float* p = fo + (size_t)rowo * 512 + cb + bj * HALF; *(f32x4*)p = v0; *(f32x4*)(p + 4) = v1; }
                    if (pool) { float* p = pool + bj * HALF; *(f32x4*)p = v0; *(f32x4*)(p + 4) = v1; } } }
    }
};
struct EpiMemKV {
    static constexpr bool PERM = true, AFTER_DRAIN = false, HAS_HOOK = false; static constexpr int HOOK_T0 = -1, HOOK_T1 = -1;
    bf16_t *MK, *MV; float* out;
    __device__ __forceinline__ void hook(f32x4 (&)[2][2][4][2], const Unit&, int, int, int, int, int) const {}
    __device__ __forceinline__ void operator()(const f32x4 (&acc)[2][2][4][2], const Unit& u, int wr, int wc, int fr, int fq) const {
        const int pn = u.pn, row0 = u.pm * BM + wr * 64 + fr, cb = (pn & 1) * 256 + wc * 32 + 8 * fq;
        bf16_t* dst = pn < 2 ? MK : MV; float* fo = out + (pn < 2 ? O_MKP : O_MVP);
#pragma unroll
        for (int ai = 0; ai < 2; ++ai)
#pragma unroll
            for (int m = 0; m < 4; ++m) { const int row = row0 + ai * HALF + m * 16;
#pragma unroll
                for (int bj = 0; bj < 2; ++bj) { const f32x4 v0 = acc[ai][bj][m][0], v1 = acc[ai][bj][m][1];
                    *(u32x4*)(dst + (size_t)row * 512 + cb + bj * HALF) = pack8(v0, v1);
                    float* p = fo + (size_t)row * 512 + cb + bj * HALF; *(f32x4*)p = v0; *(f32x4*)(p + 4) = v1; } }
    }
};
struct EpiMerge {
    static constexpr bool PERM = true, AFTER_DRAIN = false, HAS_HOOK = true; static constexpr int HOOK_T0 = 8, HOOK_T1 = 16;
    const bf16_t* G; bf16_t* MM;
    __device__ __forceinline__ void hook(f32x4 (&acc)[2][2][4][2], const Unit& u, int t, int wr, int wc, int fr, int fq) const {
        int fr_ = fr, fq_ = fq; asm volatile("" : "+v"(fr_), "+v"(fq_));
        const int seg = t >> 3, row0 = u.pm * BM + wr * 64 + fr_, cb = u.pn * BM + wc * 32 + 8 * fq_;
#pragma unroll
        for (int ai = 0; ai < 2; ++ai)
#pragma unroll
            for (int m = 0; m < 4; ++m) { const bf16_t* rowp = G + (size_t)(row0 + ai * HALF + m * 16) * 3072 + (seg - 1) * 1024 + cb;
#pragma unroll
                for (int bj = 0; bj < 2; ++bj) { const u32x4 gp = *(const u32x4*)(rowp + bj * HALF), gn = *(const u32x4*)(rowp + 1024 + bj * HALF);
                    f32x4 r0, r1;
                    r0[0] = bflo(gp.x) * __builtin_amdgcn_rcpf(bflo(gn.x)); r0[1] = bfhi(gp.x) * __builtin_amdgcn_rcpf(bfhi(gn.x));
                    r0[2] = bflo(gp.y) * __builtin_amdgcn_rcpf(bflo(gn.y)); r0[3] = bfhi(gp.y) * __builtin_amdgcn_rcpf(bfhi(gn.y));
                    r1[0] = bflo(gp.z) * __builtin_amdgcn_rcpf(bflo(gn.z)); r1[1] = bfhi(gp.z) * __builtin_amdgcn_rcpf(bfhi(gn.z));
                    r1[2] = bflo(gp.w) * __builtin_amdgcn_rcpf(bflo(gn.w)); r1[3] = bfhi(gp.w) * __builtin_amdgcn_rcpf(bfhi(gn.w));
                    acc[ai][bj][m][0] *= r0; acc[ai][bj][m][1] *= r1; }
                asm volatile("" : "+v"(acc[ai][0][m][0]), "+v"(acc[ai][0][m][1]), "+v"(acc[ai][1][m][0]), "+v"(acc[ai][1][m][1])); asm volatile("" ::: "memory"); }
    }
    __device__ __forceinline__ void operator()(const f32x4 (&acc)[2][2][4][2], const Unit& u, int wr, int wc, int fr, int fq) const {
        const int row0 = u.pm * BM + wr * 64 + fr, cb = u.pn * BM + wc * 32 + 8 * fq;
#pragma unroll
        for (int ai = 0; ai < 2; ++ai)
#pragma unroll
            for (int m = 0; m < 4; ++m) { const size_t row = (size_t)(row0 + ai * HALF + m * 16);
#pragma unroll
                for (int bj = 0; bj < 2; ++bj) { const u32x4 g = *(const u32x4*)(G + row * 3072 + 2048 + cb + bj * HALF);
                    f32x4 v0 = acc[ai][bj][m][0], v1 = acc[ai][bj][m][1];
                    v0[0] *= bflo(g.x); v0[1] *= bfhi(g.x); v0[2] *= bflo(g.y); v0[3] *= bfhi(g.y); v1[0] *= bflo(g.z); v1[1] *= bfhi(g.z); v1[2] *= bflo(g.w); v1[3] *= bfhi(g.w);
                    *(u32x4*)(MM + row * 1024 + cb + bj * HALF) = pack8(v0, v1); }
                asm volatile("" ::: "memory"); }
    }
};
struct EpiWout {
    static constexpr bool PERM = true, AFTER_DRAIN = false, HAS_HOOK = false; static constexpr int HOOK_T0 = -1, HOOK_T1 = -1;
    const float *xp, *xs; float* H; bf16_t* HB; float* ssq;
    __device__ __forceinline__ void hook(f32x4 (&)[2][2][4][2], const Unit&, int, int, int, int, int) const {}
    __device__ __forceinline__ void operator()(const f32x4 (&acc)[2][2][4][2], const Unit& u, int wr, int wc, int fr, int fq) const {
        const int row0 = u.pm * BM + wr * 64 + fr, cb = u.pn * BM + wc * 32 + 8 * fq; const bool samp = u.pm >= TOK_P / BM;
        const float* xb = samp ? xs - (size_t)TOK_P * 1024 : xp;
#pragma unroll
        for (int ai = 0; ai < 2; ++ai)
#pragma unroll
            for (int m = 0; m < 4; ++m) { const size_t row = (size_t)(row0 + ai * HALF + m * 16); float s = 0.f;
#pragma unroll
                for (int bj = 0; bj < 2; ++bj) { const size_t off = row * 1024 + cb + bj * HALF;
                    const f32x4 h0 = *(const f32x4*)(xb + off) + acc[ai][bj][m][0], h1 = *(const f32x4*)(xb + off + 4) + acc[ai][bj][m][1];
                    *(f32x4*)(H + off) = h0; *(f32x4*)(H + off + 4) = h1; *(u32x4*)(HB + off) = pack8(h0, h1);
                    s += (h0[0] * h0[0] + h0[1] * h0[1]) + (h0[2] * h0[2] + h0[3] * h0[3]) + (h1[0] * h1[0] + h1[1] * h1[1]) + (h1[2] * h1[2] + h1[3] * h1[3]); }
                s += __shfl_xor(s, 16); s += __shfl_xor(s, 32);
                if (fq == 0) atomicAdd(ssq + row, s); }
    }
};
struct EpiUp {
    static constexpr bool PERM = true, AFTER_DRAIN = false, HAS_HOOK = false; static constexpr int HOOK_T0 = -1, HOOK_T1 = -1;
    const float* ssq; bf16_t* A2;
    __device__ __forceinline__ void hook(f32x4 (&)[2][2][4][2], const Unit&, int, int, int, int, int) const {}
    __device__ __forceinline__ void operator()(const f32x4 (&acc)[2][2][4][2], const Unit& u, int wr, int wc, int fr, int fq) const {
        const int row0 = u.pm * BM + wr * 64 + fr, cb = u.pn * BM + wc * 32 + 8 * fq;
#pragma unroll
        for (int ai = 0; ai < 2; ++ai)
#pragma unroll
            for (int m = 0; m < 4; ++m) { const size_t row = (size_t)(row0 + ai * HALF + m * 16);
                const float rs = 1.0f / sqrtf(__hip_atomic_load(ssq + row, __ATOMIC_RELAXED, __HIP_MEMORY_SCOPE_AGENT) * (1.0f / 1024.0f) + 1e-6f);
#pragma unroll
                for (int bj = 0; bj < 2; ++bj) { f32x4 v0 = acc[ai][bj][m][0] * rs, v1 = acc[ai][bj][m][1] * rs;
#pragma unroll
                    for (int j = 0; j < 4; ++j) { const float a = fmaxf(v0[j], 0.f), b = fmaxf(v1[j], 0.f); v0[j] = a * a; v1[j] = b * b; }
                    *(u32x4*)(A2 + row * 4096 + cb + bj * HALF) = pack8(v0, v1); } }
    }
};
struct EpiDown {
    static constexpr bool PERM = true, AFTER_DRAIN = false, HAS_HOOK = false; static constexpr int HOOK_T0 = -1, HOOK_T1 = -1;
    float* H; float* ssq;
    __device__ __forceinline__ void hook(f32x4 (&)[2][2][4][2], const Unit&, int, int, int, int, int) const {}
    __device__ __forceinline__ void operator()(const f32x4 (&acc)[2][2][4][2], const Unit& u, int wr, int wc, int fr, int fq) const {
        const int row0 = u.pm * BM + wr * 64 + fr, cb = u.pn * BM + wc * 32 + 8 * fq;
#pragma unroll
        for (int ai = 0; ai < 2; ++ai)
#pragma unroll
            for (int m = 0; m < 4; ++m) { const size_t row = (size_t)(row0 + ai * HALF + m * 16); float s = 0.f;
#pragma unroll
                for (int bj = 0; bj < 2; ++bj) { const size_t off = row * 1024 + cb + bj * HALF;
                    const f32x4 h0 = *(const f32x4*)(H + off) + acc[ai][bj][m][0], h1 = *(const f32x4*)(H + off + 4) + acc[ai][bj][m][1];
                    *(f32x4*)(H + off) = h0; *(f32x4*)(H + off + 4) = h1;
                    s += (h0[0] * h0[0] + h0[1] * h0[1]) + (h0[2] * h0[2] + h0[3] * h0[3]) + (h1[0] * h1[0] + h1[1] * h1[1]) + (h1[2] * h1[2] + h1[3] * h1[3]); }
                s += __shfl_xor(s, 16); s += __shfl_xor(s, 32);
                if (fq == 0) atomicAdd(ssq + row, s); }
    }
};
template <class Epi, class Sched, bool ALIGN_EPI = false, bool SP2 = false>
__device__ __forceinline__ void gemm_phase(PG8_LAS unsigned char* lds, const Gemm g, const Sched& S, const Epi& E) {
    int tid_ = threadIdx.x; asm volatile("" : "+v"(tid_));
    const int tid = tid_, wid = __builtin_amdgcn_readfirstlane(tid >> 6), lane = tid & 63, wr = wid >> 2, wc = wid & 3, fr = lane & 15, fq = lane >> 4;
    const int K = g.K, nt = K / BK;
    unsigned voffA[2], voffB[2];
#pragma unroll
    for (int i = 0; i < 2; ++i) { int R, C; stage_rc(tid * 16 + i * 8192, R, C); const int Rb = Epi::PERM ? ((R & ~31) + perm32(R & 31)) : R;
        voffA[i] = (unsigned)(R * K + C) * 2u; voffB[i] = (unsigned)(Rb * K + C) * 2u; }
    const size_t kstep = (size_t)(BK * 2);
    const size_t hstep = (size_t)HALF * K * 2;
    const size_t tstep = 2 * hstep;
    const unsigned ldsw = (unsigned)wid * 1024u;
    const int aoff = lds_byte(wr * 64 + fr, fq * 8), boff = lds_byte(wc * 32 + fr, fq * 8);
#define PG8_SA(b, h) (((b) * 2 + (h)) * HTB)
#define PG8_SB(b, h) ((4 + (b) * 2 + (h)) * HTB)
#define PG8_STAGE(bufoff, gbase, voff) do { _Pragma("unroll") for (int _i = 0; _i < 2; ++_i) \
        __builtin_amdgcn_global_load_lds((const unsigned*)((const char*)(gbase) + (voff)[_i]), (PG8_LAS unsigned*)(lds + (bufoff) + ldsw + _i * 8192), 16, 0, 0); } while (0)
#define PG8_LDA(dst, b, h) do { _Pragma("unroll") for (int m = 0; m < 4; ++m) _Pragma("unroll") for (int k = 0; k < 2; ++k) dst[m][k] = *(const PG8_LAS bf16x8*)(lds + PG8_SA(b, h) + aoff + m * 2048 + k * 1024); } while (0)
#define PG8_LDB(dst, b, h) do { _Pragma("unroll") for (int n = 0; n < 2; ++n) _Pragma("unroll") for (int k = 0; k < 2; ++k) dst[n][k] = *(const PG8_LAS bf16x8*)(lds + PG8_SB(b, h) + boff + n * 2048 + k * 1024); } while (0)
#define PG8_MMA(ai, bj, At, Bt) do { __builtin_amdgcn_s_setprio(1); _Pragma("unroll") for (int m = 0; m < 4; ++m) _Pragma("unroll") for (int n = 0; n < 2; ++n) _Pragma("unroll") for (int k = 0; k < 2; ++k) \
        acc[ai][bj][m][n] = __builtin_amdgcn_mfma_f32_16x16x32_bf16(Bt[n][k], At[m][k], acc[ai][bj][m][n], 0, 0, 0); __builtin_amdgcn_s_setprio(0); } while (0)
#define PG8_WAIT_V(n) asm volatile("s_waitcnt vmcnt(" #n ")" ::: "memory")
#define PG8_WAIT_L(n) asm volatile("s_waitcnt lgkmcnt(" #n ")" ::: "memory")
#define PG8_BAR __builtin_amdgcn_s_barrier()
#define PG8_SCHED __builtin_amdgcn_sched_barrier(0)
    Unit cur, nxt; int ui = 0;
    if (!S.next(0, cur)) return;
    f32x4 acc[2][2][4][2];
#pragma unroll
    for (int a = 0; a < 2; ++a)
#pragma unroll
        for (int b = 0; b < 2; ++b)
#pragma unroll
            for (int m = 0; m < 4; ++m)
#pragma unroll
                for (int n = 0; n < 2; ++n) acc[a][b][m][n] = (f32x4){0.f, 0.f, 0.f, 0.f};
    bf16x8 At[4][2], B0[2][2], B1[2][2];
    const char* cA = (const char*)g.A + (size_t)cur.pm * tstep; const char* cB = (const char*)g.Bt + (size_t)cur.pn * tstep;
    S.a_ready(cur);
    if constexpr (SP2) {
        PG8_STAGE(PG8_SB(0, 0), cB, voffB); PG8_STAGE(PG8_SB(0, 1), cB + hstep, voffB); PG8_STAGE(PG8_SA(0, 0), cA, voffA); PG8_STAGE(PG8_SA(0, 1), cA + hstep, voffA);
        if (wr == 1) PG8_BAR;
        PG8_WAIT_V(2); PG8_BAR;
        PG8_STAGE(PG8_SB(1, 0), cB + kstep, voffB); PG8_STAGE(PG8_SA(1, 0), cA + kstep, voffA); PG8_STAGE(PG8_SB(1, 1), cB + hstep + kstep, voffB);
        PG8_WAIT_V(6); PG8_BAR;
    } else {
        PG8_STAGE(PG8_SB(0, 0), cB, voffB); PG8_STAGE(PG8_SA(0, 0), cA, voffA); PG8_STAGE(PG8_SB(0, 1), cB + hstep, voffB); PG8_STAGE(PG8_SA(0, 1), cA + hstep, voffA);
        if (wr == 1) PG8_BAR;
        PG8_WAIT_V(4); PG8_BAR;
        PG8_STAGE(PG8_SB(1, 0), cB + kstep, voffB); PG8_STAGE(PG8_SA(1, 0), cA + kstep, voffA); PG8_STAGE(PG8_SB(1, 1), cB + hstep + kstep, voffB);
        PG8_WAIT_V(6); PG8_BAR;
    }
    for (;;) {
        const bool has_next = S.next(ui + 1, nxt);
        const char* nA = has_next ? (const char*)g.A + (size_t)nxt.pm * tstep : cA; const char* nB = has_next ? (const char*)g.Bt + (size_t)nxt.pn * tstep : cB;
        for (int t = 0; t < nt; t += 2) {
            if constexpr (Epi::HAS_HOOK) { if (t == Epi::HOOK_T0 || t == Epi::HOOK_T1) E.hook(acc, cur, t, wr, wc, fr, fq); }
            const bool last = (t == nt - 2);
            const char* a1 = cA + (size_t)(t + 1) * kstep;
            const char* a2 = last ? nA : cA + (size_t)(t + 2) * kstep; const char* b2 = last ? nB : cB + (size_t)(t + 2) * kstep;
            const char* a3 = a2 + kstep; const char* b3 = b2 + kstep;
            if (last && has_next) S.a_ready(nxt);
            if constexpr (SP2) {
            PG8_LDB(B0, 0, 0); PG8_LDB(B1, 0, 1); PG8_SCHED; PG8_LDA(At, 0, 0); PG8_STAGE(PG8_SA(1, 1), a1 + hstep, voffA);
            PG8_WAIT_V(8); PG8_WAIT_L(0); PG8_BAR; PG8_MMA(0, 0, At, B0); PG8_MMA(0, 1, At, B1); PG8_BAR; PG8_SCHED;
            PG8_LDA(At, 0, 1); PG8_STAGE(PG8_SB(0, 0), b2, voffB); PG8_STAGE(PG8_SB(0, 1), b2 + hstep, voffB); PG8_STAGE(PG8_SA(0, 0), a2, voffA);
            PG8_WAIT_V(8); PG8_WAIT_L(0); PG8_BAR; PG8_MMA(1, 0, At, B0); PG8_MMA(1, 1, At, B1); PG8_BAR; PG8_SCHED;
            PG8_LDB(B0, 1, 0); PG8_LDB(B1, 1, 1); PG8_SCHED; PG8_LDA(At, 1, 0); PG8_STAGE(PG8_SA(0, 1), a2 + hstep, voffA);
            PG8_WAIT_V(8); PG8_WAIT_L(0); PG8_BAR; PG8_MMA(0, 0, At, B0); PG8_MMA(0, 1, At, B1); PG8_BAR; PG8_SCHED;
            PG8_LDA(At, 1, 1); PG8_STAGE(PG8_SB(1, 0), b3, voffB); PG8_STAGE(PG8_SB(1, 1), b3 + hstep, voffB); PG8_STAGE(PG8_SA(1, 0), a3, voffA);
            PG8_WAIT_V(8); PG8_WAIT_L(0); PG8_BAR; PG8_MMA(1, 0, At, B0); PG8_MMA(1, 1, At, B1); PG8_BAR; PG8_SCHED;
            } else {
            PG8_LDB(B0, 0, 0); PG8_SCHED; PG8_LDA(At, 0, 0); PG8_STAGE(PG8_SA(1, 1), a1 + hstep, voffA);
            PG8_WAIT_L(8); PG8_BAR; PG8_WAIT_L(0); PG8_MMA(0, 0, At, B0); PG8_BAR; PG8_SCHED;
            PG8_LDB(B1, 0, 1); PG8_STAGE(PG8_SB(0, 0), b2, voffB);
            PG8_BAR; PG8_WAIT_L(0); PG8_MMA(0, 1, At, B1); PG8_BAR;
            PG8_LDA(At, 0, 1); PG8_STAGE(PG8_SA(0, 0), a2, voffA);
            PG8_BAR; PG8_WAIT_L(0); PG8_MMA(1, 0, At, B0); PG8_BAR; PG8_SCHED;
            PG8_STAGE(PG8_SB(0, 1), b2 + hstep, voffB);
            PG8_WAIT_V(6); PG8_BAR; PG8_MMA(1, 1, At, B1); PG8_BAR;
            PG8_LDB(B0, 1, 0); PG8_SCHED; PG8_LDA(At, 1, 0); PG8_STAGE(PG8_SA(0, 1), a2 + hstep, voffA);
            PG8_WAIT_L(8); PG8_BAR; PG8_WAIT_L(0); PG8_MMA(0, 0, At, B0); PG8_BAR; PG8_SCHED;
            PG8_LDB(B1, 1, 1); PG8_STAGE(PG8_SB(1, 0), b3, voffB);
            PG8_BAR; PG8_WAIT_L(0); PG8_MMA(0, 1, At, B1); PG8_BAR;
            PG8_LDA(At, 1, 1); PG8_STAGE(PG8_SA(1, 0), a3, voffA);
            PG8_BAR; PG8_WAIT_L(0); PG8_MMA(1, 0, At, B0); PG8_BAR; PG8_SCHED;
            PG8_STAGE(PG8_SB(1, 1), b3 + hstep, voffB);
            PG8_WAIT_V(6); PG8_BAR; PG8_MMA(1, 1, At, B1); PG8_BAR;
            }
        }
        if constexpr (ALIGN_EPI) { if (wr == 0) PG8_BAR; }
        if constexpr (!Epi::AFTER_DRAIN) { E(acc, cur, wr, wc, fr, fq); S.done(cur); }
        if (!has_next) break;
#pragma unroll
        for (int a = 0; a < 2; ++a)
#pragma unroll
            for (int b = 0; b < 2; ++b)
#pragma unroll
                for (int m = 0; m < 4; ++m)
#pragma unroll
                    for (int n = 0; n < 2; ++n) acc[a][b][m][n] = (f32x4){0.f, 0.f, 0.f, 0.f};
        cur = nxt; cA = nA; cB = nB; ++ui;
        if constexpr (ALIGN_EPI) { if (wr == 1) PG8_BAR; }
    }
    PG8_WAIT_V(0);
    if constexpr (!ALIGN_EPI) { if (wr == 0) PG8_BAR; }
    PG8_BAR;
    if constexpr (Epi::AFTER_DRAIN) { E.fused(acc, cur, wr, wc, fr, fq, lds, wid, lane); S.done(cur); }
#undef PG8_SA
#undef PG8_SB
#undef PG8_STAGE
#undef PG8_LDA
#undef PG8_LDB
#undef PG8_MMA
#undef PG8_WAIT_V
#undef PG8_WAIT_L
#undef PG8_BAR
#undef PG8_SCHED
}
}
namespace attn_body {
using bf16=__hip_bfloat16;
using bf16x8=__attribute__((ext_vector_type(8)))short;
using s16x4=__attribute__((ext_vector_type(4)))short;
using f32x16=__attribute__((ext_vector_type(16)))float;
using u32x4=__attribute__((ext_vector_type(4)))unsigned;
constexpr int NHEAD=8,SEQ=4096,D=64,DM=NHEAD*D,OP=1536;
constexpr int NW=8,QBLK=32,QB=QBLK*NW,KVBLK=64,NQB=SEQ/QB;
constexpr int ATTN_PITCH=DM, ATTN_UNIT_ROWS=QB;
__device__ __forceinline__ int crow(int r,int hi){return (r&3)+8*(r>>2)+4*hi;}
#define SBAR() __builtin_amdgcn_sched_barrier(0)
__device__ __forceinline__ void cmask(f32x16&p0,f32x16&p1,int jb,int qrel,int hi){
  const float NEG=-INFINITY; int kb=64*jb+4*hi;
  #pragma unroll
  for(int r=0;r<16;++r){int kv=kb+(r&3)+8*(r>>2); if(kv>qrel)p0[r]=NEG; if(kv+32>qrel)p1[r]=NEG;}
}

constexpr int NSLOT=3, SLOTB=8192;
constexpr int LDS_K=0, LDS_V=NSLOT*SLOTB, LDS_WS=2*NSLOT*SLOTB, LDS_OST=LDS_WS+NW*64*4, LDS_DL=LDS_OST+NW*4096, LDS_BYTES=LDS_DL+SEQ*4;
constexpr float C2=0.125f*1.4426950408889634f;
__device__ __forceinline__ void glds16(const void*gsrc,unsigned lds_dst){unsigned keep;
  asm volatile("s_mov_b32 %0, m0\n\ts_mov_b32 m0, %2\n\ts_nop 0\n\tglobal_load_lds_dwordx4 %1, off\n\ts_mov_b32 m0, %0":"=&s"(keep):"v"(gsrc),"s"(lds_dst):"memory");}
__device__ __forceinline__ float max3f(float a,float b,float c){float r;asm("v_max3_f32 %0, %1, %2, %3":"=v"(r):"v"(a),"v"(b),"v"(c));return r;}
__device__ __forceinline__ float max2f(float a,float b){float r;asm("v_max_f32_e32 %0, %1, %2":"=v"(r):"v"(a),"v"(b));return r;}
__device__ __forceinline__ float fadd_s(float a,float b){float r;asm("v_add_f32_e32 %0, %1, %2":"=v"(r):"v"(a),"v"(b));return r;}
__device__ __forceinline__ float fsub_s(float a,float b){float r;asm("v_sub_f32_e32 %0, %1, %2":"=v"(r):"v"(a),"v"(b));return r;}
typedef float f32x4_t __attribute__((ext_vector_type(4))); typedef float f32x2_t __attribute__((ext_vector_type(2))); typedef __bf16 bf16x2_t __attribute__((ext_vector_type(2)));
__device__ __forceinline__ unsigned cvtpk_s(float lo,float hi){f32x2_t v={lo,hi};bf16x2_t b=__builtin_convertvector(v,bf16x2_t);return __builtin_bit_cast(unsigned,b);}
#define WAIT_BAR(N) asm volatile("s_waitcnt vmcnt(" #N ") lgkmcnt(0)\n\ts_barrier":::"memory")

__device__ __forceinline__ void qkt(f32x16&p0,f32x16&p1,const char*Kslot,const bf16x8*qr,const f32x16&negm,int r32,int hi){
  const char*kb=Kslot+hi*1024+r32*16;
  #pragma unroll
  for(int d0=0;d0<4;++d0){
    const bf16x8 b0=*reinterpret_cast<const bf16x8*>(kb+d0*2048);
    const bf16x8 b1=*reinterpret_cast<const bf16x8*>(kb+d0*2048+512);
    if(d0==0){p0=__builtin_amdgcn_mfma_f32_32x32x16_bf16(b0,qr[0],negm,0,0,0);p1=__builtin_amdgcn_mfma_f32_32x32x16_bf16(b1,qr[0],negm,0,0,0);}
    else{p0=__builtin_amdgcn_mfma_f32_32x32x16_bf16(b0,qr[d0],p0,0,0,0);p1=__builtin_amdgcn_mfma_f32_32x32x16_bf16(b1,qr[d0],p1,0,0,0);}}
}
typedef __attribute__((address_space(3))) const char* lds_cptr;
typedef short v4i16_t __attribute__((ext_vector_type(4)));
__device__ __forceinline__ void kload8(bf16x8*kf,lds_cptr kp){
  kf[0]=*(const __attribute__((address_space(3))) bf16x8*)(kp);      kf[1]=*(const __attribute__((address_space(3))) bf16x8*)(kp+512);
  kf[2]=*(const __attribute__((address_space(3))) bf16x8*)(kp+2048); kf[3]=*(const __attribute__((address_space(3))) bf16x8*)(kp+2560);
  kf[4]=*(const __attribute__((address_space(3))) bf16x8*)(kp+4096); kf[5]=*(const __attribute__((address_space(3))) bf16x8*)(kp+4608);
  kf[6]=*(const __attribute__((address_space(3))) bf16x8*)(kp+6144); kf[7]=*(const __attribute__((address_space(3))) bf16x8*)(kp+6656);
}
__device__ __forceinline__ void kload2(bf16x8*kf,lds_cptr kp,int j){ kf[2*j]=*(const __attribute__((address_space(3))) bf16x8*)(kp+j*2048); kf[2*j+1]=*(const __attribute__((address_space(3))) bf16x8*)(kp+j*2048+512); }
__device__ __forceinline__ s16x4 vtr(lds_cptr p){ return __builtin_bit_cast(s16x4,__builtin_amdgcn_ds_read_tr16_b64_v4i16((__attribute__((address_space(3))) v4i16_t*)p)); }
__device__ __forceinline__ float rowmax(const f32x16&p0,const f32x16&p1){
  float a=max3f(p0[0],p0[1],p1[0]),b=max3f(p0[2],p0[3],p1[1]);a=max3f(a,p1[2],p1[3]);
  #pragma unroll
  for(int r=4;r<16;r+=4){a=max3f(a,p0[r],p0[r+1]);b=max3f(b,p0[r+2],p0[r+3]);a=max3f(a,p1[r],p1[r+1]);b=max3f(b,p1[r+2],p1[r+3]);}
  const float m=max2f(a,b);
  auto rr=__builtin_amdgcn_permlane32_swap(__float_as_uint(m),__float_as_uint(m),false,false);
  return max2f(__uint_as_float(rr[0]),__uint_as_float(rr[1]));
}
__device__ __forceinline__ void pv(f32x16*o,int vb,bf16x8 pa0,bf16x8 pa1,bf16x8 pa2,bf16x8 pa3){
  #pragma unroll
  for(int d0=0;d0<2;++d0){s16x4 lo[4],hi[4];
    #pragma unroll
    for(int ks=0;ks<4;++ks){
      asm volatile("ds_read_b64_tr_b16 %0,%1 offset:%c2":"=&v"(lo[ks]):"v"(vb),"i"(d0*4096+ks*1024):"memory");
      asm volatile("ds_read_b64_tr_b16 %0,%1 offset:%c2":"=&v"(hi[ks]):"v"(vb),"i"(d0*4096+ks*1024+512):"memory");}
    asm volatile("s_waitcnt lgkmcnt(0)":::"memory");SBAR();
    #define PK(k) (bf16x8){lo[k][0],lo[k][1],lo[k][2],lo[k][3],hi[k][0],hi[k][1],hi[k][2],hi[k][3]}
    o[d0]=__builtin_amdgcn_mfma_f32_32x32x16_bf16(pa0,PK(0),o[d0],0,0,0);
    o[d0]=__builtin_amdgcn_mfma_f32_32x32x16_bf16(pa1,PK(1),o[d0],0,0,0);
    o[d0]=__builtin_amdgcn_mfma_f32_32x32x16_bf16(pa2,PK(2),o[d0],0,0,0);
    o[d0]=__builtin_amdgcn_mfma_f32_32x32x16_bf16(pa3,PK(3),o[d0],0,0,0);
    #undef PK
  }
}

#ifndef ATTN_STORE16
#define ATTN_STORE16(p,v) (*(u32x4*)(p)=(v))
#endif
template<int THRL> __device__ __forceinline__ void attn_unit(int b,int h,int qb,int ts,const bf16*Q,const bf16*__restrict__ K,const bf16*__restrict__ V,bf16*O,const float*dP,char*shm){
  int tid_=threadIdx.x; asm volatile("":"+v"(tid_));
  const int tid=tid_,lane=tid&63,r32=lane&31,hi=lane>>5; const int wid=__builtin_amdgcn_readfirstlane(tid>>6);
  const long rowbase=(long)b*SEQ; const int q0=qb*QB;
  const bf16*Qw=Q+(rowbase+q0+wid*QBLK)*DM+h*D;
  const bf16*Kh=K+(rowbase+(long)ts*KVBLK)*DM+h*D,*Vh=V+(rowbase+(long)ts*KVBLK)*DM+h*D;
  const unsigned lds0=(unsigned)(uintptr_t)shm;
  float*wsf=(float*)(shm+LDS_WS)+wid*64;
  const bf16*ksrc=Kh+(long)lane*DM+wid*8;
  const bf16*vsrc=Vh+(long)(16*(wid&3)+(lane>>2))*DM+(wid>>2)*32+(lane&3)*8;
  const unsigned kdst=lds0+LDS_K+wid*1024, vdst=lds0+LDS_V+wid*1024;
  #define DMA_K(t,slot) glds16(ksrc+(long)(t)*KVBLK*DM,(unsigned)__builtin_amdgcn_readfirstlane(kdst+(slot)))
  #define DMA_V(t,slot) glds16(vsrc+(long)(t)*KVBLK*DM,(unsigned)__builtin_amdgcn_readfirstlane(vdst+(slot)))
  const int vb0=(int)(lds0+LDS_V)+((lane>>4)&1)*32+(lane&3)*8+(4*hi+((lane&15)>>2))*64;
  const char*Kbase=shm+LDS_K; bf16x8 kf[8];
  const lds_cptr shm3=(lds_cptr)shm; const lds_cptr kp0=shm3+LDS_K+hi*1024+r32*16; const lds_cptr vp0=shm3+LDS_V+((lane>>4)&1)*32+(lane&3)*8+(4*hi+((lane&15)>>2))*64;
  const int NT=(q0+QB)/KVBLK-ts;
  { __attribute__((address_space(3))) float*dlw=(__attribute__((address_space(3))) float*)(shm3+LDS_DL); const float dref=dP[q0+QB-1]; const int nk=NT*KVBLK;
    for(int i=tid;i<nk;i+=NW*64)dlw[i]=dP[ts*KVBLK+i]-dref; }
  #define ADDB(P0,P1,t) do{ const __attribute__((address_space(3))) f32x4_t*dp_=(const __attribute__((address_space(3))) f32x4_t*)(shm3+LDS_DL+(t)*256+hi*16); \
    _Pragma("unroll") for(int rr=0;rr<4;++rr){ const f32x4_t a_=dp_[rr*2],b_=dp_[8+rr*2]; \
      _Pragma("unroll") for(int j=0;j<4;++j){P0[4*rr+j]+=a_[j];P1[4*rr+j]+=b_[j];} SBAR(); } }while(0)
  DMA_K(0,0);DMA_V(0,0);DMA_K(1,SLOTB);
  bf16x8 qr[4];
  #pragma unroll
  for(int d0=0;d0<4;++d0)qr[d0]=*reinterpret_cast<const bf16x8*>(&Qw[(long)r32*DM+d0*16+hi*8]);
  float mhat=0.f,l_reg=0.f;f32x16 o[2];o[0]=f32x16{};o[1]=f32x16{};f32x16 negm=f32x16{};asm volatile("":"+v"(negm));
  const int qrel=wid*QBLK+r32;
  #define CMASK(P0,P1,t) do{int jb_=(t)-(NT-4); if(jb_>=0)cmask(P0,P1,jb_,qrel,hi);}while(0)
  bool resc=false;
  #define START(P0,P1) do{ const float rm=rowmax(P0,P1); resc=false; \
    { const float dl=rm; mhat=fadd_s(mhat,dl); \
      _Pragma("unroll") for(int r=0;r<16;++r){P0[r]=fsub_s(P0[r],dl);P1[r]=fsub_s(P1[r],dl);} \
      _Pragma("unroll") for(int r=0;r<16;++r)negm[r]=-mhat; asm volatile("":"+v"(negm)); } \
    _Pragma("unroll") for(int r=0;r<16;++r)P0[r]=__builtin_amdgcn_exp2f(P0[r]); }while(0)
  #define RESC() do{ if(resc){ asm volatile("s_waitcnt lgkmcnt(0)":::"memory"); \
      _Pragma("unroll") for(int d_=0;d_<2;++d_) _Pragma("unroll") for(int r=0;r<16;++r)o[d_][r]*=wsf[crow(r,hi)]; } }while(0)
  f32x16 pA0,pA1,pB0,pB1;
  int sl_prev=0,sl_cur=0,sl_next=SLOTB;
  #define ROT() do{sl_prev=sl_cur;sl_cur=sl_next;sl_next=(sl_next==(NSLOT-1)*SLOTB)?0:sl_next+SLOTB;}while(0)
  DMA_K(2,2*SLOTB);
  WAIT_BAR(3);
  qkt(pA0,pA1,Kbase,qr,negm,r32,hi);asm volatile("s_nop 15\n\ts_nop 7":"+v"(pA0),"+v"(pA1));CMASK(pA0,pA1,0);ADDB(pA0,pA1,0);
  START(pA0,pA1);
  _Pragma("unroll") for(int r=0;r<16;++r)pA1[r]=__builtin_amdgcn_exp2f(pA1[r]);
  WAIT_BAR(0);
  DMA_K(3,0);DMA_V(1,SLOTB);
  ROT();
  kload8(kf,kp0+sl_cur);
  WAIT_BAR(2);
  s16x4 vlo[8],vhi[8]; u32x4 pw0,pw1,pw2,pw3;
  #define PKW(P,B) cvtpk_s(P[B],P[B+1])
  #define PAF(k) __builtin_bit_cast(bf16x8,pw##k)
  #define VFR(i) (bf16x8){vlo[i][0],vlo[i][1],vlo[i][2],vlo[i][3],vhi[i][0],vhi[i][1],vhi[i][2],vhi[i][3]}
  #define PIN(x) asm volatile("":"+v"(x))
  #define MX3(a,b,c) __builtin_fmaxf(__builtin_fmaxf((a),(b)),(c))
  #define GAPA(MF,A0,A1,A2,A3,W0,W1,PW) do{ MF; sacc+=A0; sacc+=A1; sacc+=A2; sacc+=A3; PIN(sacc); W0; W1; PIN(PW); SBAR(); }while(0)
  #define EX(v) __builtin_amdgcn_exp2f(v)
  #define GAPB(MF,X,B) do{ MF; X[B]=EX(X[B]); X[B+1]=EX(X[B+1]); X[B+2]=EX(X[B+2]); X[B+3]=EX(X[B+3]); PIN(X); SBAR(); }while(0)
  #define VRD(i) do{ vlo[i]=vtr(vp_+(((i)>>2)*4096+((i)&3)*1024)); vhi[i]=vtr(vp_+(((i)>>2)*4096+((i)&3)*1024+512)); }while(0)
  #define KRD(G,j) do{ if(G){ kload2(kf,kp0+sl_next,j); SBAR(); } }while(0)
  #define STEP(C0,C1,P0,P1,t,GK,GV,GL) do{ SBAR(); \
    const lds_cptr vp_=vp0+sl_prev; \
    VRD(0); SBAR(); float sacc=(P0[0]+P0[1]); \
    GAPA(C0=__builtin_amdgcn_mfma_f32_32x32x16_bf16(kf[0],qr[0],negm,0,0,0), P0[2],P0[3],P0[4],P0[5],     pw0[0]=PKW(P0,0), pw0[1]=PKW(P0,2), pw0); \
    VRD(4); SBAR(); GAPA(C1=__builtin_amdgcn_mfma_f32_32x32x16_bf16(kf[1],qr[0],negm,0,0,0), P0[6],P0[7],P0[8],P0[9],     pw0[2]=PKW(P0,4), pw0[3]=PKW(P0,6), pw0); \
    VRD(1); SBAR(); GAPA(C0=__builtin_amdgcn_mfma_f32_32x32x16_bf16(kf[2],qr[1],C0,0,0,0),   P0[10],P0[11],P0[12],P0[13], pw1[0]=PKW(P0,8), pw1[1]=PKW(P0,10), pw1); \
    VRD(5); SBAR(); GAPA(C1=__builtin_amdgcn_mfma_f32_32x32x16_bf16(kf[3],qr[1],C1,0,0,0),   P0[14],P0[15],P1[0],P1[1],   pw1[2]=PKW(P0,12),pw1[3]=PKW(P0,14), pw1); \
    VRD(2); SBAR(); GAPA(C0=__builtin_amdgcn_mfma_f32_32x32x16_bf16(kf[4],qr[2],C0,0,0,0),   P1[2],P1[3],P1[4],P1[5],     pw2[0]=PKW(P1,0), pw2[1]=PKW(P1,2), pw2); \
    VRD(6); SBAR(); GAPA(C1=__builtin_amdgcn_mfma_f32_32x32x16_bf16(kf[5],qr[2],C1,0,0,0),   P1[6],P1[7],P1[8],P1[9],     pw2[2]=PKW(P1,4), pw2[3]=PKW(P1,6), pw2); \
    VRD(3); SBAR(); GAPA(C0=__builtin_amdgcn_mfma_f32_32x32x16_bf16(kf[6],qr[3],C0,0,0,0),   P1[10],P1[11],P1[12],P1[13], pw3[0]=PKW(P1,8), pw3[1]=PKW(P1,10), pw3); \
    VRD(7); SBAR(); GAPA(C1=__builtin_amdgcn_mfma_f32_32x32x16_bf16(kf[7],qr[3],C1,0,0,0),   P1[14],P1[15],0.f,0.f,       pw3[2]=PKW(P1,12),pw3[3]=PKW(P1,14), pw3); \
    l_reg+=sacc; \
    if(GK){DMA_K((t)+3,sl_cur);} if(GV){DMA_V((t)+1,sl_next);} \
    CMASK(C0,C1,t); ADDB(C0,C1,t); \
    { float a=MX3(C0[0],C0[1],C1[0]),b=MX3(C0[2],C0[3],C1[1]); a=MX3(a,C1[2],C1[3]); \
      _Pragma("unroll") for(int r=4;r<16;r+=4){a=MX3(a,C0[r],C0[r+1]);b=MX3(b,C0[r+2],C0[r+3]);a=MX3(a,C1[r],C1[r+1]);b=MX3(b,C1[r+2],C1[r+3]);} \
      float rm=__builtin_fmaxf(a,b); { auto rr=__builtin_amdgcn_permlane32_swap(__float_as_uint(rm),__float_as_uint(rm),false,false); rm=__builtin_fmaxf(__uint_as_float(rr[0]),__uint_as_float(rr[1])); } \
      resc=false; \
      if(__builtin_expect(__any(rm>(float)THRL),0)){ const float dl=__builtin_fmaxf(rm,0.f); mhat+=dl; \
        _Pragma("unroll") for(int r=0;r<16;++r){C0[r]-=dl;C1[r]-=dl;} \
        _Pragma("unroll") for(int r=0;r<16;++r)negm[r]=-mhat; asm volatile("":"+v"(negm)); \
        const float f=__builtin_amdgcn_exp2f(-dl); l_reg*=f; if(hi==0)wsf[r32]=f; resc=true; } } \
    SBAR(); \
    GAPB(o[0]=__builtin_amdgcn_mfma_f32_32x32x16_bf16(PAF(0),VFR(0),o[0],0,0,0), C0,0); \
    GAPB(o[1]=__builtin_amdgcn_mfma_f32_32x32x16_bf16(PAF(0),VFR(4),o[1],0,0,0), C0,4); \
    KRD(GL,0); GAPB(o[0]=__builtin_amdgcn_mfma_f32_32x32x16_bf16(PAF(1),VFR(1),o[0],0,0,0), C0,8); \
    KRD(GL,1); GAPB(o[1]=__builtin_amdgcn_mfma_f32_32x32x16_bf16(PAF(1),VFR(5),o[1],0,0,0), C0,12); \
    KRD(GL,2); GAPB(o[0]=__builtin_amdgcn_mfma_f32_32x32x16_bf16(PAF(2),VFR(2),o[0],0,0,0), C1,0); \
    KRD(GL,3); GAPB(o[1]=__builtin_amdgcn_mfma_f32_32x32x16_bf16(PAF(2),VFR(6),o[1],0,0,0), C1,4); \
    GAPB(o[0]=__builtin_amdgcn_mfma_f32_32x32x16_bf16(PAF(3),VFR(3),o[0],0,0,0), C1,8); \
    GAPB(o[1]=__builtin_amdgcn_mfma_f32_32x32x16_bf16(PAF(3),VFR(7),o[1],0,0,0), C1,12); \
    }while(0)
  int t=1;
  #undef CMASK
  #define CMASK(P0,P1,t) do{}while(0)
  for(;t+5<NT;t+=2){
    STEP(pB0,pB1,pA0,pA1,t,true,true,true);     WAIT_BAR(2); RESC(); ROT();
    STEP(pA0,pA1,pB0,pB1,t+1,true,true,true);   WAIT_BAR(2); RESC(); ROT();
  }
  #undef CMASK
  #define CMASK(P0,P1,t) do{int jb_=(t)-(NT-4); if(jb_>=0)cmask(P0,P1,jb_,qrel,hi);}while(0)
  #define ENDW(tt) do{ if((tt)+3<NT){WAIT_BAR(2);} else if((tt)+2<NT){WAIT_BAR(1);} else {WAIT_BAR(0);} }while(0)
  for(;t+1<NT;t+=2){
    STEP(pB0,pB1,pA0,pA1,t,(t+3<NT),(t+1<NT),(t+1<NT));       ENDW(t);   RESC(); ROT();
    STEP(pA0,pA1,pB0,pB1,t+1,(t+4<NT),(t+2<NT),(t+2<NT));     ENDW(t+1); RESC(); ROT();
  }
  STEP(pB0,pB1,pA0,pA1,NT-1,false,false,false); RESC();
  { float sacc=pB0[0]+pB0[1]; _Pragma("unroll") for(int r=2;r<16;++r)sacc+=pB0[r]; _Pragma("unroll") for(int r=0;r<16;++r)sacc+=pB1[r]; l_reg+=sacc;
    pw0=(u32x4){PKW(pB0,0),PKW(pB0,2),PKW(pB0,4),PKW(pB0,6)};pw1=(u32x4){PKW(pB0,8),PKW(pB0,10),PKW(pB0,12),PKW(pB0,14)};pw2=(u32x4){PKW(pB1,0),PKW(pB1,2),PKW(pB1,4),PKW(pB1,6)};pw3=(u32x4){PKW(pB1,8),PKW(pB1,10),PKW(pB1,12),PKW(pB1,14)};
    SBAR(); pv(o,vb0+sl_cur,PAF(0),PAF(1),PAF(2),PAF(3)); }
  #undef PKW
  #undef PAF
  #undef VFR
  #undef PIN
  #undef MX3
  #undef GAPA
  #undef GAPB
  #undef EX
  #undef VRD
  #undef KRD
  #undef STEP
  #undef ENDW
  {auto rr=__builtin_amdgcn_permlane32_swap(__float_as_uint(l_reg),__float_as_uint(l_reg),false,false);l_reg=__uint_as_float(rr[0])+__uint_as_float(rr[1]);}
  if(hi==0)wsf[32+r32]=l_reg;asm volatile("s_waitcnt lgkmcnt(0)":::"memory");
  float rli[16];
  #pragma unroll
  for(int r=0;r<16;++r)rli[r]=__builtin_amdgcn_rcpf(wsf[32+crow(r,hi)]);
  bf16*Ow=O+(rowbase+q0+wid*QBLK)*OP+h*D;
  { bf16*stg=(bf16*)(shm+LDS_OST)+wid*2048;
    #pragma unroll
    for(int r=0;r<16;++r){const int orow=crow(r,hi);
      #pragma unroll
      for(int d0=0;d0<2;++d0)stg[orow*64+d0*32+r32]=__float2bfloat16(o[d0][r]*rli[r]);}
    asm volatile("s_waitcnt lgkmcnt(0)":::"memory");
    #pragma unroll
    for(int i=0;i<4;++i){const int row=i*8+(lane>>3),ch=lane&7; const u32x4 v=*(const u32x4*)(stg+row*64+ch*8); ATTN_STORE16(Ow+(long)row*OP+ch*8,v);} }
  asm volatile("s_waitcnt lgkmcnt(0)\n\ts_barrier":::"memory");
  #undef ADDB
  #undef DMA_K
  #undef DMA_V
  #undef CMASK
  #undef START
  #undef RESC
  #undef ROT
}
constexpr int ATTN_LDS_BYTES=LDS_BYTES;
#undef SBAR
#undef WAIT_BAR
}
namespace dense_body {
using bf16 = __hip_bfloat16;
constexpr int   D = 128, NW = 8, QBLK = 32, KVBLK = 64;
constexpr float SCALE = 0.088388347648318440f;
constexpr float THR = 8.f;
constexpr int SDEPTH = 2;
constexpr int LDQ = 512, LDK = 512, LDO = 1536;
constexpr size_t SHM_V = KVBLK * D * 2, SHM_K = KVBLK * D * 2, SHM_ATTN = 2 * SHM_V + 2 * SHM_K + NW * 64 * 4;
using bf16x8 = __attribute__((ext_vector_type(8))) short;
using s16x4  = __attribute__((ext_vector_type(4))) short;
using f32x16 = __attribute__((ext_vector_type(16))) float;
using f32x8  = __attribute__((ext_vector_type(8))) float;
using u32x4  = __attribute__((ext_vector_type(4))) unsigned;
#define KSWZ(row, colB) ((row) * 256 + ((colB) ^ (((row) & 7) << 4)))
#define SBAR() __builtin_amdgcn_sched_barrier(0)
__device__ __forceinline__ int crow(int r, int hi) { return (r & 3) + 8 * (r >> 2) + 4 * hi; }
__device__ __forceinline__ unsigned cvtpk(float lo, float hi) {
  unsigned r; asm volatile("v_cvt_pk_bf16_f32 %0, %1, %2" : "=v"(r) : "v"(lo), "v"(hi)); return r;
}
template <typename TIn> struct Stage;
template <> struct Stage<bf16>  { using T = bf16x8;
  __device__ static __forceinline__ T ld8(const bf16* p) { return *reinterpret_cast<const bf16x8*>(p); }
  __device__ static __forceinline__ bf16x8 tobf(T x) { return x; } };
template <> struct Stage<float> { using T = f32x8;
  __device__ static __forceinline__ T ld8(const float* p) { return *reinterpret_cast<const f32x8*>(p); }
  __device__ static __forceinline__ bf16x8 tobf(T x) {
    u32x4 w = {cvtpk(x[0], x[1]), cvtpk(x[2], x[3]), cvtpk(x[4], x[5]), cvtpk(x[6], x[7])}; return *reinterpret_cast<bf16x8*>(&w); } };

__device__ __forceinline__ void partialSM(f32x16& p0, f32x16& p1, float& m_reg, float& mn, float& alpha) {
  constexpr float C = SCALE * 1.4426950408889634f;
  float pmax = p0[0]; for (int r = 1; r < 16; ++r) pmax = fmaxf(pmax, p0[r]); for (int r = 0; r < 16; ++r) pmax = fmaxf(pmax, p1[r]);
  { auto rr = __builtin_amdgcn_permlane32_swap(__float_as_uint(pmax), __float_as_uint(pmax), false, false);
    pmax = fmaxf(__uint_as_float(rr[0]), __uint_as_float(rr[1])); }
  if (__builtin_expect(__all(pmax - m_reg <= THR / SCALE), 1)) { mn = m_reg; alpha = 1.f; }
  else { mn = fmaxf(m_reg, pmax); alpha = __builtin_amdgcn_exp2f((m_reg - mn) * C); m_reg = mn; }
  float mnC = -mn * C;
  for (int r = 0; r < 16; ++r) p0[r] = fmaf(p0[r], C, mnC); for (int r = 0; r < 16; ++r) p1[r] = fmaf(p1[r], C, mnC);
  for (int r = 0; r < 16; ++r) p0[r] = __builtin_amdgcn_exp2f(p0[r]);
}
__device__ __forceinline__ void finishSM(f32x16& p0, f32x16& p1, float alpha, float& l_reg, bf16x8& pa0, bf16x8& pa1, bf16x8& pa2, bf16x8& pa3) {
  for (int r = 0; r < 16; ++r) p1[r] = __builtin_amdgcn_exp2f(p1[r]);
  float ps = 0; for (int r = 0; r < 16; ++r) ps += p0[r]; for (int r = 0; r < 16; ++r) ps += p1[r];
  { auto rr = __builtin_amdgcn_permlane32_swap(__float_as_uint(ps), __float_as_uint(ps), false, false);
    ps = __uint_as_float(rr[0]) + __uint_as_float(rr[1]); }
  l_reg = l_reg * alpha + ps;
#define PK4(P, BASE, OUT) do { unsigned a0 = cvtpk(P[BASE + 0], P[BASE + 1]), a1 = cvtpk(P[BASE + 2], P[BASE + 3]);   \
    unsigned b0 = cvtpk(P[BASE + 4], P[BASE + 5]), b1 = cvtpk(P[BASE + 6], P[BASE + 7]);                              \
    auto r0 = __builtin_amdgcn_permlane32_swap(a0, b0, false, false); auto r1 = __builtin_amdgcn_permlane32_swap(a1, b1, false, false); \
    u32x4 w = {r0[0], r1[0], r0[1], r1[1]}; OUT = *reinterpret_cast<bf16x8*>(&w); } while (0)
  PK4(p0, 0, pa0); PK4(p0, 8, pa1); PK4(p1, 0, pa2); PK4(p1, 8, pa3);
#undef PK4
}
__device__ __forceinline__ void qkt(f32x16& p0, f32x16& p1, const bf16* Ks, const bf16x8* qr, int r32, int hi) {
  p0 = f32x16{}; p1 = f32x16{};
  for (int d0 = 0; d0 < 8; ++d0) { int cb = (d0 * 16 + hi * 8) * 2;
    bf16x8 b0 = *reinterpret_cast<const bf16x8*>((const char*)Ks + KSWZ(r32, cb));
    bf16x8 b1 = *reinterpret_cast<const bf16x8*>((const char*)Ks + KSWZ(32 + r32, cb));
    p0 = __builtin_amdgcn_mfma_f32_32x32x16_bf16(b0, qr[d0], p0, 0, 0, 0);
    p1 = __builtin_amdgcn_mfma_f32_32x32x16_bf16(b1, qr[d0], p1, 0, 0, 0); }
}
__device__ __forceinline__ int v_st(int k, int c) { const int kk = (k & ~0xC) | ((k & 4) << 1) | ((k & 8) >> 1); return ((kk >> 3) * 4 + (c >> 5)) * 512 + ((kk & 7) * 32 + (c & 31)) * 2; }
__device__ __forceinline__ int v_rd_base(int lane) { return ((lane & 3) << 3) | (((lane >> 2) & 3) << 6) | (((lane >> 4) & 1) << 5) | (((lane >> 5) & 1) << 8); }
constexpr int v_rd_off(int d0, int ks, int half) { return d0 * 512 + ks * 4096 + half * 2048; }
template <int OFF> __device__ __forceinline__ s16x4 tr_read(int vb) {
  s16x4 r; asm volatile("ds_read_b64_tr_b16 %0, %1 offset:%2" : "=&v"(r) : "v"(vb), "i"(OFF) : "memory"); return r;
}
template <int D0> __device__ __forceinline__ void pv_one(f32x16& od, int vb, bf16x8 pa0, bf16x8 pa1, bf16x8 pa2, bf16x8 pa3) {
  const s16x4 l0 = tr_read<v_rd_off(D0, 0, 0)>(vb), h0 = tr_read<v_rd_off(D0, 0, 1)>(vb), l1 = tr_read<v_rd_off(D0, 1, 0)>(vb), h1 = tr_read<v_rd_off(D0, 1, 1)>(vb);
  const s16x4 l2 = tr_read<v_rd_off(D0, 2, 0)>(vb), h2 = tr_read<v_rd_off(D0, 2, 1)>(vb), l3 = tr_read<v_rd_off(D0, 3, 0)>(vb), h3 = tr_read<v_rd_off(D0, 3, 1)>(vb);
  asm volatile("s_waitcnt lgkmcnt(0)" ::: "memory"); SBAR();
#define PK(L, H) (bf16x8){L[0], L[1], L[2], L[3], H[0], H[1], H[2], H[3]}
  od = __builtin_amdgcn_mfma_f32_32x32x16_bf16(pa0, PK(l0, h0), od, 0, 0, 0);
  od = __builtin_amdgcn_mfma_f32_32x32x16_bf16(pa1, PK(l1, h1), od, 0, 0, 0);
  od = __builtin_amdgcn_mfma_f32_32x32x16_bf16(pa2, PK(l2, h2), od, 0, 0, 0);
  od = __builtin_amdgcn_mfma_f32_32x32x16_bf16(pa3, PK(l3, h3), od, 0, 0, 0);
#undef PK
}
__device__ __forceinline__ void pv_d0(f32x16* o, int vb, bf16x8 pa0, bf16x8 pa1, bf16x8 pa2, bf16x8 pa3) {
  pv_one<0>(o[0], vb, pa0, pa1, pa2, pa3); pv_one<1>(o[1], vb, pa0, pa1, pa2, pa3); pv_one<2>(o[2], vb, pa0, pa1, pa2, pa3); pv_one<3>(o[3], vb, pa0, pa1, pa2, pa3);
}

template <typename TQ>
__device__ __forceinline__ void attn_dense_body(const TQ* __restrict__ Qb, const bf16* __restrict__ Kh, const bf16* __restrict__ Vh,
                                                bf16* __restrict__ Ob, int seq, char* lds) {
  using St = Stage<bf16>; using SQ = Stage<TQ>;
  int tid_ = threadIdx.x; asm volatile("" : "+v"(tid_));
  const int tid = tid_, wid = tid >> 6, lane = tid & 63, r32 = lane & 31, hi = lane >> 5;
  bf16* V_lds = (bf16*)lds; bf16* K_lds = (bf16*)(lds + 2 * SHM_V);
  float* ws = (float*)(lds + 2 * SHM_V + 2 * SHM_K) + wid * 64; float* li_l = ws; float* al_l = ws + 32;
  float m_reg = -1e30f, l_reg = 0; f32x16 o[4] = {}; bf16x8 qr[8];
  const TQ* Qw = Qb + (long)(wid * QBLK + r32) * LDQ + hi * 8;
#pragma unroll
  for (int d0 = 0; d0 < 8; ++d0) qr[d0] = SQ::tobf(SQ::ld8(Qw + d0 * 16));
  const int sr = tid >> 4, sc = (tid & 15) * 8, vst0 = v_st(sr, sc), vst1 = v_st(32 + sr, sc);
  const int vb0 = (int)(uintptr_t)V_lds + v_rd_base(lane);
  struct { typename St::T vs0, vs1, ks0, ks1; } sr_[SDEPTH];
#define SLOAD(i, k0) do { sr_[i].vs0 = St::ld8(&Vh[(long)((k0) + sr) * LDK + sc]); sr_[i].vs1 = St::ld8(&Vh[(long)((k0) + 32 + sr) * LDK + sc]); \
    sr_[i].ks0 = St::ld8(&Kh[(long)((k0) + sr) * LDK + sc]); sr_[i].ks1 = St::ld8(&Kh[(long)((k0) + 32 + sr) * LDK + sc]); } while (0)
#define SWRITE(b, i) do { *(bf16x8*)((char*)V_lds + (b) * SHM_V + vst0) = St::tobf(sr_[i].vs0);          \
    *(bf16x8*)((char*)V_lds + (b) * SHM_V + vst1) = St::tobf(sr_[i].vs1); int kc = sc * 2;               \
    *(bf16x8*)((char*)K_lds + (b) * SHM_K + KSWZ(sr, kc)) = St::tobf(sr_[i].ks0);                       \
    *(bf16x8*)((char*)K_lds + (b) * SHM_K + KSWZ(32 + sr, kc)) = St::tobf(sr_[i].ks1); } while (0)
#define SWAIT() do { if constexpr (SDEPTH == 2) asm volatile("s_waitcnt vmcnt(4)" ::: "memory"); else asm volatile("s_waitcnt vmcnt(0)" ::: "memory"); } while (0)
#define RESC(a) do { if (__any((a) < 1.f)) { if (hi == 0) al_l[r32] = (a); asm volatile("s_waitcnt lgkmcnt(0)" ::: "memory"); \
    for (int d = 0; d < 4; ++d) for (int r = 0; r < 16; ++r) o[d][r] *= al_l[crow(r, hi)]; } } while (0)
  f32x16 pA0, pA1, pB0, pB1; float mnA, mnB, alA, alB; bf16x8 pa0, pa1, pa2, pa3; const int NT = seq / KVBLK;
  constexpr int SE = 0, SO = SDEPTH - 1;
  SLOAD(SE, 0); asm volatile("s_waitcnt vmcnt(0)" ::: "memory"); SWRITE(0, SE); __syncthreads();
  qkt(pA0, pA1, K_lds, qr, r32, hi); partialSM(pA0, pA1, m_reg, mnA, alA);
  SLOAD(SO, KVBLK); if constexpr (SDEPTH == 2) { if (2 < NT) SLOAD(SE, 2 * KVBLK); }
  SWAIT(); SWRITE(1, SO); __syncthreads();
  for (int j = 1; j + 1 < NT; j += 2) {
    SBAR(); qkt(pB0, pB1, (bf16*)((char*)K_lds + SHM_K), qr, r32, hi);
    finishSM(pA0, pA1, alA, l_reg, pa0, pa1, pa2, pa3); SBAR();
    SLOAD(SO, (j + SDEPTH) * KVBLK); SBAR();
    pv_d0(o, vb0, pa0, pa1, pa2, pa3); partialSM(pB0, pB1, m_reg, mnB, alB);
    __syncthreads(); SWAIT(); SWRITE(0, SE);
    RESC(alB); __syncthreads();
    SBAR(); qkt(pA0, pA1, K_lds, qr, r32, hi);
    finishSM(pB0, pB1, alB, l_reg, pa0, pa1, pa2, pa3); SBAR();
    if (SDEPTH == 1 || j + 3 < NT) SLOAD(SE, (j + 1 + SDEPTH) * KVBLK); SBAR();
    pv_d0(o, vb0 + (int)SHM_V, pa0, pa1, pa2, pa3); partialSM(pA0, pA1, m_reg, mnA, alA);
    __syncthreads(); SWAIT(); SWRITE(1, SO);
    RESC(alA); __syncthreads();
  }
  SBAR(); qkt(pB0, pB1, (bf16*)((char*)K_lds + SHM_K), qr, r32, hi);
  finishSM(pA0, pA1, alA, l_reg, pa0, pa1, pa2, pa3); SBAR();
  pv_d0(o, vb0, pa0, pa1, pa2, pa3); partialSM(pB0, pB1, m_reg, mnB, alB);
  __syncthreads(); RESC(alB);
  finishSM(pB0, pB1, alB, l_reg, pa0, pa1, pa2, pa3); SBAR();
  pv_d0(o, vb0 + (int)SHM_V, pa0, pa1, pa2, pa3);
  if (hi == 0) li_l[r32] = l_reg; asm volatile("s_waitcnt lgkmcnt(0)" ::: "memory");
  float rli[16];
#pragma unroll
  for (int r = 0; r < 16; ++r) rli[r] = __builtin_amdgcn_rcpf(li_l[crow(r, hi)]);
  __syncthreads();
  { bf16* stg = (bf16*)lds + wid * 4096;
#pragma unroll
    for (int r = 0; r < 16; ++r) { const int orow = crow(r, hi);
#pragma unroll
      for (int d0 = 0; d0 < 4; ++d0) stg[orow * 128 + d0 * 32 + r32] = __float2bfloat16(o[d0][r] * rli[r]); }
    asm volatile("s_waitcnt lgkmcnt(0)" ::: "memory");
    bf16* Ow = Ob + (long)(wid * QBLK) * LDO;
#pragma unroll
    for (int i = 0; i < 8; ++i) { const int row = i * 4 + (lane >> 4), ch = lane & 15; const u32x4 v = *(const u32x4*)(stg + row * 128 + ch * 8); *(u32x4*)(Ow + (long)row * LDO + ch * 8) = v; } }
  __syncthreads();
#undef SLOAD
#undef SWRITE
#undef SWAIT
#undef RESC
}
#undef KSWZ
#undef SBAR
}
namespace small_attn {
typedef float f32x4 __attribute__((ext_vector_type(4)));
typedef unsigned u32x4 __attribute__((ext_vector_type(4)));
typedef unsigned short bf16_t;
#define SA_LAS __attribute__((address_space(3)))
__device__ __forceinline__ float bf2f(unsigned short b) { return __uint_as_float((unsigned)b << 16); }
__device__ __forceinline__ unsigned short f2bf(float f) { unsigned u = __float_as_uint(f); return (unsigned short)((u + 0x7fffu + ((u >> 16) & 1u)) >> 16); }
template <int DH, bool FOX>
__device__ __forceinline__ void unit(const bf16_t* Q, const float* Kc, const float* Vc, const bf16_t* Kn, const bf16_t* Vn, const float* dS, bf16_t* O, float qscale, SA_LAS unsigned char* lds) {
    constexpr int DQ = DH / 4, DB = DH / 16, NBC = FOX ? 16 : 2, NB = FOX ? 17 : 2, CP = 512;
    const int tid = threadIdx.x, lane = tid & 63, i = lane & 15, g = lane >> 4; const int wid = __builtin_amdgcn_readfirstlane(tid >> 6);
    float qv[DQ];
    { const bf16_t* qp = Q + (size_t)i * 512 + DQ * g;
#pragma unroll
      for (int c = 0; c < DQ / 8; ++c) { const u32x4 w = *(const u32x4*)(qp + 8 * c);
          qv[8 * c + 0] = __uint_as_float(w.x << 16) * qscale; qv[8 * c + 1] = __uint_as_float(w.x & 0xffff0000u) * qscale; qv[8 * c + 2] = __uint_as_float(w.y << 16) * qscale; qv[8 * c + 3] = __uint_as_float(w.y & 0xffff0000u) * qscale;
          qv[8 * c + 4] = __uint_as_float(w.z << 16) * qscale; qv[8 * c + 5] = __uint_as_float(w.z & 0xffff0000u) * qscale; qv[8 * c + 6] = __uint_as_float(w.w << 16) * qscale; qv[8 * c + 7] = __uint_as_float(w.w & 0xffff0000u) * qscale; } }
    const float dref = FOX ? dS[2063] : 0.f;
    f32x4 s[NB];
    const int kb0 = wid * NBC * 16;
#pragma unroll
    for (int blk = 0; blk < NBC; ++blk) {
        const float* kp = Kc + (size_t)(kb0 + blk * 16 + i) * CP + DQ * g;
        f32x4 a = (f32x4){0.f, 0.f, 0.f, 0.f};
#pragma unroll
        for (int c = 0; c < DQ / 4; ++c) { const f32x4 kv = *(const f32x4*)(kp + 4 * c);
#pragma unroll
            for (int e = 0; e < 4; ++e) a = __builtin_amdgcn_mfma_f32_16x16x4f32(kv[e], qv[4 * c + e], a, 0, 0, 0); }
        if (FOX) { const f32x4 bv = *(const f32x4*)(dS + kb0 + blk * 16 + 4 * g); a = a + (bv - dref); }
        s[blk] = a;
    }
    if constexpr (FOX) {
        f32x4 a = (f32x4){0.f, 0.f, 0.f, 0.f};
        if (wid == 7) {
            const bf16_t* kp = Kn + (size_t)i * 512 + DQ * g;
#pragma unroll
            for (int c = 0; c < DQ / 8; ++c) { const u32x4 w = *(const u32x4*)(kp + 8 * c);
                const float kf[8] = {__uint_as_float(w.x << 16), __uint_as_float(w.x & 0xffff0000u), __uint_as_float(w.y << 16), __uint_as_float(w.y & 0xffff0000u),
                                     __uint_as_float(w.z << 16), __uint_as_float(w.z & 0xffff0000u), __uint_as_float(w.w << 16), __uint_as_float(w.w & 0xffff0000u)};
#pragma unroll
                for (int e = 0; e < 8; ++e) a = __builtin_amdgcn_mfma_f32_16x16x4f32(kf[e], qv[8 * c + e], a, 0, 0, 0); }
            const f32x4 bv = *(const f32x4*)(dS + 2048 + 4 * g); a = a + (bv - dref);
#pragma unroll
            for (int r = 0; r < 4; ++r) if (4 * g + r > i) a[r] = -INFINITY;
        } else { a = (f32x4){-INFINITY, -INFINITY, -INFINITY, -INFINITY}; }
        s[NB - 1] = a;
    }
    float mx = -INFINITY;
#pragma unroll
    for (int blk = 0; blk < NB; ++blk) mx = fmaxf(fmaxf(mx, fmaxf(s[blk][0], s[blk][1])), fmaxf(s[blk][2], s[blk][3]));
    mx = fmaxf(mx, __shfl_xor(mx, 16)); mx = fmaxf(mx, __shfl_xor(mx, 32));
    float ls = 0.f;
#pragma unroll
    for (int blk = 0; blk < NB; ++blk)
#pragma unroll
        for (int r = 0; r < 4; ++r) { const float p = __builtin_amdgcn_exp2f(s[blk][r] - mx); s[blk][r] = p; ls += p; }
    ls += __shfl_xor(ls, 16); ls += __shfl_xor(ls, 32);
    f32x4 oacc[DB];
#pragma unroll
    for (int db = 0; db < DB; ++db) oacc[db] = (f32x4){0.f, 0.f, 0.f, 0.f};
#pragma unroll
    for (int blk = 0; blk < NBC; ++blk)
#pragma unroll
        for (int st = 0; st < 4; ++st) { const float* vp = Vc + (size_t)(kb0 + blk * 16 + 4 * g + st) * CP + DB * i;
#pragma unroll
            for (int c = 0; c < DB / 4; ++c) { const f32x4 vv = *(const f32x4*)(vp + 4 * c);
#pragma unroll
                for (int e = 0; e < 4; ++e) oacc[4 * c + e] = __builtin_amdgcn_mfma_f32_16x16x4f32(s[blk][st], vv[e], oacc[4 * c + e], 0, 0, 0); } }
    if constexpr (FOX) { if (wid == 7) {
#pragma unroll
        for (int st = 0; st < 4; ++st) { const bf16_t* vp = Vn + (size_t)(4 * g + st) * 512 + DB * i;
            const unsigned long long w = *(const unsigned long long*)vp;
            const float vf[4] = {__uint_as_float((unsigned)(w << 16) & 0xffff0000u), __uint_as_float((unsigned)w & 0xffff0000u), __uint_as_float((unsigned)(w >> 16) & 0xffff0000u), __uint_as_float((unsigned)(w >> 32) & 0xffff0000u)};
#pragma unroll
            for (int e = 0; e < 4; ++e) oacc[e] = __builtin_amdgcn_mfma_f32_16x16x4f32(s[NB - 1][st], vf[e], oacc[e], 0, 0, 0); } } }
    SA_LAS float* Ml = (SA_LAS float*)lds; SA_LAS float* Ll = Ml + 128; SA_LAS float* Ol = Ll + 128;
    if (g == 0) { Ml[wid * 16 + i] = mx; Ll[wid * 16 + i] = ls; }
#pragma unroll
    for (int r = 0; r < 4; ++r)
#pragma unroll
        for (int c = 0; c < DB / 4; ++c) *(SA_LAS f32x4*)(Ol + (size_t)(wid * 16 + 4 * g + r) * DH + DB * i + 4 * c) = (f32x4){oacc[4 * c + 0][r], oacc[4 * c + 1][r], oacc[4 * c + 2][r], oacc[4 * c + 3][r]};
    __syncthreads();
    for (int e = tid; e < 16 * DH; e += 512) { const int q = e / DH, d = e % DH;
        float M = Ml[q];
#pragma unroll
        for (int w = 1; w < 8; ++w) M = fmaxf(M, Ml[w * 16 + q]);
        float num = 0.f, den = 0.f;
#pragma unroll
        for (int w = 0; w < 8; ++w) { const float f = __builtin_amdgcn_exp2f(Ml[w * 16 + q] - M); num += f * Ol[(size_t)(w * 16 + q) * DH + d]; den += f * Ll[w * 16 + q]; }
        O[(size_t)q * 1536 + d] = f2bf(num / den); }
    __syncthreads();
}
#undef SA_LAS
}
constexpr int NWAVES = 8;
constexpr int DM = 1024, FF = 4096, TOKP = 32768, TOKS = 256, TOK = TOKP + TOKS, NMEMROWS = 2048, NIN = 5632;
constexpr float EPS = 1e-6f;
constexpr size_t MiB = 1u << 20;
constexpr size_t WS_CTL = 0, CTL_ZERO_BYTES = 1 * MiB;
constexpr size_t WS_W1T = 1 * MiB;
constexpr size_t WS_WMT = 14 * MiB;
constexpr size_t WS_WOT = 17 * MiB;
constexpr size_t WS_WUT = 19 * MiB;
constexpr size_t WS_WDT = 27 * MiB;
constexpr size_t WS_DP = 35 * MiB;
constexpr size_t WS_DS = 36 * MiB;
constexpr size_t WS_Q = 40 * MiB, ACT512 = (size_t)TOK * 512 * 2;
constexpr size_t WS_K = WS_Q + ACT512, WS_V = WS_K + ACT512, WS_U = WS_V + ACT512, WS_QM = WS_U + ACT512;
constexpr size_t WS_MK = 202 * MiB, WS_MV = 204 * MiB;
constexpr size_t WS_G = 206 * MiB;
constexpr size_t WS_AM = 400 * MiB;
constexpr size_t WS_END = 497 * MiB;
constexpr size_t WS_MM = WS_Q;
constexpr size_t WS_HB = WS_V;
constexpr size_t WS_A2 = WS_G;
static_assert(WS_QM + ACT512 <= WS_MK && WS_G + (size_t)TOK * 3072 * 2 <= WS_AM && WS_AM + (size_t)TOK * 1536 * 2 <= WS_END && WS_A2 + (size_t)TOK * 4096 * 2 <= WS_END, "d_ws map");
static_assert(WS_MM + (size_t)TOK * 2048 <= WS_V && WS_HB + (size_t)TOK * 2048 <= WS_QM && WS_DS + 128 * 2064 * 4 <= WS_Q, "d_ws overlays");
constexpr int CW_BAR = 4096, CW_SSQ1 = 65536, CW_SSQ2 = 131072;
static_assert((CW_SSQ2 + TOK) * 4 <= (int)CTL_ZERO_BYTES, "CTL words inside the memset region");
constexpr int RING_OFF = 0, RING_BYTES = 131072, LDSCTL_OFF = RING_BYTES, MISC_OFF = LDSCTL_OFF + 320, LDS_BYTES = 147456;

#define GAS __attribute__((address_space(1)))
#define LAS __attribute__((address_space(3)))
typedef unsigned short bf16;
typedef unsigned v4u __attribute__((ext_vector_type(4)));
typedef float f32x4 __attribute__((ext_vector_type(4)));
typedef short bf16x8 __attribute__((ext_vector_type(8)));
typedef GAS unsigned gu32;
typedef GAS unsigned long long gu64;
#define RLX_AGENT __ATOMIC_RELAXED, __HIP_MEMORY_SCOPE_AGENT
#define LDS_WAIT() asm volatile("s_waitcnt lgkmcnt(0)" ::: "memory")
#define VM_WAIT() asm volatile("s_waitcnt vmcnt(0)" ::: "memory")
__device__ __forceinline__ unsigned long long rt() { return __builtin_amdgcn_s_memrealtime(); }
__device__ __forceinline__ unsigned f2bf(float f) { unsigned u = __builtin_bit_cast(unsigned, f); return (u + 0x7fffu + ((u >> 16) & 1u)) >> 16; }
__device__ __forceinline__ unsigned pk2(float lo, float hi) { return f2bf(lo) | (f2bf(hi) << 16); }

#define XB_TMO      128
#define XB_XCNT(j)  (256  + 64 * (j))
#define XB_XSUB(j)  (1280 + 64 * (j))
#define XB_XGEN(j)  (2304 + 64 * (j))
#define XB_TOP      3328
#define XB_TOPGEN   3392
#define XCD_BAR_WORDS 3456
#define XB_SPIN_CAP (1u << 18)

__device__ __forceinline__ unsigned xb_ld(unsigned* p)              { return __hip_atomic_load(p, __ATOMIC_RELAXED, __HIP_MEMORY_SCOPE_AGENT); }
__device__ __forceinline__ unsigned xb_add(unsigned* p, unsigned v) { return __hip_atomic_fetch_add(p, v, __ATOMIC_RELAXED, __HIP_MEMORY_SCOPE_AGENT); }
__device__ __forceinline__ unsigned xb_xcc_id() { return (unsigned)__builtin_amdgcn_s_getreg((3 << 11) | 20) & 0xFu; }
#define XB_SPIN(cond, bar) do { unsigned _sp = 0; while (cond) { __builtin_amdgcn_s_sleep(1); \
    if ((++_sp & 255u) == 0u) { if (xb_ld(&(bar)[XB_TMO])) break; if (_sp > XB_SPIN_CAP) { atomicAdd(&(bar)[XB_TMO], 1u); break; } } } } while (0)

struct XcdBarrier {
    unsigned* bar; unsigned x;
    volatile LAS unsigned* st;
};

__device__ __forceinline__ XcdBarrier xcd_barrier_post(unsigned* bar, volatile LAS unsigned* st) {
    XcdBarrier b; b.bar = bar; b.x = xb_xcc_id(); b.st = st;
    if (threadIdx.x == 0) (void)xb_add(&bar[XB_XCNT(b.x)], 1u);
    return b;
}
__device__ __forceinline__ void xcd_barrier_complete(unsigned* bar, unsigned x, unsigned& nloc, unsigned& nx) {
    const unsigned G = gridDim.x * gridDim.y * gridDim.z;
    unsigned sum, cnt, mine, sp = 0u;
    for (;;) {
        sum = 0u; cnt = 0u; mine = 0u;
#pragma unroll
        for (unsigned j = 0; j < 16; ++j) { const unsigned c = xb_ld(&bar[XB_XCNT(j)]); sum += c; cnt += (c > 0u) ? 1u : 0u; mine = (j == x) ? c : mine; }
        if (sum == G) break;
        __builtin_amdgcn_s_sleep(1);
        if ((++sp & 255u) == 0u) { if (xb_ld(&bar[XB_TMO])) break; if (sp > XB_SPIN_CAP) { atomicAdd(&bar[XB_TMO], 1u); break; } }
    }
    nloc = mine > 0u ? mine : 1u; nx = cnt > 0u ? cnt : 1u;
}

__device__ __forceinline__ void xcd_barrier(const XcdBarrier& b) {
    asm volatile("s_waitcnt vmcnt(0)" ::: "memory");
    __syncthreads();
    if (threadIdx.x == 0) {
        unsigned* bar = b.bar;
        __builtin_amdgcn_s_waitcnt(0);
        unsigned nloc = b.st[0], nx = b.st[1];
        if (nloc == 0u) { xcd_barrier_complete(bar, b.x, nloc, nx); b.st[0] = nloc; b.st[1] = nx; }
        const unsigned old = xb_add(&bar[XB_XSUB(b.x)], 1u);
        const unsigned gen = old / nloc;
        if (old + 1u == (gen + 1u) * nloc) {
            __builtin_amdgcn_fence(__ATOMIC_RELEASE, "agent");
            asm volatile("s_waitcnt vmcnt(0)" ::: "memory");
            const unsigned og = xb_add(&bar[XB_TOP], 1u);
            const unsigned tg = og / nx;
            if (og + 1u == (tg + 1u) * nx) xb_add(&bar[XB_TOPGEN], 1u);
            else XB_SPIN(xb_ld(&bar[XB_TOPGEN]) == tg, bar);
            __builtin_amdgcn_fence(__ATOMIC_ACQUIRE, "agent");
            xb_add(&bar[XB_XGEN(b.x)], 1u);
            asm volatile("s_waitcnt vmcnt(0)" ::: "memory");
        } else {
            XB_SPIN(xb_ld(&bar[XB_XGEN(b.x)]) == gen, bar);
            __builtin_amdgcn_fence(__ATOMIC_ACQUIRE, "agent");
            asm volatile("s_waitcnt vmcnt(0)" ::: "memory");
        }
    }
    __syncthreads();
}
__device__ __forceinline__ float bf2f(unsigned short b);
__device__ __forceinline__ float bf2f(unsigned short b) { return __uint_as_float((unsigned)b << 16); }
__device__ __forceinline__ float wave_sum(float v) {
#pragma unroll
    for (int o = 1; o < 64; o <<= 1) v += __shfl_xor(v, o);
    return v;
}
__device__ __forceinline__ void p0_transpose_item(const float* W, int src_pitch, int src_col, int k0, bf16* WT, int dst_pitch, int dst_row, int dst_k0, const float* kscale, LAS float* scr, int lane) {
#pragma unroll 8
    for (int i = 0; i < 32; ++i) { const int kk = 2 * i + (lane >> 5); float v = W[(size_t)(k0 + kk) * src_pitch + src_col + (lane & 31)]; if (kscale) v *= kscale[k0 + kk]; scr[kk * 33 + (lane & 31)] = v; }
    LDS_WAIT(); asm volatile("" ::: "memory");
    const int c = lane & 7;
#pragma unroll
    for (int j = 0; j < 4; ++j) { const int n = (lane >> 3) + 8 * j; const LAS float* s = scr + (8 * c) * 33 + n;
        v4u o; o.x = pk2(s[0 * 33], s[1 * 33]); o.y = pk2(s[2 * 33], s[3 * 33]); o.z = pk2(s[4 * 33], s[5 * 33]); o.w = pk2(s[6 * 33], s[7 * 33]);
        *(GAS v4u*)(WT + (size_t)(dst_row + n) * dst_pitch + dst_k0 + k0 + 8 * c) = o; }
    LDS_WAIT(); asm volatile("" ::: "memory");
}
__device__ __forceinline__ void p0_weff_item(int id, const float* w_pool, const float* s_pool, const float* w_br_pool, bf16* WMT, int lane) {
    const int g = id >> 8, cb = (id >> 4) & 15, nb = id & 15, n = nb * 64 + lane;
    float acc[8];
#pragma unroll
    for (int i = 0; i < 8; ++i) acc[i] = 0.f;
    const float* wp = w_pool + (size_t)(g * 128 + cb * 8) * 128;
#pragma unroll 4
    for (int d = 0; d < 128; ++d) { const float w = w_br_pool[(size_t)(g * 128 + d) * 1024 + n] * s_pool[g * 128 + d];
#pragma unroll
        for (int i = 0; i < 8; ++i) acc[i] = fmaf(wp[i * 128 + d], w, acc[i]); }
    v4u o; o.x = pk2(acc[0], acc[1]); o.y = pk2(acc[2], acc[3]); o.z = pk2(acc[4], acc[5]); o.w = pk2(acc[6], acc[7]);
    *(GAS v4u*)(WMT + (size_t)n * 1536 + 512 + g * 128 + cb * 8) = o;
}
__device__ __forceinline__ void p0_token_rows(const float* xp, const float* xs, const float* g_attn, const float* w_in, const float* b_f, bf16* XN, float* out, int gw, int NGW, int lane) {
    f32x4 wfa[16], wfb[16], gv[4];
#pragma unroll
    for (int j = 0; j < 4; ++j) { gv[j] = *(const GAS f32x4*)(g_attn + 256 * j + 4 * lane);
#pragma unroll
        for (int e = 0; e < 4; ++e) { const float* p = w_in + (size_t)(256 * j + 4 * lane + e) * 5640 + 1536; wfa[j * 4 + e] = *(const GAS f32x4*)p; wfb[j * 4 + e] = *(const GAS f32x4*)(p + 4); } }
    const float bf = b_f[lane & 7];
    for (int m = gw; m < TOK; m += NGW) {
        const float* xr = m < TOKP ? xp + (size_t)m * DM : xs + (size_t)(m - TOKP) * DM;
        f32x4 v[4]; float ss = 0.f;
#pragma unroll
        for (int j = 0; j < 4; ++j) { v[j] = *(const GAS f32x4*)(xr + 256 * j + 4 * lane); ss += (v[j].x * v[j].x + v[j].y * v[j].y) + (v[j].z * v[j].z + v[j].w * v[j].w); }
        const float rstd = 1.0f / sqrtf(wave_sum(ss) * (1.0f / DM) + EPS);
        f32x4 fa = (f32x4){0.f, 0.f, 0.f, 0.f}, fb = (f32x4){0.f, 0.f, 0.f, 0.f};
        GAS unsigned long long* o8 = (GAS unsigned long long*)(XN + (size_t)m * DM) + lane;
#pragma unroll
        for (int j = 0; j < 4; ++j) { v[j] = v[j] * rstd * gv[j];
            o8[64 * j] = (unsigned long long)pk2(v[j].x, v[j].y) | ((unsigned long long)pk2(v[j].z, v[j].w) << 32);
#pragma unroll
            for (int e = 0; e < 4; ++e) { fa += wfa[j * 4 + e] * v[j][e]; fb += wfb[j * 4 + e] * v[j][e]; } }
        float f[8];
#pragma unroll
        for (int i = 0; i < 4; ++i) { f[i] = wave_sum(fa[i]); f[4 + i] = wave_sum(fb[i]); }
        if (lane < 8) { float fz = f[0];
#pragma unroll
            for (int i = 1; i < 8; ++i) fz = lane == i ? f[i] : fz;
            const float z = fz + bf;
            const float lf = z >= 0.f ? -log1pf(expf(-z)) : z - log1pf(expf(z));
            out[(m < TOKP ? pg8::O_LFP + (size_t)m * 8 : pg8::O_LFS + (size_t)(m - TOKP) * 8) + lane] = lf; }
    }
}
__device__ __forceinline__ void p0_mem_rows(const float* mem, const float* g_mem, bf16* MEMN, int gw, int NGW, int lane) {
    f32x4 gv[4];
#pragma unroll
    for (int j = 0; j < 4; ++j) gv[j] = *(const GAS f32x4*)(g_mem + 256 * j + 4 * lane);
    for (int m = gw; m < NMEMROWS; m += NGW) {
        const float* xr = mem + (size_t)m * DM; f32x4 v[4]; float ss = 0.f;
#pragma unroll
        for (int j = 0; j < 4; ++j) { v[j] = *(const GAS f32x4*)(xr + 256 * j + 4 * lane); ss += (v[j].x * v[j].x + v[j].y * v[j].y) + (v[j].z * v[j].z + v[j].w * v[j].w); }
        const float rstd = 1.0f / sqrtf(wave_sum(ss) * (1.0f / DM) + EPS);
        GAS unsigned long long* o8 = (GAS unsigned long long*)(MEMN + (size_t)m * DM) + lane;
#pragma unroll
        for (int j = 0; j < 4; ++j) { v[j] = v[j] * rstd * gv[j]; o8[64 * j] = (unsigned long long)pk2(v[j].x, v[j].y) | ((unsigned long long)pk2(v[j].z, v[j].w) << 32); }
    }
}
__device__ __forceinline__ void p1_cumsum(int seq, const float* out, const float* cache_logf, float* DP, float* DS, LAS unsigned char* lds, int tid) {
    const bool samp = seq >= 64; const int sidx = samp ? seq - 64 : seq, b = sidx >> 3, h = sidx & 7, L = samp ? 2064 : 4096, per = samp ? 5 : 8;
    const int lane = tid & 63, wv = tid >> 6;
    double loc[8]; double run = 0.0;
#pragma unroll
    for (int e = 0; e < 8; ++e) { loc[e] = 0.0; if (e < per) { const int idx = tid * per + e; float v = 0.f;
        if (idx < L) v = samp ? (idx < 2048 ? cache_logf[(size_t)(b * 2048 + idx) * 8 + h] : out[pg8::O_LFS + (size_t)(b * 16 + idx - 2048) * 8 + h]) : out[pg8::O_LFP + (size_t)(b * 4096 + idx) * 8 + h];
        run += (double)v; loc[e] = run; } }
    double incl = run;
#pragma unroll
    for (int o = 1; o < 64; o <<= 1) { const double t = __shfl_up(incl, o); if (lane >= o) incl += t; }
    LAS double* wt = (LAS double*)lds;
    if (lane == 63) wt[wv] = incl;
    __syncthreads();
    double base = incl - run;
#pragma unroll
    for (int w = 0; w < 8; ++w) if (w < wv) base += wt[w];
    float* D = samp ? DS + (size_t)sidx * 2064 : DP + (size_t)sidx * 4096;
#pragma unroll
    for (int e = 0; e < 8; ++e) if (e < per) { const int idx = tid * per + e; if (idx < L) D[idx] = (float)(-(base + loc[e]) * 1.4426950408889634); }
    __syncthreads();
}
__device__ __forceinline__ void p2_pool_item(int it, const bf16* U, const float* cache_pool, bf16* AM, int tid) {
    const int cc = tid & 63, tg = tid >> 6, g = cc >> 4, w = 2 << g, col = cc * 8;
    for (int tt = 0; tt < 8; ++tt) {
        const int m = it * 64 + tg * 8 + tt; const bool samp = m >= TOKP;
        const int rs = m - TOKP, b = rs >> 4, t = samp ? (rs & 15) : (m & 4095);
        float acc[8], ut[8];
#pragma unroll
        for (int i = 0; i < 8; ++i) { acc[i] = 0.f; ut[i] = 0.f; }
        for (int j = 0; j < 16; ++j) { if (j < w) { const int tj = t - j;
            if (tj >= 0) { const v4u x = *(const GAS v4u*)(U + (size_t)(m - j) * 512 + col);
                const float xv[8] = {__uint_as_float(x.x << 16), __uint_as_float(x.x & 0xffff0000u), __uint_as_float(x.y << 16), __uint_as_float(x.y & 0xffff0000u),
                                     __uint_as_float(x.z << 16), __uint_as_float(x.z & 0xffff0000u), __uint_as_float(x.w << 16), __uint_as_float(x.w & 0xffff0000u)};
#pragma unroll
                for (int i = 0; i < 8; ++i) { acc[i] += xv[i]; if (j == 0) ut[i] = xv[i]; } }
            else if (samp) { const float* cp = cache_pool + (size_t)(b * 15 + 15 + tj) * 512 + col; const f32x4 c0 = *(const GAS f32x4*)cp, c1 = *(const GAS f32x4*)(cp + 4);
#pragma unroll
                for (int i = 0; i < 4; ++i) { acc[i] += c0[i]; acc[4 + i] += c1[i]; } } } }
        const int cnt = samp ? w : (w < t + 1 ? w : t + 1); const float rc = 1.0f / (float)cnt;
        v4u o; o.x = pk2(acc[0] * rc - ut[0], acc[1] * rc - ut[1]); o.y = pk2(acc[2] * rc - ut[2], acc[3] * rc - ut[3]); o.z = pk2(acc[4] * rc - ut[4], acc[5] * rc - ut[5]); o.w = pk2(acc[6] * rc - ut[6], acc[7] * rc - ut[7]);
        *(GAS v4u*)(AM + (size_t)m * 1536 + 512 + col) = o;
    }
}
__device__ __forceinline__ void p7_final(float* Y, const float* ssq, const float* g_final, int gw, int NGW, int lane) {
    f32x4 gv[4];
#pragma unroll
    for (int j = 0; j < 4; ++j) gv[j] = *(const GAS f32x4*)(g_final + 256 * j + 4 * lane);
    for (int m = gw; m < TOK; m += NGW) {
        const float rs = 1.0f / sqrtf(__hip_atomic_load(ssq + m, __ATOMIC_RELAXED, __HIP_MEMORY_SCOPE_AGENT) * (1.0f / DM) + EPS);
        GAS f32x4* yr = (GAS f32x4*)(Y + (size_t)m * DM) + lane;
#pragma unroll
        for (int j = 0; j < 4; ++j) { const f32x4 v = yr[64 * j]; yr[64 * j] = v * rs * gv[j]; }
    }
}

struct Args { const float* in[24]; float* out; unsigned char* ws; };
__global__ void __launch_bounds__(NWAVES * 64, 2) fwd_megakernel(Args args) {
    extern __shared__ __attribute__((aligned(16))) unsigned char lds[];
    LAS unsigned char* L = (LAS unsigned char*)lds;
    volatile LAS unsigned* MISC = (volatile LAS unsigned*)(L + MISC_OFF);
    const int tid = threadIdx.x, lane = tid & 63, wave = __builtin_amdgcn_readfirstlane(tid >> 6);
    const int G = gridDim.x, bx = blockIdx.x, vcu = (G % 8 == 0) ? (bx % 8) * (G / 8) + bx / 8 : bx;
    volatile LAS unsigned* PT = (volatile LAS unsigned*)(L + LDSCTL_OFF);
#define PTRI(i) ((const float*)(const GAS float*)(((unsigned long long)(unsigned)__builtin_amdgcn_readfirstlane((int)PT[2 * (i) + 1]) << 32) | (unsigned long long)(unsigned)__builtin_amdgcn_readfirstlane((int)PT[2 * (i)])))
#define OUTP ((float*)PTRI(24))
#define WSP ((unsigned char*)PTRI(25))
    for (int u = tid; u < (LDS_BYTES - LDSCTL_OFF) / 4; u += NWAVES * 64) ((LAS unsigned*)(L + LDSCTL_OFF))[u] = 0u;
    __syncthreads();
    if (tid == 0) {
#define PUT(i, p) do { const unsigned long long v_ = (unsigned long long)(uintptr_t)(p); PT[2 * (i)] = (unsigned)v_; PT[2 * (i) + 1] = (unsigned)(v_ >> 32); } while (0)
        PUT(0, args.in[0]); PUT(1, args.in[1]); PUT(2, args.in[2]); PUT(3, args.in[3]); PUT(4, args.in[4]); PUT(5, args.in[5]); PUT(6, args.in[6]); PUT(7, args.in[7]);
        PUT(8, args.in[8]); PUT(9, args.in[9]); PUT(10, args.in[10]); PUT(11, args.in[11]); PUT(12, args.in[12]); PUT(13, args.in[13]); PUT(14, args.in[14]); PUT(15, args.in[15]);
        PUT(16, args.in[16]); PUT(17, args.in[17]); PUT(18, args.in[18]); PUT(19, args.in[19]); PUT(20, args.in[20]); PUT(21, args.in[21]); PUT(22, args.in[22]); PUT(23, args.in[23]);
        PUT(24, args.out); PUT(25, args.ws);
#undef PUT
    }
    __syncthreads();
    XcdBarrier bar = xcd_barrier_post((unsigned*)(WSP + WS_CTL) + CW_BAR, MISC + 8);
    const int gw = vcu * NWAVES + wave, NGW = G * NWAVES;

    {
        LAS float* scr = (LAS float*)(L + RING_OFF + wave * 16384);
        unsigned char* ws = WSP; float* out = OUTP;
        bf16* XN = (bf16*)out; bf16* MEMN = XN + (size_t)TOK * DM;
        bf16 *W1T = (bf16*)(ws + WS_W1T), *WMT = (bf16*)(ws + WS_WMT), *WOT = (bf16*)(ws + WS_WOT), *WUT = (bf16*)(ws + WS_WUT), *WDT = (bf16*)(ws + WS_WDT);
        const float *w_in = PTRI(10), *w_mkv = PTRI(15), *w_bf = PTRI(16), *w_bp = PTRI(17), *w_bm = PTRI(18), *w_out = PTRI(19), *w_up = PTRI(21), *w_down = PTRI(22), *g_mlp = PTRI(20), *w_pool = PTRI(12), *s_pool = PTRI(13);
        constexpr int I_IN = 16 * 176, I_MKV = 16 * 32, I_BF = 8 * 32, I_OUT = 16 * 32, I_UP = 16 * 128, I_DN = 64 * 32, I_WE = 1024;
        constexpr int NITEMS = I_IN + I_MKV + 2 * I_BF + I_OUT + I_UP + I_DN + I_WE;
        for (int it = gw; it < NITEMS; it += NGW) {
            int r = it;
            if (r < I_IN) { const int kb = r / 176, nb = r % 176, n0 = nb * 32; p0_transpose_item(w_in, 5640, n0 + (n0 >= 1536 ? 8 : 0), kb * 64, W1T, 1024, n0, 0, nullptr, scr, lane); continue; } r -= I_IN;
            if (r < I_MKV) { const int kb = r / 32, nb = r % 32; p0_transpose_item(w_mkv, 1024, nb * 32, kb * 64, W1T, 1024, NIN + nb * 32, 0, nullptr, scr, lane); continue; } r -= I_MKV;
            if (r < I_BF) { const int kb = r / 32, nb = r % 32; p0_transpose_item(w_bf, 1024, nb * 32, kb * 64, WMT, 1536, nb * 32, 0, nullptr, scr, lane); continue; } r -= I_BF;
            if (r < I_BF) { const int kb = r / 32, nb = r % 32; p0_transpose_item(w_bm, 1024, nb * 32, kb * 64, WMT, 1536, nb * 32, 1024, nullptr, scr, lane); continue; } r -= I_BF;
            if (r < I_OUT) { const int kb = r / 32, nb = r % 32; p0_transpose_item(w_out, 1024, nb * 32, kb * 64, WOT, 1024, nb * 32, 0, nullptr, scr, lane); continue; } r -= I_OUT;
            if (r < I_UP) { const int kb = r / 128, nb = r % 128; p0_transpose_item(w_up, 4096, nb * 32, kb * 64, WUT, 1024, nb * 32, 0, g_mlp, scr, lane); continue; } r -= I_UP;
            if (r < I_DN) { const int kb = r / 32, nb = r % 32; p0_transpose_item(w_down, 1024, nb * 32, kb * 64, WDT, 4096, nb * 32, 0, nullptr, scr, lane); continue; } r -= I_DN;
            p0_weff_item(r, w_pool, s_pool, w_bp, WMT, lane);
        }
        p0_mem_rows(PTRI(2), PTRI(14), MEMN, gw, NGW, lane);
        p0_token_rows(PTRI(0), PTRI(1), PTRI(9), w_in, PTRI(11), XN, out, gw, NGW, lane);
    }
    xcd_barrier(bar);

    {
        unsigned char* ws = WSP; float* out = OUTP;
        bf16* XN = (bf16*)out; bf16* MEMN = XN + (size_t)TOK * DM; bf16* W1T = (bf16*)(ws + WS_W1T);
        for (int s = bx; s < 192; s += G) p1_cumsum(s, out, PTRI(5), (float*)(ws + WS_DP), (float*)(ws + WS_DS), L, tid);
        { pg8::Gemm g{XN, W1T, TOK, NIN, DM}; pg8::StaticOrder S; S.init(TOK, NIN, G, bx);
          pg8::EpiInProj E{(bf16*)(ws + WS_Q), (bf16*)(ws + WS_K), (bf16*)(ws + WS_V), (bf16*)(ws + WS_U), (bf16*)(ws + WS_QM), (bf16*)(ws + WS_G), out};
          pg8::gemm_phase<pg8::EpiInProj, pg8::StaticOrder, true, true>(L + RING_OFF, g, S, E); }
        { pg8::Gemm g{MEMN, W1T + (size_t)NIN * DM, NMEMROWS, 1024, DM}; pg8::StaticOrder S; S.init(NMEMROWS, 1024, G, (bx + G - 22 % G) % G);
          pg8::EpiMemKV E{(bf16*)(ws + WS_MK), (bf16*)(ws + WS_MV), out};
          pg8::gemm_phase<pg8::EpiMemKV, pg8::StaticOrder, true, true>(L + RING_OFF, g, S, E); }
    }
    xcd_barrier(bar);

    {
        unsigned char* ws = WSP;
        bf16 *Qb = (bf16*)(ws + WS_Q), *Kb = (bf16*)(ws + WS_K), *Vb = (bf16*)(ws + WS_V), *QMb = (bf16*)(ws + WS_QM), *AM = (bf16*)(ws + WS_AM);
        for (int v = vcu; v < 192; v += G) {
            if (v < 128) { const int b = v >> 3, h = v & 7; const size_t r0 = (size_t)(TOKP + b * 16);
                small_attn::unit<64, true>(Qb + r0 * 512 + h * 64, PTRI(3) + ((size_t)b * 2048 * 8 + h) * 64, PTRI(4) + ((size_t)b * 2048 * 8 + h) * 64, Kb + r0 * 512 + h * 64, Vb + r0 * 512 + h * 64,
                                           (const float*)(ws + WS_DS) + (size_t)v * 2064, AM + r0 * 1536 + h * 64, 1.0f, L + RING_OFF); }
            else { const int u = v - 128, b = u >> 2, h = u & 3; const size_t r0 = (size_t)(TOKP + b * 16);
                small_attn::unit<128, false>(QMb + r0 * 512 + h * 128, PTRI(7) + ((size_t)b * 256 * 4 + h) * 128, PTRI(8) + ((size_t)b * 256 * 4 + h) * 128, nullptr, nullptr,
                                             nullptr, AM + r0 * 1536 + 1024 + h * 128, 0.08838834764831845f * 1.4426950408889634f, L + RING_OFF); }
        }
        for (int it = vcu; it < TOK / 64; it += G) p2_pool_item(it, (const bf16*)(ws + WS_U), PTRI(6), AM, tid);
        for (int id = 2 * vcu; id < 512; id += 2 * G)
            for (int k = 0; k < 2; ++k) { const int u = id + k, bh = u >> 4, qblk = u & 15, b = bh >> 2, h = bh & 3; const size_t r0 = (size_t)b * 4096 + qblk * 256;
                dense_body::attn_dense_body<dense_body::bf16>((const dense_body::bf16*)(QMb + r0 * 512 + h * 128), (const dense_body::bf16*)((bf16*)(ws + WS_MK) + (size_t)b * 256 * 512 + h * 128),
                                                              (const dense_body::bf16*)((bf16*)(ws + WS_MV) + (size_t)b * 256 * 512 + h * 128), (dense_body::bf16*)(AM + r0 * 1536 + 1024 + h * 128), 256, (char*)lds + RING_OFF); }
        for (int v = vcu; v < 256; v += G) { const int p = v >> 2, j = v & 3, b = p >> 3, h = p & 7;
            for (int k = 0; k < 4; ++k) { const int qb = k == 0 ? 15 - j : k == 1 ? 8 + j : k == 2 ? 7 - j : j;
                attn_body::attn_unit<8>(b, h, qb, 0, (const attn_body::bf16*)Qb, (const attn_body::bf16*)Kb, (const attn_body::bf16*)Vb, (attn_body::bf16*)AM, (const float*)(ws + WS_DP) + (size_t)p * 4096, (char*)lds + RING_OFF); } }
    }
    xcd_barrier(bar);
#ifdef DIAG
    diag_p2(WSP, OUTP, PTRI(3), PTRI(4), PTRI(7), PTRI(8), PTRI(6), (gu32*)(WSP + WS_CTL), gw, NGW, lane);
    xcd_barrier(bar);
#endif

    { unsigned char* ws = WSP; pg8::Gemm g{(bf16*)(ws + WS_AM), (bf16*)(ws + WS_WMT), TOK, DM, 1536}; pg8::StaticOrder S; S.init(TOK, DM, G, bx);
      pg8::EpiMerge E{(bf16*)(ws + WS_G), (bf16*)(ws + WS_MM)};
      pg8::gemm_phase<pg8::EpiMerge, pg8::StaticOrder, true, true>(L + RING_OFF, g, S, E); }
    xcd_barrier(bar);
#ifdef DIAG
    diag_p3(WSP, (gu32*)(WSP + WS_CTL), gw, NGW, lane);
#endif

    { unsigned char* ws = WSP; pg8::Gemm g{(bf16*)(ws + WS_MM), (bf16*)(ws + WS_WOT), TOK, DM, DM}; pg8::StaticOrder S; S.init(TOK, DM, G, bx);
      pg8::EpiWout E{PTRI(0), PTRI(1), OUTP, (bf16*)(ws + WS_HB), (float*)(ws + WS_CTL) + CW_SSQ1};
      pg8::gemm_phase<pg8::EpiWout, pg8::StaticOrder, true, true>(L + RING_OFF, g, S, E); }
    xcd_barrier(bar);
#ifdef DIAG
    diag_p4(WSP, OUTP, PTRI(0), PTRI(1), (gu32*)(WSP + WS_CTL), gw, NGW, lane);
#endif

    { unsigned char* ws = WSP; pg8::Gemm g{(bf16*)(ws + WS_HB), (bf16*)(ws + WS_WUT), TOK, FF, DM}; pg8::StaticOrder S; S.init(TOK, FF, G, bx);
      pg8::EpiUp E{(float*)(ws + WS_CTL) + CW_SSQ1, (bf16*)(ws + WS_A2)};
      pg8::gemm_phase<pg8::EpiUp, pg8::StaticOrder, true, true>(L + RING_OFF, g, S, E); }
    xcd_barrier(bar);
#ifdef DIAG
    diag_p5(WSP, OUTP, PTRI(20), PTRI(21), (gu32*)(WSP + WS_CTL), gw, NGW, lane);
    xcd_barrier(bar);
#endif

    { unsigned char* ws = WSP; pg8::Gemm g{(bf16*)(ws + WS_A2), (bf16*)(ws + WS_WDT), TOK, DM, FF}; pg8::StaticOrder S; S.init(TOK, DM, G, bx);
      pg8::EpiDown E{OUTP, (float*)(ws + WS_CTL) + CW_SSQ2};
      pg8::gemm_phase<pg8::EpiDown, pg8::StaticOrder, true, true>(L + RING_OFF, g, S, E); }
    xcd_barrier(bar);

    p7_final(OUTP, (float*)(WSP + WS_CTL) + CW_SSQ2, PTRI(23), gw, NGW, lane);
#ifdef DIAG
    if (bx == 0) { const unsigned msk = __hip_atomic_load((gu32*)(WSP + WS_CTL) + CW_DIAG, __ATOMIC_RELAXED, __HIP_MEMORY_SCOPE_AGENT);
        const int idx = msk ? __builtin_ctz(msk) + 1 : 0; const float sc = 1.0f + sqrtf(2.0f + 0.5f * (float)idx);
        float* lf = OUTP + pg8::O_LFS; for (int i = tid; i < 2048; i += NWAVES * 64) lf[i] *= sc; }
#endif
}

extern "C" void kernel_launch(void* const* d_in, const int* in_sizes, int n_in, void* d_out, int out_size, void* d_ws, size_t ws_size, hipStream_t stream) {
    static int grid = 0;
    if (grid == 0) {
        if (n_in != 24 || in_sizes[0] != TOKP * DM || (size_t)out_size != pg8::O_END || ws_size < WS_END) {
            fprintf(stderr, "kernel_launch: built for 24 inputs, x_prompt of %d floats, out of %zu floats, >= %zu bytes of workspace; got n_in %d, in0 %d, out %d, ws %zu; nothing launched\n",
                    TOKP * DM, (size_t)pg8::O_END, (size_t)WS_END, n_in, n_in > 0 ? in_sizes[0] : -1, out_size, ws_size); grid = -1; return; }
        int dev = 0, cus = 0, per_cu = 0;
        if (hipGetDevice(&dev) != hipSuccess || hipDeviceGetAttribute(&cus, hipDeviceAttributeMultiprocessorCount, dev) != hipSuccess) { fprintf(stderr, "kernel_launch: hipGetDevice / hipDeviceGetAttribute failed\n"); grid = -1; return; }
        if (hipFuncSetAttribute((const void*)fwd_megakernel, hipFuncAttributeMaxDynamicSharedMemorySize, LDS_BYTES) != hipSuccess) { fprintf(stderr, "kernel_launch: hipFuncSetAttribute failed\n"); grid = -1; return; }
        if (hipOccupancyMaxActiveBlocksPerMultiprocessor(&per_cu, (const void*)fwd_megakernel, NWAVES * 64, LDS_BYTES) != hipSuccess || per_cu < 1) {
            fprintf(stderr, "kernel_launch: occupancy query reports %d workgroups per CU; nothing launched\n", per_cu); (void)hipGetLastError(); grid = -1; return; }
        grid = cus;
        if (grid % 8 != 0) fprintf(stderr, "kernel_launch: note: %d CUs\n", grid);
    }
    if (grid < 0) return;
    if (hipMemsetAsync((char*)d_ws + WS_CTL, 0, CTL_ZERO_BYTES, stream) != hipSuccess) { fprintf(stderr, "kernel_launch: hipMemsetAsync failed\n"); return; }
    Args a{};
    for (int i = 0; i < 24; ++i) a.in[i] = (const float*)d_in[i];
    a.out = (float*)d_out; a.ws = (unsigned char*)d_ws;
    hipLaunchKernelGGL(fwd_megakernel, dim3(grid), dim3(NWAVES * 64), LDS_BYTES, stream, a);
    const hipError_t le = hipPeekAtLastError();
    if (le != hipSuccess) fprintf(stderr, "kernel_launch: launch failed: %s\n", hipGetErrorName(le));
}
```

```cpp
#include <hip/hip_runtime.h>
#include <hip/hip_bf16.h>
#include <cstdio>
#include <cstdint>
#include <cmath>
namespace pg8 {
#define PG8_LAS __attribute__((address_space(3)))
typedef unsigned short bf16_t;
typedef short bf16x8 __attribute__((ext_vector_type(8)));
typedef float f32x4 __attribute__((ext_vector_type(4)));
typedef unsigned u32x4 __attribute__((ext_vector_type(4)));
typedef int i32x4 __attribute__((ext_vector_type(4)));
constexpr int BM = 256, BK = 64, HALF = 128, HTB = HALF * BK * 2  , STAGE_BYTES = 8 * HTB, NXCD = 8, WGM = 8;

__host__ __device__ __forceinline__ int lds_byte(int r, int c) { const int st = (r >> 4) * 2 + (c >> 5), rr = r & 15, cc = c & 31, ob = rr * 64 + cc * 2; return st * 1024 + (ob ^ (((ob >> 9) & 1) << 5)); }
__host__ __device__ __forceinline__ void stage_rc(int b, int& R, int& C) { const int st = b / 1024, sb = b % 1024, swz = sb ^ (((sb >> 9) & 1) << 5); R = (st >> 1) * 16 + swz / 64; C = (st & 1) * 32 + (swz % 64) / 2; }
__host__ __device__ __forceinline__ int perm32(int rho) { const int n = rho >> 4, i = rho & 15; return 8 * (i >> 2) + 4 * n + (i & 3); }

struct Unit { int pm, pn, kc; };
struct Gemm { const bf16_t* A; const bf16_t* Bt; int M, N, K, ld; };

struct StaticOrder {
    int nM, nN, nwg, G, c;
    __host__ __device__ void init(int M, int N, int G_, int c_) { nM = M / BM; nN = N / BM; nwg = nM * nN; G = G_; c = c_; }
    __host__ __device__ bool next(int i, Unit& u) const {
        const long L = (long)i * G + c; if (L >= nwg) return false;
        int wgid = (int)L; { const int q = nwg / NXCD, r = nwg % NXCD, xcd = wgid % NXCD, off = wgid / NXCD; wgid = (xcd < r ? xcd * (q + 1) : r * (q + 1) + (xcd - r) * q) + off; }
        const int nig = WGM * nN, gid = wgid / nig, fm = gid * WGM, gsz = (nM - fm) < WGM ? (nM - fm) : WGM;
        u.pm = fm + ((wgid % nig) % gsz); u.pn = (wgid % nig) / gsz; u.kc = 0; return true;
    }
    __device__ __forceinline__ void a_ready(const Unit&) const {}
    __device__ __forceinline__ void done(const Unit&) const {}
    __device__ __forceinline__ void mid(int) const {}
};
struct QueueOrder {
    int nM, nN, nwg, xcd, cnt; unsigned* ctr; volatile __attribute__((address_space(3))) int* slot; mutable int pend;
    __device__ __forceinline__ void init(int M, int N, int xcd_, unsigned* ctr_, volatile __attribute__((address_space(3))) int* slot_) {
        nM = M / BM; nN = N / BM; nwg = nM * nN; xcd = xcd_; cnt = nwg / NXCD + (xcd_ < nwg % NXCD ? 1 : 0); ctr = ctr_; slot = slot_; pend = 0;
        if (threadIdx.x == 0) { const int r = (int)__hip_atomic_fetch_add(ctr, 2u, __ATOMIC_RELAXED, __HIP_MEMORY_SCOPE_AGENT); slot[0] = r; slot[1] = r + 1; }
        __syncthreads(); }
    __device__ __forceinline__ bool next(int i, Unit& u) const {
        const int off = __builtin_amdgcn_readfirstlane(slot[i & 1]); if (off >= cnt) return false;
        int wgid; { const int q = nwg / NXCD, r = nwg % NXCD; wgid = (xcd < r ? xcd * (q + 1) : r * (q + 1) + (xcd - r) * q) + off; }
        const int nig = WGM * nN, gid = wgid / nig, fm = gid * WGM, gsz = (nM - fm) < WGM ? (nM - fm) : WGM;
        u.pm = fm + ((wgid % nig) % gsz); u.pn = (wgid % nig) / gsz; u.kc = 0;
        if (i >= 1 && threadIdx.x == 0) slot[(i + 1) & 1] = (int)__hip_atomic_fetch_add(ctr, 1u, __ATOMIC_RELAXED, __HIP_MEMORY_SCOPE_AGENT);
        return true; }
    __device__ __forceinline__ void mid(int ui) const { }
    __device__ __forceinline__ void a_ready(const Unit&) const {}
    __device__ __forceinline__ void done(const Unit&) const {}
};

typedef float f32x2_t __attribute__((ext_vector_type(2))); typedef __bf16 bf16x2_t __attribute__((ext_vector_type(2)));
__device__ __forceinline__ unsigned cvt_pk_bf16(float lo, float hi) { f32x2_t v = {lo, hi}; bf16x2_t b = __builtin_convertvector(v, bf16x2_t); return __builtin_bit_cast(unsigned, b); }
__device__ __forceinline__ u32x4 pack8(const f32x4 v0, const f32x4 v1) { u32x4 w; w.x = cvt_pk_bf16(v0[0], v0[1]); w.y = cvt_pk_bf16(v0[2], v0[3]); w.z = cvt_pk_bf16(v1[0], v1[1]); w.w = cvt_pk_bf16(v1[2], v1[3]); return w; }
__device__ __forceinline__ float bflo(unsigned w) { return __uint_as_float(w << 16); }
__device__ __forceinline__ float bfhi(unsigned w) { return __uint_as_float(w & 0xffff0000u); }
__device__ __forceinline__ unsigned gate_q8x4_y(float y0, float y1, float y2, float y3) {
    unsigned b[4]; const float yy[4] = {y0, y1, y2, y3};
#pragma unroll
    for (int j = 0; j < 4; ++j) { const float g = __builtin_amdgcn_rcpf(1.0f + __builtin_amdgcn_exp2f(fminf(yy[j], 8.9f))); b[j] = __float_as_uint(fmaf(g, 255.0f, 8388608.0f)); }
    const unsigned p01 = __builtin_amdgcn_perm(b[1], b[0], 0x0c0c0400u), p23 = __builtin_amdgcn_perm(b[3], b[2], 0x0c0c0400u);
    return __builtin_amdgcn_perm(p23, p01, 0x05040100u);
}
__device__ __forceinline__ unsigned gate_tab4(const __attribute__((address_space(3))) unsigned char* tab, float y0, float y1, float y2, float y3) {
    unsigned b[4]; const float yy[4] = {y0, y1, y2, y3};
#pragma unroll
    for (int j = 0; j < 4; ++j) { const float t = fmaf(__builtin_amdgcn_fmed3f(yy[j], -9.0f, 8.99f), 128.0f, 12582912.0f + 1152.0f); b[j] = (unsigned)tab[__float_as_uint(t) & 0xfffu]; }
    return b[0] | (b[1] << 8) | (b[2] << 16) | (b[3] << 24);
}
__device__ __forceinline__ unsigned gate_q8(float x) { const float g = __builtin_amdgcn_rcpf(1.0f + __builtin_amdgcn_exp2f(-1.4426950408889634f * x)); const int q = (int)(g * 255.0f + 0.5f); return (unsigned)(q < 1 ? 1 : q > 255 ? 255 : q); }
__device__ __forceinline__ float sigmoid_f(float x) { return __builtin_amdgcn_rcpf(1.0f + __builtin_amdgcn_exp2f(-1.4426950408889634f * x)); }

constexpr int TOK_P = 32768, TOK = 33024;
constexpr size_t O_YP = 0, O_YS = 33554432, O_KP = 33816576, O_VP = 50593792, O_LFP = 67371008, O_PLP = 67633152, O_MKP = 67694592, O_MVP = 68743168,
                 O_KS = 69791744, O_VS = 69922816, O_LFS = 70053888, O_PLS = 70055936, O_END = 70178816;
constexpr float C2F = 0.125f * 1.4426950408889634f;

struct EpiInProj {
    static constexpr bool PERM = true, AFTER_DRAIN = false, HAS_HOOK = false; static constexpr int HOOK_T0 = -1, HOOK_T1 = -1;
    bf16_t *Q, *K, *V, *U, *QM, *G; float* out; unsigned* nrm;
    __device__ __forceinline__ void hook(f32x4 (&)[2][2][4][2], const Unit&, int, int, int, int, int) const {}
    __device__ __forceinline__ void operator()(const f32x4 (&acc)[2][2][4][2], const Unit& u, int wr, int wc, int fr, int fq) const {
        const int pn = u.pn, row0 = u.pm * BM + wr * 64 + fr; const bool samp = u.pm >= TOK_P / BM;
        if (pn < 4 && !samp) {
#pragma unroll
            for (int bj = 0; bj < 2; ++bj) { float mx = 0.f;
#pragma unroll
                for (int ai = 0; ai < 2; ++ai)
#pragma unroll
                    for (int m = 0; m < 4; ++m) { const f32x4 v0 = acc[ai][bj][m][0], v1 = acc[ai][bj][m][1];
                        float sq = (v0[0] * v0[0] + v0[1] * v0[1]) + (v0[2] * v0[2] + v0[3] * v0[3]) + (v1[0] * v1[0] + v1[1] * v1[1]) + (v1[2] * v1[2] + v1[3] * v1[3]);
                        sq += __shfl_xor(sq, 16); sq += __shfl_xor(sq, 32); mx = fmaxf(mx, sq); }
                mx = fmaxf(mx, __shfl_xor(mx, 1)); mx = fmaxf(mx, __shfl_xor(mx, 2)); mx = fmaxf(mx, __shfl_xor(mx, 4)); mx = fmaxf(mx, __shfl_xor(mx, 8));
                if ((fr | fq) == 0) { const int b = u.pm >> 4, head = (pn & 1) * 4 + bj * 2 + (wc >> 1);
                    atomicMax(nrm + (((pn >> 1) * 8 + b) * 8 + head) * 2 + (wc & 1), __float_as_uint(mx)); } }
        }
        const int ct = wc * 32 + 8 * fq;
        if (pn >= 10) {
            const int cb = (pn - 10) * 256 + ct; unsigned char* G8 = (unsigned char*)G;
#pragma unroll
            for (int ai = 0; ai < 2; ++ai)
#pragma unroll
                for (int m = 0; m < 4; ++m) { unsigned char* rowp = G8 + (size_t)(row0 + ai * HALF + m * 16) * 3072 + cb;
#pragma unroll
                    for (int bj = 0; bj < 2; ++bj) { const f32x4 v0 = acc[ai][bj][m][0], v1 = acc[ai][bj][m][1]; unsigned lo = 0u, hi = 0u;
#pragma unroll
                        for (int j = 0; j < 4; ++j) { lo |= gate_q8(v0[j]) << (8 * j); hi |= gate_q8(v1[j]) << (8 * j); }
                        *(unsigned long long*)(rowp + bj * HALF) = (unsigned long long)lo | ((unsigned long long)hi << 32); } }
            return;
        }
        const int seg = pn >> 1, cb = (pn & 1) * 256 + ct;
        bf16_t* dst = seg == 0 ? Q : seg == 1 ? K : seg == 2 ? V : seg == 3 ? U : QM;
        const float sc = seg == 0 ? C2F : 1.0f;
        float* fo = nullptr;
        if (seg == 1) fo = out + (samp ? O_KS : O_KP); else if (seg == 2) fo = out + (samp ? O_VS : O_VP);
#pragma unroll
        for (int ai = 0; ai < 2; ++ai)
#pragma unroll
            for (int m = 0; m < 4; ++m) { const int row = row0 + ai * HALF + m * 16; bf16_t* rowp = dst + (size_t)row * 512 + cb;
                const int rowo = samp ? row - TOK_P : row;
                float* pool = nullptr;
                if (seg == 3) { if (!samp) { const int t = row & 4095, b = row >> 12; if (t >= 4096 - 15) pool = out + O_PLP + (size_t)(b * 15 + t - (4096 - 15)) * 512 + cb; }
                                else { const int t = rowo & 15, b = rowo >> 4; if (t >= 1) pool = out + O_PLS + (size_t)(b * 15 + t - 1) * 512 + cb; } }
#pragma unroll
                for (int bj = 0; bj < 2; ++bj) { const f32x4 v0 = acc[ai][bj][m][0], v1 = acc[ai][bj][m][1];
                    *(u32x4*)(rowp + bj * HALF) = pack8(v0 * sc, v1 * sc);
                    if (fo) { float* p = fo + (size_t)rowo * 512 + cb + bj * HALF; *(f32x4*)p = v0; *(f32x4*)(p + 4) = v1; }
                    if (pool) { float* p = pool + bj * HALF; *(f32x4*)p = v0; *(f32x4*)(p + 4) = v1; } } }
    }
};
struct EpiGates8 {
    static constexpr bool PERM = true, AFTER_DRAIN = false, HAS_HOOK = false; static constexpr int HOOK_T0 = -1, HOOK_T1 = -1;
    unsigned char* G; const float* sx; const float* sw; const __attribute__((address_space(3))) unsigned char* stab;
    __device__ __forceinline__ void hook(i32x4 (&)[2][2][4][2], const Unit&, int, int, int, int, int) const {}
    __device__ __forceinline__ void operator()(const i32x4 (&acc)[2][2][4][2], const Unit& u, int wr, int wc, int fr, int fq) const {
        const int row0 = u.pm * BM + wr * 64 + fr, cb = u.pn * BM + wc * 32 + 8 * fq;
        f32x4 w0[2], w1[2];
#pragma unroll
        for (int bj = 0; bj < 2; ++bj) { w0[bj] = *(const f32x4*)(sw + cb + bj * HALF) * -1.4426950408889634f; w1[bj] = *(const f32x4*)(sw + cb + bj * HALF + 4) * -1.4426950408889634f; }
        unsigned char* gt = G + (size_t)((u.pm * 4 + (u.pn & 3)) * 3 + (u.pn >> 2)) * 65536 + (size_t)(((wr * 4 + wc) * 8) * 64 + fq * 16 + fr) * 16;
        float sxv[2][4];
#pragma unroll
        for (int ai = 0; ai < 2; ++ai)
#pragma unroll
            for (int m = 0; m < 4; ++m) sxv[ai][m] = sx[(size_t)(row0 + ai * HALF + m * 16)];
#pragma unroll
        for (int ai = 0; ai < 2; ++ai)
#pragma unroll
            for (int m = 0; m < 4; ++m) { const float s = sxv[ai][m]; unsigned q[4];
#pragma unroll
                for (int bj = 0; bj < 2; ++bj) { const i32x4 a0 = acc[ai][bj][m][0], a1 = acc[ai][bj][m][1]; const f32x4 s0 = w0[bj] * s, s1 = w1[bj] * s;
                    q[2 * bj] = gate_tab4(stab, (float)a0[0] * s0[0], (float)a0[1] * s0[1], (float)a0[2] * s0[2], (float)a0[3] * s0[3]);
                    q[2 * bj + 1] = gate_tab4(stab, (float)a1[0] * s1[0], (float)a1[1] * s1[1], (float)a1[2] * s1[2], (float)a1[3] * s1[3]); }
                *(u32x4*)(gt + (size_t)(ai * 4 + m) * 1024) = (u32x4){q[0], q[1], q[2], q[3]}; }
    }
};
struct EpiMemKV {
    static constexpr bool PERM = true, AFTER_DRAIN = false, HAS_HOOK = false; static constexpr int HOOK_T0 = -1, HOOK_T1 = -1;
    bf16_t *MK, *MV; float* out;
    __device__ __forceinline__ void hook(f32x4 (&)[2][2][4][2], const Unit&, int, int, int, int, int) const {}
    __device__ __forceinline__ void operator()(const f32x4 (&acc)[2][2][4][2], const Unit& u, int wr, int wc, int fr, int fq) const {
        const int pn = u.pn, row0 = u.pm * BM + wr * 64 + fr, cb = (pn & 1) * 256 + wc * 32 + 8 * fq;
        bf16_t* dst = pn < 2 ? MK : MV; float* fo = out + (pn < 2 ? O_MKP : O_MVP);
#pragma unroll
        for (int ai = 0; ai < 2; ++ai)
#pragma unroll
            for (int m = 0; m < 4; ++m) { const int row = row0 + ai * HALF + m * 16;
#pragma unroll
                for (int bj = 0; bj < 2; ++bj) { const f32x4 v0 = acc[ai][bj][m][0], v1 = acc[ai][bj][m][1];
                    *(u32x4*)(dst + (size_t)row * 512 + cb + bj * HALF) = pack8(v0, v1);
                    float* p = fo + (size_t)row * 512 + cb + bj * HALF; *(f32x4*)p = v0; *(f32x4*)(p + 4) = v1; } }
    }
};
struct EpiMerge {
    static constexpr bool PERM = true, AFTER_DRAIN = false, HAS_HOOK = true; static constexpr int HOOK_T0 = 8, HOOK_T1 = 16;
    const unsigned char* G; bf16_t* MM; const __attribute__((address_space(3))) unsigned char* rtab;
    __device__ __forceinline__ void hook(f32x4 (&acc)[2][2][4][2], const Unit& u, int t, int wr, int wc, int fr, int fq) const {
        int fr_ = fr, fq_ = fq; asm volatile("" : "+v"(fr_), "+v"(fq_));
        const int seg = t >> 3;
        const unsigned char* gt = G + (size_t)((u.pm * 4 + u.pn) * 3 + (seg - 1)) * 65536 + (size_t)(((wr * 4 + wc) * 8) * 64 + fq_ * 16 + fr_) * 16;
        u32x4 gp[8], gn[8];
#pragma unroll
        for (int c = 0; c < 8; ++c) { gp[c] = __builtin_nontemporal_load((const u32x4*)(gt + (size_t)c * 1024)); gn[c] = __builtin_nontemporal_load((const u32x4*)(gt + 65536 + (size_t)c * 1024)); }
#pragma unroll
        for (int ai = 0; ai < 2; ++ai)
#pragma unroll
            for (int m = 0; m < 4; ++m)
#pragma unroll
                for (int bj = 0; bj < 2; ++bj) { const u32x4 p4 = gp[ai * 4 + m], n4 = gn[ai * 4 + m];
#pragma unroll
                    for (int h = 0; h < 2; ++h) { const unsigned p = p4[2 * bj + h], n = n4[2 * bj + h];
#pragma unroll
                        for (int j = 0; j < 4; ++j) acc[ai][bj][m][h][j] *= (float)((p >> (8 * j)) & 255u) * *(const __attribute__((address_space(3))) float*)(rtab + (j == 0 ? (n << 2) & 0x3fcu : (n >> (8 * j - 2)) & 0x3fcu)); } }
    }
    __device__ __forceinline__ void operator()(const f32x4 (&acc)[2][2][4][2], const Unit& u, int wr, int wc, int fr, int fq) const {
        const int row0 = u.pm * BM + wr * 64 + fr, cb = u.pn * BM + wc * 32 + 8 * fq;
        const unsigned char* gt = G + (size_t)((u.pm * 4 + u.pn) * 3 + 2) * 65536 + (size_t)(((wr * 4 + wc) * 8) * 64 + fq * 16 + fr) * 16;
        u32x4 g2[8];
#pragma unroll
        for (int c = 0; c < 8; ++c) g2[c] = __builtin_nontemporal_load((const u32x4*)(gt + (size_t)c * 1024));
#pragma unroll
        for (int ai = 0; ai < 2; ++ai)
#pragma unroll
            for (int m = 0; m < 4; ++m) { const size_t row = (size_t)(row0 + ai * HALF + m * 16);
#pragma unroll
                for (int bj = 0; bj < 2; ++bj) { const unsigned glo = g2[ai * 4 + m][2 * bj], ghi = g2[ai * 4 + m][2 * bj + 1]; f32x4 v0 = acc[ai][bj][m][0], v1 = acc[ai][bj][m][1];
#pragma unroll
                    for (int j = 0; j < 4; ++j) { v0[j] *= (float)((glo >> (8 * j)) & 255u) * (1.0f / 255.0f); v1[j] *= (float)((ghi >> (8 * j)) & 255u) * (1.0f / 255.0f); }
                    *(u32x4*)(MM + row * 1024 + cb + bj * HALF) = pack8(v0, v1); } }
    }
};
struct EpiWout {
    static constexpr bool PERM = true, AFTER_DRAIN = false, HAS_HOOK = false; static constexpr int HOOK_T0 = -1, HOOK_T1 = -1;
    const float *xp, *xs; float* H; bf16_t* HB; float* ssq;
    __device__ __forceinline__ void hook(f32x4 (&)[2][2][4][2], const Unit&, int, int, int, int, int) const {}
    __device__ __forceinline__ void operator()(const f32x4 (&acc)[2][2][4][2], const Unit& u, int wr, int wc, int fr, int fq) const {
        const int row0 = u.pm * BM + wr * 64 + fr, cb = u.pn * BM + wc * 32 + 8 * fq; const bool samp = u.pm >= TOK_P / BM;
        const float* xb = samp ? xs - (size_t)TOK_P * 1024 : xp;
#pragma unroll
        for (int ai = 0; ai < 2; ++ai) {
            f32x4 xv[4][2][2];
#pragma unroll
            for (int m = 0; m < 4; ++m)
#pragma unroll
                for (int bj = 0; bj < 2; ++bj) { const float* p = xb + (size_t)(row0 + ai * HALF + m * 16) * 1024 + cb + bj * HALF; xv[m][bj][0] = __builtin_nontemporal_load((const f32x4*)p); xv[m][bj][1] = __builtin_nontemporal_load((const f32x4*)(p + 4)); }
#pragma unroll
            for (int m = 0; m < 4; ++m) { const size_t row = (size_t)(row0 + ai * HALF + m * 16); float s = 0.f;
#pragma unroll
                for (int bj = 0; bj < 2; ++bj) { const size_t off = row * 1024 + cb + bj * HALF;
                    const f32x4 h0 = xv[m][bj][0] + acc[ai][bj][m][0], h1 = xv[m][bj][1] + acc[ai][bj][m][1];
                    *(u32x4*)(HB + off) = pack8(h0, h1);
                    s += (h0[0] * h0[0] + h0[1] * h0[1]) + (h0[2] * h0[2] + h0[3] * h0[3]) + (h1[0] * h1[0] + h1[1] * h1[1]) + (h1[2] * h1[2] + h1[3] * h1[3]); }
                s += __shfl_xor(s, 16); s += __shfl_xor(s, 32);
                if (fq == 0) atomicAdd(ssq + row, s); } }
    }
};
struct EpiUp {
    static constexpr bool PERM = true, AFTER_DRAIN = false, HAS_HOOK = false; static constexpr int HOOK_T0 = -1, HOOK_T1 = -1;
    const float* ssq; bf16_t* A2;
    __device__ __forceinline__ void hook(f32x4 (&)[2][2][4][2], const Unit&, int, int, int, int, int) const {}
    __device__ __forceinline__ void operator()(const f32x4 (&acc)[2][2][4][2], const Unit& u, int wr, int wc, int fr, int fq) const {
        const int row0 = u.pm * BM + wr * 64 + fr, cb = u.pn * BM + wc * 32 + 8 * fq;
#pragma unroll
        for (int ai = 0; ai < 2; ++ai)
#pragma unroll
            for (int m = 0; m < 4; ++m) { const size_t row = (size_t)(row0 + ai * HALF + m * 16);
#pragma unroll
                for (int bj = 0; bj < 2; ++bj) { f32x4 v0 = acc[ai][bj][m][0], v1 = acc[ai][bj][m][1];
#pragma unroll
                    for (int j = 0; j < 4; ++j) { const float a = fmaxf(v0[j], 0.f), b = fmaxf(v1[j], 0.f); v0[j] = a * a; v1[j] = b * b; }
                    *(u32x4*)(A2 + row * (4096 + 64)   + cb + bj * HALF) = pack8(v0, v1); } }
    }
};
struct EpiDown {
    static constexpr bool PERM = true, AFTER_DRAIN = false, HAS_HOOK = false; static constexpr int HOOK_T0 = -1, HOOK_T1 = -1;
    float* Y; const bf16_t* HB; float* ssq; unsigned* cnt; const float* gfin; const float* ssq1;
    __device__ __forceinline__ void hook(f32x4 (&)[2][2][4][2], const Unit&, int, int, int, int, int) const {}
    __device__ __forceinline__ void operator()(const f32x4 (&acc_)[2][2][4][2], const Unit& u, int wr, int wc, int fr, int fq) const {
        f32x4 (&acc)[2][2][4][2] = const_cast<f32x4 (&)[2][2][4][2]>(acc_);
        const int row0 = u.pm * BM + wr * 64 + fr, cb = u.pn * BM + wc * 32 + 8 * fq;
        u32x4 hbv[2][4][2];
#pragma unroll
        for (int ai = 0; ai < 2; ++ai)
#pragma unroll
            for (int m = 0; m < 4; ++m)
#pragma unroll
                for (int bj = 0; bj < 2; ++bj) hbv[ai][m][bj] = __builtin_nontemporal_load((const u32x4*)(HB + (size_t)(row0 + ai * HALF + m * 16) * 1024 + cb + bj * HALF));
        float s1v[2][4];
#pragma unroll
        for (int ai = 0; ai < 2; ++ai)
#pragma unroll
            for (int m = 0; m < 4; ++m) s1v[ai][m] = ssq1[(size_t)(row0 + ai * HALF + m * 16)];
#pragma unroll
        for (int ai = 0; ai < 2; ++ai)
#pragma unroll
            for (int m = 0; m < 4; ++m) { const size_t row = (size_t)(row0 + ai * HALF + m * 16); float s = 0.f; const float r2 = 1.0f / (s1v[ai][m] * (1.0f / 1024.0f) + 1e-6f);
#pragma unroll
                for (int bj = 0; bj < 2; ++bj) { const u32x4 hb = hbv[ai][m][bj];
                    const f32x4 h0 = (f32x4){bflo(hb.x), bfhi(hb.x), bflo(hb.y), bfhi(hb.y)} + acc[ai][bj][m][0] * r2, h1 = (f32x4){bflo(hb.z), bfhi(hb.z), bflo(hb.w), bfhi(hb.w)} + acc[ai][bj][m][1] * r2;
                    acc[ai][bj][m][0] = h0; acc[ai][bj][m][1] = h1;
                    s += (h0[0] * h0[0] + h0[1] * h0[1]) + (h0[2] * h0[2] + h0[3] * h0[3]) + (h1[0] * h1[0] + h1[1] * h1[1]) + (h1[2] * h1[2] + h1[3] * h1[3]); }
                s += __shfl_xor(s, 16); s += __shfl_xor(s, 32);
                if (fq == 0) atomicAdd(ssq + row, s); }
        asm volatile("s_waitcnt vmcnt(0)" ::: "memory");
        unsigned* pc = cnt + 64 * u.pm;
        if ((fr | fq) == 0) __hip_atomic_fetch_add(pc, 1u, __ATOMIC_RELAXED, __HIP_MEMORY_SCOPE_AGENT);
        for (unsigned sp = 0; sp < (1u << 18); ++sp) { if (__builtin_amdgcn_readfirstlane((int)__hip_atomic_load(pc, __ATOMIC_RELAXED, __HIP_MEMORY_SCOPE_AGENT)) >= 32) break; __builtin_amdgcn_s_sleep(2); }
        f32x4 g0[2], g1[2];
#pragma unroll
        for (int bj = 0; bj < 2; ++bj) { g0[bj] = *(const f32x4*)(gfin + cb + bj * HALF); g1[bj] = *(const f32x4*)(gfin + cb + bj * HALF + 4); }
        float totv[2][4];
#pragma unroll
        for (int ai = 0; ai < 2; ++ai)
#pragma unroll
            for (int m = 0; m < 4; ++m) { float tot = 0.f; if (fq == 0) tot = __hip_atomic_load(ssq + (size_t)(row0 + ai * HALF + m * 16), __ATOMIC_RELAXED, __HIP_MEMORY_SCOPE_AGENT); totv[ai][m] = tot; }
#pragma unroll
        for (int ai = 0; ai < 2; ++ai)
#pragma unroll
            for (int m = 0; m < 4; ++m) { const size_t row = (size_t)(row0 + ai * HALF + m * 16);
                float tot = totv[ai][m];
                tot = __shfl(tot, fr);
                const float rs = 1.0f / sqrtf(tot * (1.0f / 1024.0f) + 1e-6f);
#pragma unroll
                for (int bj = 0; bj < 2; ++bj) { float* p = Y + row * 1024 + cb + bj * HALF; *(f32x4*)p = acc[ai][bj][m][0] * rs * g0[bj]; *(f32x4*)(p + 4) = acc[ai][bj][m][1] * rs * g1[bj]; } }
    }
};
__device__ __forceinline__ f32x4 mma16(bf16x8 b, bf16x8 a, f32x4 c) { return __builtin_amdgcn_mfma_f32_16x16x32_bf16(b, a, c, 0, 0, 0); }
__device__ __forceinline__ i32x4 mma16(bf16x8 b, bf16x8 a, i32x4 c) { return __builtin_amdgcn_mfma_i32_16x16x64_i8(__builtin_bit_cast(i32x4, b), __builtin_bit_cast(i32x4, a), c, 0, 0, 0); }
template <bool I8> struct AccT { typedef f32x4 type; }; template <> struct AccT<true> { typedef i32x4 type; };
template <class Epi, class Sched, bool ALIGN_EPI = false, bool SP2 = false, bool I8 = false>
__device__ __forceinline__ void gemm_phase(PG8_LAS unsigned char* lds, const Gemm g, const Sched& S, const Epi& E) {
    int tid_ = threadIdx.x; asm volatile("" : "+v"(tid_));
    const int tid = tid_, wid = __builtin_amdgcn_readfirstlane(tid >> 6), lane = tid & 63, wr = wid >> 2, wc = wid & 3, fr = lane & 15, fq = lane >> 4;
    const int K = g.K, LD = g.ld, nt = K / BK;
    unsigned voffA[2], voffB[2];
#pragma unroll
    for (int i = 0; i < 2; ++i) { int R, C; stage_rc(tid * 16 + i * 8192, R, C); const int Rb = Epi::PERM ? ((R & ~31) + perm32(R & 31)) : R;
        voffA[i] = (unsigned)(R * LD + C) * 2u; voffB[i] = (unsigned)(Rb * LD + C) * 2u; }
    const size_t kstep = (size_t)(BK * 2);
    const size_t hstep = (size_t)HALF * LD * 2;
    const size_t tstep = 2 * hstep;
    const unsigned ldsw = (unsigned)wid * 1024u;
    const int aoff = lds_byte(wr * 64 + fr, fq * 8), boff = lds_byte(wc * 32 + fr, fq * 8);
#define PG8_SA(b, h) (((b) * 2 + (h)) * HTB)
#define PG8_SB(b, h) ((4 + (b) * 2 + (h)) * HTB)
#define PG8_STAGE(bufoff, gbase, voff) do { _Pragma("unroll") for (int _i = 0; _i < 2; ++_i) \
        __builtin_amdgcn_global_load_lds((const unsigned*)((const char*)(gbase) + (voff)[_i]), (PG8_LAS unsigned*)(lds + (bufoff) + ldsw + _i * 8192), 16, 0, 0); } while (0)
#define PG8_LDA(dst, b, h) do { _Pragma("unroll") for (int m = 0; m < 4; ++m) _Pragma("unroll") for (int k = 0; k < 2; ++k) dst[m][k] = *(const PG8_LAS bf16x8*)(lds + PG8_SA(b, h) + aoff + m * 2048 + k * 1024); } while (0)
#define PG8_LDB(dst, b, h) do { _Pragma("unroll") for (int n = 0; n < 2; ++n) _Pragma("unroll") for (int k = 0; k < 2; ++k) dst[n][k] = *(const PG8_LAS bf16x8*)(lds + PG8_SB(b, h) + boff + n * 2048 + k * 1024); } while (0)
#define PG8_MMA(ai, bj, At, Bt) do { __builtin_amdgcn_s_setprio(1); _Pragma("unroll") for (int m = 0; m < 4; ++m) _Pragma("unroll") for (int n = 0; n < 2; ++n) _Pragma("unroll") for (int k = 0; k < 2; ++k) \
        acc[ai][bj][m][n] = mma16(Bt[n][k], At[m][k], acc[ai][bj][m][n]); __builtin_amdgcn_s_setprio(0); } while (0)
#define PG8_WAIT_V(n) asm volatile("s_waitcnt vmcnt(" #n ")" ::: "memory")
#define PG8_WAIT_L(n) asm volatile("s_waitcnt lgkmcnt(" #n ")" ::: "memory")
#define PG8_BAR __builtin_amdgcn_s_barrier()
#define PG8_SCHED __builtin_amdgcn_sched_barrier(0)
    Unit cur, nxt; int ui = 0;
    if (!S.next(0, cur)) return;
    typedef typename AccT<I8>::type acc_t; acc_t acc[2][2][4][2];
#pragma unroll
    for (int a = 0; a < 2; ++a)
#pragma unroll
        for (int b = 0; b < 2; ++b)
#pragma unroll
            for (int m = 0; m < 4; ++m)
#pragma unroll
                for (int n = 0; n < 2; ++n) acc[a][b][m][n] = acc_t{};
    bf16x8 At[4][2], B0[2][2], B1[2][2];
    const size_t cstep = (size_t)K * 2;
    const char* cA = (const char*)g.A + (size_t)cur.pm * tstep + (size_t)cur.kc * cstep; const char* cB = (const char*)g.Bt + (size_t)cur.pn * tstep + (size_t)cur.kc * cstep;
    S.a_ready(cur);
    if constexpr (SP2) {
        PG8_STAGE(PG8_SB(0, 0), cB, voffB); PG8_STAGE(PG8_SB(0, 1), cB + hstep, voffB); PG8_STAGE(PG8_SA(0, 0), cA, voffA); PG8_STAGE(PG8_SA(0, 1), cA + hstep, voffA);
        if (wr == 1) PG8_BAR;
        PG8_WAIT_V(2); PG8_BAR;
        PG8_STAGE(PG8_SB(1, 0), cB + kstep, voffB); PG8_STAGE(PG8_SA(1, 0), cA + kstep, voffA); PG8_STAGE(PG8_SB(1, 1), cB + hstep + kstep, voffB);
        PG8_WAIT_V(6); PG8_BAR;
    } else {
        PG8_STAGE(PG8_SB(0, 0), cB, voffB); PG8_STAGE(PG8_SA(0, 0), cA, voffA); PG8_STAGE(PG8_SB(0, 1), cB + hstep, voffB); PG8_STAGE(PG8_SA(0, 1), cA + hstep, voffA);
        if (wr == 1) PG8_BAR;
        PG8_WAIT_V(4); PG8_BAR;
        PG8_STAGE(PG8_SB(1, 0), cB + kstep, voffB); PG8_STAGE(PG8_SA(1, 0), cA + kstep, voffA); PG8_STAGE(PG8_SB(1, 1), cB + hstep + kstep, voffB);
        PG8_WAIT_V(6); PG8_BAR;
    }
    for (;;) {
        const bool has_next = S.next(ui + 1, nxt);
        const char* nA = has_next ? (const char*)g.A + (size_t)nxt.pm * tstep + (size_t)nxt.kc * cstep : cA; const char* nB = has_next ? (const char*)g.Bt + (size_t)nxt.pn * tstep + (size_t)nxt.kc * cstep : cB;
        for (int t = 0; t < nt; t += 2) {
            if constexpr (Epi::HAS_HOOK) { if (t == Epi::HOOK_T0 || t == Epi::HOOK_T1) E.hook(acc, cur, t, wr, wc, fr, fq); }
            if (t == 2) S.mid(ui);
            const bool last = (t == nt - 2);
            const char* a1 = cA + (size_t)(t + 1) * kstep;
            const char* a2 = last ? nA : cA + (size_t)(t + 2) * kstep; const char* b2 = last ? nB : cB + (size_t)(t + 2) * kstep;
            const char* a3 = a2 + kstep; const char* b3 = b2 + kstep;
            if (last && has_next) S.a_ready(nxt);
            if constexpr (SP2) {
            PG8_LDB(B0, 0, 0); PG8_LDB(B1, 0, 1); PG8_SCHED; PG8_LDA(At, 0, 0); PG8_STAGE(PG8_SA(1, 1), a1 + hstep, voffA);
            PG8_WAIT_V(8); PG8_WAIT_L(0); PG8_BAR; PG8_MMA(0, 0, At, B0); PG8_MMA(0, 1, At, B1); PG8_BAR; PG8_SCHED;
            PG8_LDA(At, 0, 1); PG8_STAGE(PG8_SB(0, 0), b2, voffB); PG8_STAGE(PG8_SB(0, 1), b2 + hstep, voffB); PG8_STAGE(PG8_SA(0, 0), a2, voffA);
            PG8_WAIT_V(8); PG8_WAIT_L(0); PG8_BAR; PG8_MMA(1, 0, At, B0); PG8_MMA(1, 1, At, B1); PG8_BAR; PG8_SCHED;
            PG8_LDB(B0, 1, 0); PG8_LDB(B1, 1, 1); PG8_SCHED; PG8_LDA(At, 1, 0); PG8_STAGE(PG8_SA(0, 1), a2 + hstep, voffA);
            PG8_WAIT_V(8); PG8_WAIT_L(0); PG8_BAR; PG8_MMA(0, 0, At, B0); PG8_MMA(0, 1, At, B1); PG8_BAR; PG8_SCHED;
            PG8_LDA(At, 1, 1); PG8_STAGE(PG8_SB(1, 0), b3, voffB); PG8_STAGE(PG8_SB(1, 1), b3 + hstep, voffB); PG8_STAGE(PG8_SA(1, 0), a3, voffA);
            PG8_WAIT_V(8); PG8_WAIT_L(0); PG8_BAR; PG8_MMA(1, 0, At, B0); PG8_MMA(1, 1, At, B1); PG8_BAR; PG8_SCHED;
            } else {
            PG8_LDB(B0, 0, 0); PG8_SCHED; PG8_LDA(At, 0, 0); PG8_STAGE(PG8_SA(1, 1), a1 + hstep, voffA);
            PG8_WAIT_L(8); PG8_BAR; PG8_WAIT_L(0); PG8_MMA(0, 0, At, B0); PG8_BAR; PG8_SCHED;
            PG8_LDB(B1, 0, 1); PG8_STAGE(PG8_SB(0, 0), b2, voffB);
            PG8_BAR; PG8_WAIT_L(0); PG8_MMA(0, 1, At, B1); PG8_BAR;
            PG8_LDA(At, 0, 1); PG8_STAGE(PG8_SA(0, 0), a2, voffA);
            PG8_BAR; PG8_WAIT_L(0); PG8_MMA(1, 0, At, B0); PG8_BAR; PG8_SCHED;
            PG8_STAGE(PG8_SB(0, 1), b2 + hstep, voffB);
            PG8_WAIT_V(6); PG8_BAR; PG8_MMA(1, 1, At, B1); PG8_BAR;
            PG8_LDB(B0, 1, 0); PG8_SCHED; PG8_LDA(At, 1, 0); PG8_STAGE(PG8_SA(0, 1), a2 + hstep, voffA);
            PG8_WAIT_L(8); PG8_BAR; PG8_WAIT_L(0); PG8_MMA(0, 0, At, B0); PG8_BAR; PG8_SCHED;
            PG8_LDB(B1, 1, 1); PG8_STAGE(PG8_SB(1, 0), b3, voffB);
            PG8_BAR; PG8_WAIT_L(0); PG8_MMA(0, 1, At, B1); PG8_BAR;
            PG8_LDA(At, 1, 1); PG8_STAGE(PG8_SA(1, 0), a3, voffA);
            PG8_BAR; PG8_WAIT_L(0); PG8_MMA(1, 0, At, B0); PG8_BAR; PG8_SCHED;
            PG8_STAGE(PG8_SB(1, 1), b3 + hstep, voffB);
            PG8_WAIT_V(6); PG8_BAR; PG8_MMA(1, 1, At, B1); PG8_BAR;
            }
        }
        if constexpr (ALIGN_EPI) { if (wr == 0) PG8_BAR; }
        if constexpr (!Epi::AFTER_DRAIN) { E(acc, cur, wr, wc, fr, fq); S.done(cur); }
        if (!has_next) break;
#pragma unroll
        for (int a = 0; a < 2; ++a)
#pragma unroll
            for (int b = 0; b < 2; ++b)
#pragma unroll
                for (int m = 0; m < 4; ++m)
#pragma unroll
                    for (int n = 0; n < 2; ++n) acc[a][b][m][n] = acc_t{};
        cur = nxt; cA = nA; cB = nB; ++ui;
        if constexpr (ALIGN_EPI) { if (wr == 1) PG8_BAR; }
    }
    PG8_WAIT_V(0);
    if constexpr (!ALIGN_EPI) { if (wr == 0) PG8_BAR; }
    PG8_BAR;
    if constexpr (Epi::AFTER_DRAIN) { E.fused(acc, cur, wr, wc, fr, fq, lds, wid, lane); S.done(cur); }
#undef PG8_SA
#undef PG8_SB
#undef PG8_STAGE
#undef PG8_LDA
#undef PG8_LDB
#undef PG8_MMA
#undef PG8_WAIT_V
#undef PG8_WAIT_L
#undef PG8_BAR
#undef PG8_SCHED
}
}
namespace attn_body {
using bf16=__hip_bfloat16;
using bf16x8=__attribute__((ext_vector_type(8)))short;
using s16x4=__attribute__((ext_vector_type(4)))short;
using f32x16=__attribute__((ext_vector_type(16)))float;
using u32x4=__attribute__((ext_vector_type(4)))unsigned;
constexpr int NHEAD=8,SEQ=4096,D=64,DM=NHEAD*D,OP=1536;
constexpr int NW=8,QBLK=32,QB=QBLK*NW,KVBLK=64,NQB=SEQ/QB;
constexpr int ATTN_PITCH=DM, ATTN_UNIT_ROWS=QB;
__device__ __forceinline__ int crow(int r,int hi){return (r&3)+8*(r>>2)+4*hi;}
#define SBAR() __builtin_amdgcn_sched_barrier(0)
__device__ __forceinline__ void cmask(f32x16&p0,f32x16&p1,int jb,int qrel,int hi){
  const float NEG=-INFINITY; int kb=64*jb+4*hi;
  #pragma unroll
  for(int r=0;r<16;++r){int kv=kb+(r&3)+8*(r>>2); if(kv>qrel)p0[r]=NEG; if(kv+32>qrel)p1[r]=NEG;}
}

constexpr int NSLOT=3, SLOTB=8192;
constexpr int LDS_K=0, LDS_V=NSLOT*SLOTB, LDS_WS=2*NSLOT*SLOTB, LDS_OST=LDS_WS+NW*64*4, LDS_DL=LDS_OST+NW*4096, LDS_BYTES=LDS_DL+SEQ*4;
constexpr float C2=0.125f*1.4426950408889634f;
__device__ __forceinline__ void glds16(const void*gsrc,unsigned lds_dst){unsigned keep;
  asm volatile("s_mov_b32 %0, m0\n\ts_mov_b32 m0, %2\n\ts_nop 0\n\tglobal_load_lds_dwordx4 %1, off\n\ts_mov_b32 m0, %0":"=&s"(keep):"v"(gsrc),"s"(lds_dst):"memory");}
__device__ __forceinline__ float max3f(float a,float b,float c){float r;asm("v_max3_f32 %0, %1, %2, %3":"=v"(r):"v"(a),"v"(b),"v"(c));return r;}
__device__ __forceinline__ float max2f(float a,float b){float r;asm("v_max_f32_e32 %0, %1, %2":"=v"(r):"v"(a),"v"(b));return r;}
__device__ __forceinline__ float fadd_s(float a,float b){float r;asm("v_add_f32_e32 %0, %1, %2":"=v"(r):"v"(a),"v"(b));return r;}
__device__ __forceinline__ float fsub_s(float a,float b){float r;asm("v_sub_f32_e32 %0, %1, %2":"=v"(r):"v"(a),"v"(b));return r;}
typedef float f32x4_t __attribute__((ext_vector_type(4))); typedef float f32x2_t __attribute__((ext_vector_type(2))); typedef __bf16 bf16x2_t __attribute__((ext_vector_type(2)));
__device__ __forceinline__ unsigned cvtpk_s(float lo,float hi){f32x2_t v={lo,hi};bf16x2_t b=__builtin_convertvector(v,bf16x2_t);return __builtin_bit_cast(unsigned,b);}
#define WAIT_BAR(N) asm volatile("s_waitcnt vmcnt(" #N ") lgkmcnt(0)\n\ts_barrier":::"memory")

__device__ __forceinline__ void qkt(f32x16&p0,f32x16&p1,const char*Kslot,const bf16x8*qr,const f32x16&negm,int r32,int hi){
  const char*kb=Kslot+hi*1024+r32*16;
  #pragma unroll
  for(int d0=0;d0<4;++d0){
    const bf16x8 b0=*reinterpret_cast<const bf16x8*>(kb+d0*2048);
    const bf16x8 b1=*reinterpret_cast<const bf16x8*>(kb+d0*2048+512);
    if(d0==0){p0=__builtin_amdgcn_mfma_f32_32x32x16_bf16(b0,qr[0],negm,0,0,0);p1=__builtin_amdgcn_mfma_f32_32x32x16_bf16(b1,qr[0],negm,0,0,0);}
    else{p0=__builtin_amdgcn_mfma_f32_32x32x16_bf16(b0,qr[d0],p0,0,0,0);p1=__builtin_amdgcn_mfma_f32_32x32x16_bf16(b1,qr[d0],p1,0,0,0);}}
}
typedef __attribute__((address_space(3))) const char* lds_cptr;
typedef short v4i16_t __attribute__((ext_vector_type(4)));
__device__ __forceinline__ void kload8(bf16x8*kf,lds_cptr kp){
  kf[0]=*(const __attribute__((address_space(3))) bf16x8*)(kp);      kf[1]=*(const __attribute__((address_space(3))) bf16x8*)(kp+512);
  kf[2]=*(const __attribute__((address_space(3))) bf16x8*)(kp+2048); kf[3]=*(const __attribute__((address_space(3))) bf16x8*)(kp+2560);
  kf[4]=*(const __attribute__((address_space(3))) bf16x8*)(kp+4096); kf[5]=*(const __attribute__((address_space(3))) bf16x8*)(kp+4608);
  kf[6]=*(const __attribute__((address_space(3))) bf16x8*)(kp+6144); kf[7]=*(const __attribute__((address_space(3))) bf16x8*)(kp+6656);
}
__device__ __forceinline__ void kload2(bf16x8*kf,lds_cptr kp,int j){ kf[2*j]=*(const __attribute__((address_space(3))) bf16x8*)(kp+j*2048); kf[2*j+1]=*(const __attribute__((address_space(3))) bf16x8*)(kp+j*2048+512); }
__device__ __forceinline__ s16x4 vtr(lds_cptr p){ return __builtin_bit_cast(s16x4,__builtin_amdgcn_ds_read_tr16_b64_v4i16((__attribute__((address_space(3))) v4i16_t*)p)); }
__device__ __forceinline__ float rowmax(const f32x16&p0,const f32x16&p1){
  float a=max3f(p0[0],p0[1],p1[0]),b=max3f(p0[2],p0[3],p1[1]);a=max3f(a,p1[2],p1[3]);
  #pragma unroll
  for(int r=4;r<16;r+=4){a=max3f(a,p0[r],p0[r+1]);b=max3f(b,p0[r+2],p0[r+3]);a=max3f(a,p1[r],p1[r+1]);b=max3f(b,p1[r+2],p1[r+3]);}
  const float m=max2f(a,b);
  auto rr=__builtin_amdgcn_permlane32_swap(__float_as_uint(m),__float_as_uint(m),false,false);
  return max2f(__uint_as_float(rr[0]),__uint_as_float(rr[1]));
}
__device__ __forceinline__ void pv(f32x16*o,int vb,bf16x8 pa0,bf16x8 pa1,bf16x8 pa2,bf16x8 pa3){
  #pragma unroll
  for(int d0=0;d0<2;++d0){s16x4 lo[4],hi[4];
    #pragma unroll
    for(int ks=0;ks<4;++ks){
      asm volatile("ds_read_b64_tr_b16 %0,%1 offset:%c2":"=&v"(lo[ks]):"v"(vb),"i"(d0*4096+ks*1024):"memory");
      asm volatile("ds_read_b64_tr_b16 %0,%1 offset:%c2":"=&v"(hi[ks]):"v"(vb),"i"(d0*4096+ks*1024+512):"memory");}
    asm volatile("s_waitcnt lgkmcnt(0)":::"memory");SBAR();
    #define PK(k) (bf16x8){lo[k][0],lo[k][1],lo[k][2],lo[k][3],hi[k][0],hi[k][1],hi[k][2],hi[k][3]}
    o[d0]=__builtin_amdgcn_mfma_f32_32x32x16_bf16(pa0,PK(0),o[d0],0,0,0);
    o[d0]=__builtin_amdgcn_mfma_f32_32x32x16_bf16(pa1,PK(1),o[d0],0,0,0);
    o[d0]=__builtin_amdgcn_mfma_f32_32x32x16_bf16(pa2,PK(2),o[d0],0,0,0);
    o[d0]=__builtin_amdgcn_mfma_f32_32x32x16_bf16(pa3,PK(3),o[d0],0,0,0);
    #undef PK
  }
}

#ifndef ATTN_STORE16
#define ATTN_STORE16(p,v) (*(u32x4*)(p)=(v))
#endif
template<int THRL> __device__ __forceinline__ void attn_unit(int b,int h,int qb,int ts,const bf16*Q,const bf16*__restrict__ K,const bf16*__restrict__ V,bf16*O,const float*dP,char*shm){
  int tid_=threadIdx.x; asm volatile("":"+v"(tid_));
  const int tid=tid_,lane=tid&63,r32=lane&31,hi=lane>>5; const int wid=__builtin_amdgcn_readfirstlane(tid>>6);
  const long rowbase=(long)b*SEQ; const int q0=qb*QB;
  const bf16*Qw=Q+(rowbase+q0+wid*QBLK)*DM+h*D;
  const bf16*Kh=K+(rowbase+(long)ts*KVBLK)*DM+h*D,*Vh=V+(rowbase+(long)ts*KVBLK)*DM+h*D;
  const unsigned lds0=(unsigned)(uintptr_t)shm;
  float*wsf=(float*)(shm+LDS_WS)+wid*64;
  const bf16*ksrc=Kh+(long)lane*DM+wid*8;
  const bf16*vsrc=Vh+(long)(16*(wid&3)+(lane>>2))*DM+(wid>>2)*32+(lane&3)*8;
  const unsigned kdst=lds0+LDS_K+wid*1024, vdst=lds0+LDS_V+wid*1024;
  #define DMA_K(t,slot) glds16(ksrc+(long)(t)*KVBLK*DM,(unsigned)__builtin_amdgcn_readfirstlane(kdst+(slot)))
  #define DMA_V(t,slot) glds16(vsrc+(long)(t)*KVBLK*DM,(unsigned)__builtin_amdgcn_readfirstlane(vdst+(slot)))
  const int vb0=(int)(lds0+LDS_V)+((lane>>4)&1)*32+(lane&3)*8+(4*hi+((lane&15)>>2))*64;
  const char*Kbase=shm+LDS_K; bf16x8 kf[8];
  const lds_cptr shm3=(lds_cptr)shm; const lds_cptr kp0=shm3+LDS_K+hi*1024+r32*16; const lds_cptr vp0=shm3+LDS_V+((lane>>4)&1)*32+(lane&3)*8+(4*hi+((lane&15)>>2))*64;
  const int NT=(q0+QB)/KVBLK-ts;
  const int nk=NT*KVBLK; float dlv[8]; const float dref=dP[q0+QB-1];
  _Pragma("unroll") for(int j=0;j<8;++j){ const int i=tid+j*NW*64; dlv[j]=dP[ts*KVBLK+(i<nk?i:0)]; }
  #define DLSTORE() do{ __attribute__((address_space(3))) float*dlw=(__attribute__((address_space(3))) float*)(shm3+LDS_DL); \
    _Pragma("unroll") for(int j=0;j<8;++j){ const int i=tid+j*NW*64; if(i<nk)dlw[i]=dlv[j]-dref; } }while(0)
  #define ADDB(P0,P1,t) do{ const __attribute__((address_space(3))) f32x4_t*dp_=(const __attribute__((address_space(3))) f32x4_t*)(shm3+LDS_DL+(t)*256+hi*16); \
    _Pragma("unroll") for(int rr=0;rr<4;++rr){ const f32x4_t a_=dp_[rr*2],b_=dp_[8+rr*2]; \
      _Pragma("unroll") for(int j=0;j<4;++j){P0[4*rr+j]+=a_[j];P1[4*rr+j]+=b_[j];} SBAR(); } }while(0)
  DMA_K(0,0);DMA_V(0,0);DMA_K(1,SLOTB);
  bf16x8 qr[4];
  #pragma unroll
  for(int d0=0;d0<4;++d0)qr[d0]=__builtin_nontemporal_load(reinterpret_cast<const bf16x8*>(&Qw[(long)r32*DM+d0*16+hi*8]));
  float z0_; asm volatile("v_mov_b32 %0, 0":"=v"(z0_));
  float mhat=0.f,l_reg=0.f;f32x16 o[2],negm;
  _Pragma("unroll") for(int r=0;r<16;++r){o[0][r]=z0_;o[1][r]=z0_;negm[r]=z0_;} asm volatile("":"+v"(negm));
  const int qrel=wid*QBLK+r32;
  #define CMASK(P0,P1,t) do{int jb_=(t)-(NT-4); if(jb_>=0)cmask(P0,P1,jb_,qrel,hi);}while(0)
  bool resc=false;
  #define START(P0,P1) do{ const float rm=rowmax(P0,P1); resc=false; \
    { const float dl=rm; mhat=fadd_s(mhat,dl); \
      _Pragma("unroll") for(int r=0;r<16;++r){P0[r]=fsub_s(P0[r],dl);P1[r]=fsub_s(P1[r],dl);} \
      _Pragma("unroll") for(int r=0;r<16;++r)negm[r]=-mhat; asm volatile("":"+v"(negm)); } \
    _Pragma("unroll") for(int r=0;r<16;++r)P0[r]=__builtin_amdgcn_exp2f(P0[r]); }while(0)
  #define RESC() do{ if(resc){ asm volatile("s_waitcnt lgkmcnt(0)":::"memory"); \
      _Pragma("unroll") for(int d_=0;d_<2;++d_) _Pragma("unroll") for(int r=0;r<16;++r)o[d_][r]*=wsf[crow(r,hi)]; } }while(0)
  f32x16 pA0,pA1,pB0,pB1;
  int sl_prev=0,sl_cur=0,sl_next=SLOTB;
  #define ROT() do{sl_prev=sl_cur;sl_cur=sl_next;sl_next=(sl_next==(NSLOT-1)*SLOTB)?0:sl_next+SLOTB;}while(0)
  DMA_K(2,2*SLOTB);
  DLSTORE();
  WAIT_BAR(3);
  qkt(pA0,pA1,Kbase,qr,negm,r32,hi);asm volatile("s_nop 15\n\ts_nop 7":"+v"(pA0),"+v"(pA1));CMASK(pA0,pA1,0);ADDB(pA0,pA1,0);
  START(pA0,pA1);
  _Pragma("unroll") for(int r=0;r<16;++r)pA1[r]=__builtin_amdgcn_exp2f(pA1[r]);
  WAIT_BAR(0);
  DMA_K(3,0);DMA_V(1,SLOTB);
  ROT();
  kload8(kf,kp0+sl_cur);
  WAIT_BAR(2);
  s16x4 vlo[8],vhi[8]; u32x4 pw0,pw1,pw2,pw3;
  #define PKW(P,B) cvtpk_s(P[B],P[B+1])
  #define PAF(k) __builtin_bit_cast(bf16x8,pw##k)
  #define VFR(i) (bf16x8){vlo[i][0],vlo[i][1],vlo[i][2],vlo[i][3],vhi[i][0],vhi[i][1],vhi[i][2],vhi[i][3]}
  #define PIN(x) asm volatile("":"+v"(x))
  #define MX3(a,b,c) __builtin_fmaxf(__builtin_fmaxf((a),(b)),(c))
  #define GAPA(MF,A0,A1,A2,A3,W0,W1,PW) do{ MF; sacc+=A0; sacc+=A1; sacc+=A2; sacc+=A3; PIN(sacc); W0; W1; PIN(PW); SBAR(); }while(0)
  #define EX(v) __builtin_amdgcn_exp2f(v)
  #define GAPB(MF,X,B) do{ MF; X[B]=EX(X[B]); X[B+1]=EX(X[B+1]); X[B+2]=EX(X[B+2]); X[B+3]=EX(X[B+3]); PIN(X); SBAR(); }while(0)
  #define VRD(i) do{ vlo[i]=vtr(vp_+(((i)>>2)*4096+((i)&3)*1024)); vhi[i]=vtr(vp_+(((i)>>2)*4096+((i)&3)*1024+512)); }while(0)
  #define KRD(G,j) do{ if(G){ kload2(kf,kp0+sl_next,j); SBAR(); } }while(0)
  #define STEP(C0,C1,P0,P1,t,GK,GV,GL) do{ SBAR(); \
    const lds_cptr vp_=vp0+sl_prev; \
    VRD(0); SBAR(); float sacc=(P0[0]+P0[1]); \
    GAPA(C0=__builtin_amdgcn_mfma_f32_32x32x16_bf16(kf[0],qr[0],negm,0,0,0), P0[2],P0[3],P0[4],P0[5],     pw0[0]=PKW(P0,0), pw0[1]=PKW(P0,2), pw0); \
    VRD(4); SBAR(); GAPA(C1=__builtin_amdgcn_mfma_f32_32x32x16_bf16(kf[1],qr[0],negm,0,0,0), P0[6],P0[7],P0[8],P0[9],     pw0[2]=PKW(P0,4), pw0[3]=PKW(P0,6), pw0); \
    VRD(1); SBAR(); GAPA(C0=__builtin_amdgcn_mfma_f32_32x32x16_bf16(kf[2],qr[1],C0,0,0,0),   P0[10],P0[11],P0[12],P0[13], pw1[0]=PKW(P0,8), pw1[1]=PKW(P0,10), pw1); \
    VRD(5); SBAR(); GAPA(C1=__builtin_amdgcn_mfma_f32_32x32x16_bf16(kf[3],qr[1],C1,0,0,0),   P0[14],P0[15],P1[0],P1[1],   pw1[2]=PKW(P0,12),pw1[3]=PKW(P0,14), pw1); \
    VRD(2); SBAR(); GAPA(C0=__builtin_amdgcn_mfma_f32_32x32x16_bf16(kf[4],qr[2],C0,0,0,0),   P1[2],P1[3],P1[4],P1[5],     pw2[0]=PKW(P1,0), pw2[1]=PKW(P1,2), pw2); \
    VRD(6); SBAR(); GAPA(C1=__builtin_amdgcn_mfma_f32_32x32x16_bf16(kf[5],qr[2],C1,0,0,0),   P1[6],P1[7],P1[8],P1[9],     pw2[2]=PKW(P1,4), pw2[3]=PKW(P1,6), pw2); \
    VRD(3); SBAR(); GAPA(C0=__builtin_amdgcn_mfma_f32_32x32x16_bf16(kf[6],qr[3],C0,0,0,0),   P1[10],P1[11],P1[12],P1[13], pw3[0]=PKW(P1,8), pw3[1]=PKW(P1,10), pw3); \
    VRD(7); SBAR(); GAPA(C1=__builtin_amdgcn_mfma_f32_32x32x16_bf16(kf[7],qr[3],C1,0,0,0),   P1[14],P1[15],0.f,0.f,       pw3[2]=PKW(P1,12),pw3[3]=PKW(P1,14), pw3); \
    l_reg+=sacc; \
    if(GK){DMA_K((t)+3,sl_cur);} if(GV){DMA_V((t)+1,sl_next);} \
    CMASK(C0,C1,t); ADDB(C0,C1,t); \
    { float a=MX3(C0[0],C0[1],C1[0]),b=MX3(C0[2],C0[3],C1[1]); a=MX3(a,C1[2],C1[3]); \
      _Pragma("unroll") for(int r=4;r<16;r+=4){a=MX3(a,C0[r],C0[r+1]);b=MX3(b,C0[r+2],C0[r+3]);a=MX3(a,C1[r],C1[r+1]);b=MX3(b,C1[r+2],C1[r+3]);} \
      float rm=__builtin_fmaxf(a,b); { auto rr=__builtin_amdgcn_permlane32_swap(__float_as_uint(rm),__float_as_uint(rm),false,false); rm=__builtin_fmaxf(__uint_as_float(rr[0]),__uint_as_float(rr[1])); } \
      resc=false; \
      if(__builtin_expect(__any(rm>(float)THRL),0)){ const float dl=__builtin_fmaxf(rm,0.f); mhat+=dl; \
        _Pragma("unroll") for(int r=0;r<16;++r){C0[r]-=dl;C1[r]-=dl;} \
        _Pragma("unroll") for(int r=0;r<16;++r)negm[r]=-mhat; asm volatile("":"+v"(negm)); \
        const float f=__builtin_amdgcn_exp2f(-dl); l_reg*=f; if(hi==0)wsf[r32]=f; resc=true; } } \
    SBAR(); \
    GAPB(o[0]=__builtin_amdgcn_mfma_f32_32x32x16_bf16(PAF(0),VFR(0),o[0],0,0,0), C0,0); \
    GAPB(o[1]=__builtin_amdgcn_mfma_f32_32x32x16_bf16(PAF(0),VFR(4),o[1],0,0,0), C0,4); \
    KRD(GL,0); GAPB(o[0]=__builtin_amdgcn_mfma_f32_32x32x16_bf16(PAF(1),VFR(1),o[0],0,0,0), C0,8); \
    KRD(GL,1); GAPB(o[1]=__builtin_amdgcn_mfma_f32_32x32x16_bf16(PAF(1),VFR(5),o[1],0,0,0), C0,12); \
    KRD(GL,2); GAPB(o[0]=__builtin_amdgcn_mfma_f32_32x32x16_bf16(PAF(2),VFR(2),o[0],0,0,0), C1,0); \
    KRD(GL,3); GAPB(o[1]=__builtin_amdgcn_mfma_f32_32x32x16_bf16(PAF(2),VFR(6),o[1],0,0,0), C1,4); \
    GAPB(o[0]=__builtin_amdgcn_mfma_f32_32x32x16_bf16(PAF(3),VFR(3),o[0],0,0,0), C1,8); \
    GAPB(o[1]=__builtin_amdgcn_mfma_f32_32x32x16_bf16(PAF(3),VFR(7),o[1],0,0,0), C1,12); \
    }while(0)
  int t=1;
  #undef CMASK
  #define CMASK(P0,P1,t) do{}while(0)
  for(;t+5<NT;t+=2){
    STEP(pB0,pB1,pA0,pA1,t,true,true,true);     WAIT_BAR(2); RESC(); ROT();
    STEP(pA0,pA1,pB0,pB1,t+1,true,true,true);   WAIT_BAR(2); RESC(); ROT();
  }
  #undef CMASK
  #define CMASK(P0,P1,t) do{int jb_=(t)-(NT-4); if(jb_>=0)cmask(P0,P1,jb_,qrel,hi);}while(0)
  #define ENDW(tt) do{ if((tt)+3<NT){WAIT_BAR(2);} else if((tt)+2<NT){WAIT_BAR(1);} else {WAIT_BAR(0);} }while(0)
  for(;t+1<NT;t+=2){
    STEP(pB0,pB1,pA0,pA1,t,(t+3<NT),(t+1<NT),(t+1<NT));       ENDW(t);   RESC(); ROT();
    STEP(pA0,pA1,pB0,pB1,t+1,(t+4<NT),(t+2<NT),(t+2<NT));     ENDW(t+1); RESC(); ROT();
  }
  STEP(pB0,pB1,pA0,pA1,NT-1,false,false,false); RESC();
  { float sacc=pB0[0]+pB0[1]; _Pragma("unroll") for(int r=2;r<16;++r)sacc+=pB0[r]; _Pragma("unroll") for(int r=0;r<16;++r)sacc+=pB1[r]; l_reg+=sacc;
    pw0=(u32x4){PKW(pB0,0),PKW(pB0,2),PKW(pB0,4),PKW(pB0,6)};pw1=(u32x4){PKW(pB0,8),PKW(pB0,10),PKW(pB0,12),PKW(pB0,14)};pw2=(u32x4){PKW(pB1,0),PKW(pB1,2),PKW(pB1,4),PKW(pB1,6)};pw3=(u32x4){PKW(pB1,8),PKW(pB1,10),PKW(pB1,12),PKW(pB1,14)};
    SBAR(); pv(o,vb0+sl_cur,PAF(0),PAF(1),PAF(2),PAF(3)); }
  #undef PKW
  #undef PAF
  #undef VFR
  #undef PIN
  #undef MX3
  #undef GAPA
  #undef GAPB
  #undef EX
  #undef VRD
  #undef KRD
  #undef STEP
  #undef ENDW
  {auto rr=__builtin_amdgcn_permlane32_swap(__float_as_uint(l_reg),__float_as_uint(l_reg),false,false);l_reg=__uint_as_float(rr[0])+__uint_as_float(rr[1]);}
  if(hi==0)wsf[32+r32]=l_reg;asm volatile("s_waitcnt lgkmcnt(0)":::"memory");
  float rli[16];
  #pragma unroll
  for(int r=0;r<16;++r)rli[r]=__builtin_amdgcn_rcpf(wsf[32+crow(r,hi)]);
  bf16*Ow=O+(rowbase+q0+wid*QBLK)*OP+h*D;
  { bf16*stg=(bf16*)(shm+LDS_OST)+wid*2048;
    #pragma unroll
    for(int r=0;r<16;++r){const int orow=crow(r,hi);
      #pragma unroll
      for(int d0=0;d0<2;++d0)stg[orow*64+d0*32+r32]=__float2bfloat16(o[d0][r]*rli[r]);}
    asm volatile("s_waitcnt lgkmcnt(0)":::"memory");
    #pragma unroll
    for(int i=0;i<4;++i){const int row=i*8+(lane>>3),ch=lane&7; const u32x4 v=*(const u32x4*)(stg+row*64+ch*8); ATTN_STORE16(Ow+(long)row*OP+ch*8,v);} }
  asm volatile("s_waitcnt lgkmcnt(0)\n\ts_barrier":::"memory");
  #undef ADDB
  #undef DLSTORE
  #undef DMA_K
  #undef DMA_V
  #undef CMASK
  #undef START
  #undef RESC
  #undef ROT
}
constexpr int ATTN_LDS_BYTES=LDS_BYTES;
#undef SBAR
#undef WAIT_BAR
}
namespace dense_body {
using bf16 = __hip_bfloat16;
constexpr int   D = 128, NW = 8, QBLK = 32, KVBLK = 64;
constexpr float SCALE = 0.088388347648318440f;
constexpr float THR = 8.f;
constexpr int SDEPTH = 2;
constexpr int LDQ = 512, LDK = 512, LDO = 1536;
constexpr size_t SHM_V = KVBLK * D * 2, SHM_K = KVBLK * D * 2, SHM_ATTN = 2 * SHM_V + 2 * SHM_K + NW * 64 * 4;
using bf16x8 = __attribute__((ext_vector_type(8))) short;
using s16x4  = __attribute__((ext_vector_type(4))) short;
using f32x16 = __attribute__((ext_vector_type(16))) float;
using f32x8  = __attribute__((ext_vector_type(8))) float;
using u32x4  = __attribute__((ext_vector_type(4))) unsigned;
#define KSWZ(row, colB) ((row) * 256 + ((colB) ^ (((row) & 7) << 4)))
#define SBAR() __builtin_amdgcn_sched_barrier(0)
__device__ __forceinline__ int crow(int r, int hi) { return (r & 3) + 8 * (r >> 2) + 4 * hi; }
__device__ __forceinline__ unsigned cvtpk(float lo, float hi) {
  unsigned r; asm volatile("v_cvt_pk_bf16_f32 %0, %1, %2" : "=v"(r) : "v"(lo), "v"(hi)); return r;
}
template <typename TIn> struct Stage;
template <> struct Stage<bf16>  { using T = bf16x8;
  __device__ static __forceinline__ T ld8(const bf16* p) { return *reinterpret_cast<const bf16x8*>(p); }
  __device__ static __forceinline__ bf16x8 tobf(T x) { return x; } };
template <> struct Stage<float> { using T = f32x8;
  __device__ static __forceinline__ T ld8(const float* p) { return *reinterpret_cast<const f32x8*>(p); }
  __device__ static __forceinline__ bf16x8 tobf(T x) {
    u32x4 w = {cvtpk(x[0], x[1]), cvtpk(x[2], x[3]), cvtpk(x[4], x[5]), cvtpk(x[6], x[7])}; return *reinterpret_cast<bf16x8*>(&w); } };

__device__ __forceinline__ void partialSM(f32x16& p0, f32x16& p1, float& m_reg, float& mn, float& alpha) {
  constexpr float C = SCALE * 1.4426950408889634f;
  float pmax = p0[0]; for (int r = 1; r < 16; ++r) pmax = fmaxf(pmax, p0[r]); for (int r = 0; r < 16; ++r) pmax = fmaxf(pmax, p1[r]);
  { auto rr = __builtin_amdgcn_permlane32_swap(__float_as_uint(pmax), __float_as_uint(pmax), false, false);
    pmax = fmaxf(__uint_as_float(rr[0]), __uint_as_float(rr[1])); }
  if (__builtin_expect(__all(pmax - m_reg <= THR / SCALE), 1)) { mn = m_reg; alpha = 1.f; }
  else { mn = fmaxf(m_reg, pmax); alpha = __builtin_amdgcn_exp2f((m_reg - mn) * C); m_reg = mn; }
  float mnC = -mn * C;
  for (int r = 0; r < 16; ++r) p0[r] = fmaf(p0[r], C, mnC); for (int r = 0; r < 16; ++r) p1[r] = fmaf(p1[r], C, mnC);
  for (int r = 0; r < 16; ++r) p0[r] = __builtin_amdgcn_exp2f(p0[r]);
}
__device__ __forceinline__ void finishSM(f32x16& p0, f32x16& p1, float alpha, float& l_reg, bf16x8& pa0, bf16x8& pa1, bf16x8& pa2, bf16x8& pa3) {
  for (int r = 0; r < 16; ++r) p1[r] = __builtin_amdgcn_exp2f(p1[r]);
  float ps = 0; for (int r = 0; r < 16; ++r) ps += p0[r]; for (int r = 0; r < 16; ++r) ps += p1[r];
  { auto rr = __builtin_amdgcn_permlane32_swap(__float_as_uint(ps), __float_as_uint(ps), false, false);
    ps = __uint_as_float(rr[0]) + __uint_as_float(rr[1]); }
  l_reg = l_reg * alpha + ps;
#define PK4(P, BASE, OUT) do { unsigned a0 = cvtpk(P[BASE + 0], P[BASE + 1]), a1 = cvtpk(P[BASE + 2], P[BASE + 3]);   \
    unsigned b0 = cvtpk(P[BASE + 4], P[BASE + 5]), b1 = cvtpk(P[BASE + 6], P[BASE + 7]);                              \
    auto r0 = __builtin_amdgcn_permlane32_swap(a0, b0, false, false); auto r1 = __builtin_amdgcn_permlane32_swap(a1, b1, false, false); \
    u32x4 w = {r0[0], r1[0], r0[1], r1[1]}; OUT = *reinterpret_cast<bf16x8*>(&w); } while (0)
  PK4(p0, 0, pa0); PK4(p0, 8, pa1); PK4(p1, 0, pa2); PK4(p1, 8, pa3);
#undef PK4
}
__device__ __forceinline__ void qkt(f32x16& p0, f32x16& p1, const bf16* Ks, const bf16x8* qr, int r32, int hi) {
  p0 = f32x16{}; p1 = f32x16{};
  for (int d0 = 0; d0 < 8; ++d0) { int cb = (d0 * 16 + hi * 8) * 2;
    bf16x8 b0 = *reinterpret_cast<const bf16x8*>((const char*)Ks + KSWZ(r32, cb));
    bf16x8 b1 = *reinterpret_cast<const bf16x8*>((const char*)Ks + KSWZ(32 + r32, cb));
    p0 = __builtin_amdgcn_mfma_f32_32x32x16_bf16(b0, qr[d0], p0, 0, 0, 0);
    p1 = __builtin_amdgcn_mfma_f32_32x32x16_bf16(b1, qr[d0], p1, 0, 0, 0); }
}
__device__ __forceinline__ int v_st(int k, int c) { const int kk = (k & ~0xC) | ((k & 4) << 1) | ((k & 8) >> 1); return ((kk >> 3) * 4 + (c >> 5)) * 512 + ((kk & 7) * 32 + (c & 31)) * 2; }
__device__ __forceinline__ int v_rd_base(int lane) { return ((lane & 3) << 3) | (((lane >> 2) & 3) << 6) | (((lane >> 4) & 1) << 5) | (((lane >> 5) & 1) << 8); }
constexpr int v_rd_off(int d0, int ks, int half) { return d0 * 512 + ks * 4096 + half * 2048; }
template <int OFF> __device__ __forceinline__ s16x4 tr_read(int vb) {
  s16x4 r; asm volatile("ds_read_b64_tr_b16 %0, %1 offset:%2" : "=&v"(r) : "v"(vb), "i"(OFF) : "memory"); return r;
}
template <int D0> __device__ __forceinline__ void pv_one(f32x16& od, int vb, bf16x8 pa0, bf16x8 pa1, bf16x8 pa2, bf16x8 pa3) {
  const s16x4 l0 = tr_read<v_rd_off(D0, 0, 0)>(vb), h0 = tr_read<v_rd_off(D0, 0, 1)>(vb), l1 = tr_read<v_rd_off(D0, 1, 0)>(vb), h1 = tr_read<v_rd_off(D0, 1, 1)>(vb);
  const s16x4 l2 = tr_read<v_rd_off(D0, 2, 0)>(vb), h2 = tr_read<v_rd_off(D0, 2, 1)>(vb), l3 = tr_read<v_rd_off(D0, 3, 0)>(vb), h3 = tr_read<v_rd_off(D0, 3, 1)>(vb);
  asm volatile("s_waitcnt lgkmcnt(0)" ::: "memory"); SBAR();
#define PK(L, H) (bf16x8){L[0], L[1], L[2], L[3], H[0], H[1], H[2], H[3]}
  od = __builtin_amdgcn_mfma_f32_32x32x16_bf16(pa0, PK(l0, h0), od, 0, 0, 0);
  od = __builtin_amdgcn_mfma_f32_32x32x16_bf16(pa1, PK(l1, h1), od, 0, 0, 0);
  od = __builtin_amdgcn_mfma_f32_32x32x16_bf16(pa2, PK(l2, h2), od, 0, 0, 0);
  od = __builtin_amdgcn_mfma_f32_32x32x16_bf16(pa3, PK(l3, h3), od, 0, 0, 0);
#undef PK
}
__device__ __forceinline__ void pv_d0(f32x16* o, int vb, bf16x8 pa0, bf16x8 pa1, bf16x8 pa2, bf16x8 pa3) {
  pv_one<0>(o[0], vb, pa0, pa1, pa2, pa3); pv_one<1>(o[1], vb, pa0, pa1, pa2, pa3); pv_one<2>(o[2], vb, pa0, pa1, pa2, pa3); pv_one<3>(o[3], vb, pa0, pa1, pa2, pa3);
}

__device__ __forceinline__ void mem_stage_kv(const bf16* __restrict__ Kh, const bf16* __restrict__ Vh, char* kv) {
  const int tid = threadIdx.x, sr = tid >> 4, sc = (tid & 15) * 8;
  bf16x8 kr[4][2], vr[4][2];
#pragma unroll
  for (int t = 0; t < 4; ++t) { kr[t][0] = *reinterpret_cast<const bf16x8*>(&Kh[(long)(t * 64 + sr) * LDK + sc]); kr[t][1] = *reinterpret_cast<const bf16x8*>(&Kh[(long)(t * 64 + 32 + sr) * LDK + sc]);
                                vr[t][0] = *reinterpret_cast<const bf16x8*>(&Vh[(long)(t * 64 + sr) * LDK + sc]); vr[t][1] = *reinterpret_cast<const bf16x8*>(&Vh[(long)(t * 64 + 32 + sr) * LDK + sc]); }
#pragma unroll
  for (int t = 0; t < 4; ++t) { char* kb = kv + t * SHM_K; char* vb = kv + 4 * SHM_K + t * SHM_V; const int kc = sc * 2;
    *(bf16x8*)(kb + KSWZ(sr, kc)) = kr[t][0]; *(bf16x8*)(kb + KSWZ(32 + sr, kc)) = kr[t][1];
    *(bf16x8*)(vb + v_st(sr, sc)) = vr[t][0]; *(bf16x8*)(vb + v_st(32 + sr, sc)) = vr[t][1]; }
  __syncthreads();
}
__device__ __forceinline__ void mem_qblock(const bf16* __restrict__ Qb, bf16* __restrict__ Ob, char* kv, char* scr, char* stg_all) {
  int tid_ = threadIdx.x; asm volatile("" : "+v"(tid_));
  const int tid = tid_, wid = tid >> 6, lane = tid & 63, r32 = lane & 31, hi = lane >> 5;
  float* ws = (float*)scr + wid * 64; float* li_l = ws; float* al_l = ws + 32;
  float m_reg = -1e30f, l_reg = 0; f32x16 o[4] = {}; bf16x8 qr[8];
  const bf16* Qw = Qb + (long)(wid * QBLK + r32) * LDQ + hi * 8;
#pragma unroll
  for (int d0 = 0; d0 < 8; ++d0) qr[d0] = *reinterpret_cast<const bf16x8*>(Qw + d0 * 16);
  const int vb0 = (int)(uintptr_t)(kv + 4 * SHM_K) + v_rd_base(lane);
#pragma unroll
  for (int t = 0; t < 4; ++t) {
    f32x16 p0, p1; float mn, al; bf16x8 pa0, pa1, pa2, pa3;
    qkt(p0, p1, (const bf16*)(kv + t * SHM_K), qr, r32, hi);
    partialSM(p0, p1, m_reg, mn, al);
    if (__any(al < 1.f)) { if (hi == 0) al_l[r32] = al; asm volatile("s_waitcnt lgkmcnt(0)" ::: "memory");
#pragma unroll
      for (int d = 0; d < 4; ++d)
#pragma unroll
        for (int r = 0; r < 16; ++r) o[d][r] *= al_l[crow(r, hi)]; }
    finishSM(p0, p1, al, l_reg, pa0, pa1, pa2, pa3); SBAR();
    pv_d0(o, vb0 + t * (int)SHM_V, pa0, pa1, pa2, pa3);
  }
  if (hi == 0) li_l[r32] = l_reg; asm volatile("s_waitcnt lgkmcnt(0)" ::: "memory");
  float rli[16];
#pragma unroll
  for (int r = 0; r < 16; ++r) rli[r] = __builtin_amdgcn_rcpf(li_l[crow(r, hi)]);
  bf16* stg = (bf16*)stg_all + wid * 1024;
  bf16* Ow = Ob + (long)(wid * QBLK) * LDO;
#pragma unroll
  for (int d0 = 0; d0 < 4; ++d0) {
#pragma unroll
    for (int r = 0; r < 16; ++r) stg[crow(r, hi) * 32 + r32] = __float2bfloat16(o[d0][r] * rli[r]);
    asm volatile("s_waitcnt lgkmcnt(0)" ::: "memory");
#pragma unroll
    for (int i = 0; i < 2; ++i) { const int row = i * 16 + (lane >> 2), ch = lane & 3; const u32x4 v = *(const u32x4*)(stg + row * 32 + ch * 8); *(u32x4*)(Ow + (long)row * LDO + d0 * 32 + ch * 8) = v; }
    asm volatile("s_waitcnt lgkmcnt(0)" ::: "memory");
  }
}
#undef KSWZ
#undef SBAR
}
namespace small_attn {
typedef float f32x4 __attribute__((ext_vector_type(4)));
typedef unsigned u32x4 __attribute__((ext_vector_type(4)));
typedef unsigned short bf16_t;
#define SA_LAS __attribute__((address_space(3)))
__device__ __forceinline__ float bf2f(unsigned short b) { return __uint_as_float((unsigned)b << 16); }
typedef float sa_f32x2 __attribute__((ext_vector_type(2))); typedef __bf16 sa_bf16x2 __attribute__((ext_vector_type(2)));
__device__ __forceinline__ unsigned pk2s(float lo, float hi) { sa_f32x2 v = {lo, hi}; sa_bf16x2 b = __builtin_convertvector(v, sa_bf16x2); return __builtin_bit_cast(unsigned, b); }
__device__ __forceinline__ unsigned short f2bf(float f) { unsigned u = __float_as_uint(f); return (unsigned short)((u + 0x7fffu + ((u >> 16) & 1u)) >> 16); }
template <int DH, bool FOX>
__device__ __forceinline__ void unit(const bf16_t* Q, const float* Kc, const float* Vc, const bf16_t* Kn, const bf16_t* Vn, const float* dS, bf16_t* O, float qscale, SA_LAS unsigned char* lds) {
    constexpr int DB = DH / 16, NBC = FOX ? 16 : 2, NB = FOX ? 17 : 2, CP = 512;
    const int tid = threadIdx.x, lane = tid & 63, i = lane & 15, g = lane >> 4; const int wid = __builtin_amdgcn_readfirstlane(tid >> 6);
    typedef short bf16x8s __attribute__((ext_vector_type(8)));
    constexpr int NT32 = DH / 32;
    bf16x8s qf[NT32];
#pragma unroll
    for (int t = 0; t < NT32; ++t) qf[t] = *(const bf16x8s*)(Q + (size_t)i * 512 + 32 * t + 8 * g);
    const float dref = FOX ? dS[2063] : 0.f;
    f32x4 s[NB];
    const int kb0 = wid * NBC * 16;
    constexpr int GB = FOX ? 4 : 2;
    f32x4 kb[2][GB][NT32][2];
#define SA_LOADK(buf, grp) do { _Pragma("unroll") for (int b_ = 0; b_ < GB; ++b_) { const float* kp_ = Kc + (size_t)(kb0 + ((grp) * GB + b_) * 16 + i) * CP + 8 * g; \
        _Pragma("unroll") for (int t_ = 0; t_ < NT32; ++t_) { kb[buf][b_][t_][0] = __builtin_nontemporal_load((const f32x4*)(kp_ + 32 * t_)); kb[buf][b_][t_][1] = __builtin_nontemporal_load((const f32x4*)(kp_ + 32 * t_ + 4)); } } } while (0)
    SA_LOADK(0, 0);
#pragma unroll
    for (int grp = 0; grp < NBC / GB; ++grp) {
        if (grp + 1 < NBC / GB) SA_LOADK((grp + 1) & 1, grp + 1);
#pragma unroll
        for (int b_ = 0; b_ < GB; ++b_) { f32x4 a = (f32x4){0.f, 0.f, 0.f, 0.f};
#pragma unroll
            for (int t = 0; t < NT32; ++t) { const f32x4 k0 = kb[grp & 1][b_][t][0], k1 = kb[grp & 1][b_][t][1];
                u32x4 w; w.x = pk2s(k0[0], k0[1]); w.y = pk2s(k0[2], k0[3]); w.z = pk2s(k1[0], k1[1]); w.w = pk2s(k1[2], k1[3]);
                a = __builtin_amdgcn_mfma_f32_16x16x32_bf16(__builtin_bit_cast(bf16x8s, w), qf[t], a, 0, 0, 0); }
            const int blk = grp * GB + b_;
            if (FOX) { const f32x4 bv = *(const f32x4*)(dS + kb0 + blk * 16 + 4 * g); a = a + (bv - dref); } else { a = a * qscale; }
            s[blk] = a; }
    }
#undef SA_LOADK
    if constexpr (FOX) {
        f32x4 a = (f32x4){0.f, 0.f, 0.f, 0.f};
        if (wid == 7) {
#pragma unroll
            for (int t = 0; t < NT32; ++t) a = __builtin_amdgcn_mfma_f32_16x16x32_bf16(*(const bf16x8s*)(Kn + (size_t)i * 512 + 32 * t + 8 * g), qf[t], a, 0, 0, 0);
            const f32x4 bv = *(const f32x4*)(dS + 2048 + 4 * g); a = a + (bv - dref);
#pragma unroll
            for (int r = 0; r < 4; ++r) if (4 * g + r > i) a[r] = -INFINITY;
        } else { a = (f32x4){-INFINITY, -INFINITY, -INFINITY, -INFINITY}; }
        s[NB - 1] = a;
    }
    float mx = -INFINITY;
#pragma unroll
    for (int blk = 0; blk < NB; ++blk) mx = fmaxf(fmaxf(mx, fmaxf(s[blk][0], s[blk][1])), fmaxf(s[blk][2], s[blk][3]));
    mx = fmaxf(mx, __shfl_xor(mx, 16)); mx = fmaxf(mx, __shfl_xor(mx, 32));
    float ls = 0.f;
#pragma unroll
    for (int blk = 0; blk < NB; ++blk)
#pragma unroll
        for (int r = 0; r < 4; ++r) { const float p = __builtin_amdgcn_exp2f(s[blk][r] - mx); s[blk][r] = p; ls += p; }
    ls += __shfl_xor(ls, 16); ls += __shfl_xor(ls, 32);
    f32x4 oacc[DB];
#pragma unroll
    for (int db = 0; db < DB; ++db) oacc[db] = (f32x4){0.f, 0.f, 0.f, 0.f};
    { f32x4 vb[2][GB][4][DB / 4];
#define SA_LOADV(buf, grp) do { _Pragma("unroll") for (int b_ = 0; b_ < GB; ++b_) _Pragma("unroll") for (int st_ = 0; st_ < 4; ++st_) { const float* vp_ = Vc + (size_t)(kb0 + ((grp) * GB + b_) * 16 + 4 * g + st_) * CP + DB * i; \
        _Pragma("unroll") for (int c_ = 0; c_ < DB / 4; ++c_) vb[buf][b_][st_][c_] = __builtin_nontemporal_load((const f32x4*)(vp_ + 4 * c_)); } } while (0)
      SA_LOADV(0, 0);
#pragma unroll
      for (int grp = 0; grp < NBC / GB; ++grp) {
          if (grp + 1 < NBC / GB) SA_LOADV((grp + 1) & 1, grp + 1);
#pragma unroll
          for (int b_ = 0; b_ < GB; ++b_)
#pragma unroll
              for (int st = 0; st < 4; ++st)
#pragma unroll
                  for (int c = 0; c < DB / 4; ++c) { const f32x4 vv = vb[grp & 1][b_][st][c];
#pragma unroll
                      for (int e = 0; e < 4; ++e) oacc[4 * c + e] = __builtin_amdgcn_mfma_f32_16x16x4f32(s[grp * GB + b_][st], vv[e], oacc[4 * c + e], 0, 0, 0); } }
#undef SA_LOADV
    }
    if constexpr (FOX) { if (wid == 7) {
#pragma unroll
        for (int st = 0; st < 4; ++st) { const bf16_t* vp = Vn + (size_t)(4 * g + st) * 512 + DB * i;
            const unsigned long long w = *(const unsigned long long*)vp;
            const float vf[4] = {__uint_as_float((unsigned)(w << 16) & 0xffff0000u), __uint_as_float((unsigned)w & 0xffff0000u), __uint_as_float((unsigned)(w >> 16) & 0xffff0000u), __uint_as_float((unsigned)(w >> 32) & 0xffff0000u)};
#pragma unroll
            for (int e = 0; e < 4; ++e) oacc[e] = __builtin_amdgcn_mfma_f32_16x16x4f32(s[NB - 1][st], vf[e], oacc[e], 0, 0, 0); } } }
    SA_LAS float* Ml = (SA_LAS float*)lds; SA_LAS float* Ll = Ml + 128; SA_LAS float* Ol = Ll + 128;
    if (g == 0) { Ml[wid * 16 + i] = mx; Ll[wid * 16 + i] = ls; }
#pragma unroll
    for (int r = 0; r < 4; ++r)
#pragma unroll
        for (int c = 0; c < DB / 4; ++c) *(SA_LAS f32x4*)(Ol + (size_t)(wid * 16 + 4 * g + r) * DH + DB * i + 4 * c) = (f32x4){oacc[4 * c + 0][r], oacc[4 * c + 1][r], oacc[4 * c + 2][r], oacc[4 * c + 3][r]};
    __syncthreads();
    for (int e = tid; e < 16 * DH; e += 512) { const int q = e / DH, d = e % DH;
        float M = Ml[q];
#pragma unroll
        for (int w = 1; w < 8; ++w) M = fmaxf(M, Ml[w * 16 + q]);
        float num = 0.f, den = 0.f;
#pragma unroll
        for (int w = 0; w < 8; ++w) { const float f = __builtin_amdgcn_exp2f(Ml[w * 16 + q] - M); num += f * Ol[(size_t)(w * 16 + q) * DH + d]; den += f * Ll[w * 16 + q]; }
        O[(size_t)q * 1536 + d] = f2bf(num / den); }
    __syncthreads();
}
#undef SA_LAS
}
constexpr int NWAVES = 8;
constexpr int DM = 1024, FF = 4096, TOKP = 32768, TOKS = 256, TOK = TOKP + TOKS, NMEMROWS = 2048, NIN = 5632;
constexpr float EPS = 1e-6f;
constexpr size_t MiB = 1u << 20;
constexpr size_t WS_CTL = 0, CTL_ZERO_BYTES = 1 * MiB;
constexpr size_t WS_W1T = 1 * MiB;
constexpr size_t WS_WMT = 14 * MiB;
constexpr size_t WS_WOT = 17 * MiB;
constexpr size_t WS_WUT = 19 * MiB;
constexpr int FFP = FF + 64;
constexpr size_t WS_WDT = 497 * MiB;
constexpr size_t WS_DP = 35 * MiB;
constexpr size_t WS_DS = 36 * MiB;
constexpr size_t WS_Q = 40 * MiB, ACT512 = (size_t)TOK * 512 * 2;
constexpr size_t WS_K = WS_Q + ACT512, WS_V = WS_K + ACT512, WS_U = WS_V + ACT512, WS_QM = WS_U + ACT512;
constexpr size_t WS_MK = 202 * MiB, WS_MV = 204 * MiB;
constexpr size_t WS_G = 206 * MiB;
constexpr size_t WS_XN8 = 304 * MiB;
constexpr size_t WS_W8 = 340 * MiB, WS_SX = 344 * MiB, WS_SW = 345 * MiB;
constexpr size_t WS_AM = 400 * MiB;
constexpr size_t WS_END = 506 * MiB;
constexpr size_t WS_MM = WS_Q;
constexpr size_t WS_HB = WS_V;
constexpr size_t WS_A2 = WS_G;
static_assert(WS_QM + ACT512 <= WS_MK && WS_G + (size_t)TOK * 3072 * 2 <= WS_AM && WS_AM + (size_t)TOK * 1536 * 2 <= WS_END && WS_A2 + (size_t)TOK * FFP * 2 <= WS_AM + (size_t)TOK * 1536 * 2 && WS_WDT + (size_t)1024 * FFP * 2 <= WS_END, "d_ws map");
static_assert(WS_MM + (size_t)TOK * 2048 <= WS_V && WS_HB + (size_t)TOK * 2048 <= WS_QM && WS_DS + 128 * 2064 * 4 <= WS_Q, "d_ws overlays");
constexpr int CW_BAR = 4096, CW_SSQ1 = 65536, CW_SSQ2 = 131072, CW_NRM = 2304, CW_QUEUE = 2600, CW_W8RDY = 2664, CW_Q1 = 2700, CW_Q2 = 2832, CW_Q3 = 2976, CW_CMAX = 32768, CW_CNT = 16384;
static_assert((CW_SSQ2 + TOK) * 4 <= (int)CTL_ZERO_BYTES, "CTL words inside the memset region");
constexpr int RING_OFF = 0, RING_BYTES = 131072, LDS_BYTES = 163840, LDSCTL_OFF = LDS_BYTES - 1024, MISC_OFF = LDSCTL_OFF + 320;
constexpr int TSCR_WAVE = 64 * 65 * 4, MEMSC_OFF = 8 * TSCR_WAVE, MEMST_OFF = MEMSC_OFF + 2048;
static_assert(MEMSC_OFF >= RING_BYTES && MEMST_OFF + 16384 <= LDSCTL_OFF, "LDS map");
constexpr int RTAB_OFF = MEMST_OFF + 16384;
constexpr int STAB_OFF = RTAB_OFF + 1024;
static_assert(STAB_OFF + 2304 <= LDSCTL_OFF, "LDS map");

#define GAS __attribute__((address_space(1)))
#define LAS __attribute__((address_space(3)))
typedef unsigned short bf16;
typedef unsigned v4u __attribute__((ext_vector_type(4)));
typedef float f32x4 __attribute__((ext_vector_type(4)));
typedef short bf16x8 __attribute__((ext_vector_type(8)));
typedef GAS unsigned gu32;
typedef GAS unsigned long long gu64;
#define RLX_AGENT __ATOMIC_RELAXED, __HIP_MEMORY_SCOPE_AGENT
#define LDS_WAIT() asm volatile("s_waitcnt lgkmcnt(0)" ::: "memory")
#define VM_WAIT() asm volatile("s_waitcnt vmcnt(0)" ::: "memory")
__device__ __forceinline__ unsigned long long rt() { return __builtin_amdgcn_s_memrealtime(); }
__device__ __forceinline__ unsigned f2bf(float f) { unsigned u = __builtin_bit_cast(unsigned, f); return (u + 0x7fffu + ((u >> 16) & 1u)) >> 16; }
typedef float pk_f32x2 __attribute__((ext_vector_type(2))); typedef __bf16 pk_bf16x2 __attribute__((ext_vector_type(2)));
__device__ __forceinline__ unsigned pk2(float lo, float hi) { pk_f32x2 v = {lo, hi}; return __builtin_bit_cast(unsigned, __builtin_convertvector(v, pk_bf16x2)); }

#define XB_TMO      128
#define XB_XCNT(j)  (256  + 64 * (j))
#define XB_XSUB(j)  (1280 + 64 * (j))
#define XB_XGEN(j)  (2304 + 64 * (j))
#define XB_TOP      3328
#define XB_TOPGEN   3392
#define XCD_BAR_WORDS 3456
#define XB_SPIN_CAP (1u << 18)

__device__ __forceinline__ unsigned xb_ld(unsigned* p)              { return __hip_atomic_load(p, __ATOMIC_RELAXED, __HIP_MEMORY_SCOPE_AGENT); }
__device__ __forceinline__ unsigned xb_add(unsigned* p, unsigned v) { return __hip_atomic_fetch_add(p, v, __ATOMIC_RELAXED, __HIP_MEMORY_SCOPE_AGENT); }
__device__ __forceinline__ unsigned xb_xcc_id() { return (unsigned)__builtin_amdgcn_s_getreg((3 << 11) | 20) & 0xFu; }
#define XB_SPIN(cond, bar) do { unsigned _sp = 0; while (cond) { __builtin_amdgcn_s_sleep(1); \
    if ((++_sp & 255u) == 0u) { if (xb_ld(&(bar)[XB_TMO])) break; if (_sp > XB_SPIN_CAP) { atomicAdd(&(bar)[XB_TMO], 1u); break; } } } } while (0)

struct XcdBarrier {
    unsigned* bar; unsigned x;
    volatile LAS unsigned* st;
};

__device__ __forceinline__ XcdBarrier xcd_barrier_post(unsigned* bar, volatile LAS unsigned* st) {
    XcdBarrier b; b.bar = bar; b.x = xb_xcc_id(); b.st = st;
    if (threadIdx.x == 0) (void)xb_add(&bar[XB_XCNT(b.x)], 1u);
    return b;
}
__device__ __forceinline__ void xcd_barrier_complete(unsigned* bar, unsigned x, unsigned& nloc, unsigned& nx) {
    const unsigned G = gridDim.x * gridDim.y * gridDim.z;
    unsigned sum, cnt, mine, sp = 0u;
    for (;;) {
        sum = 0u; cnt = 0u; mine = 0u;
#pragma unroll
        for (unsigned j = 0; j < 16; ++j) { const unsigned c = xb_ld(&bar[XB_XCNT(j)]); sum += c; cnt += (c > 0u) ? 1u : 0u; mine = (j == x) ? c : mine; }
        if (sum == G) break;
        __builtin_amdgcn_s_sleep(1);
        if ((++sp & 255u) == 0u) { if (xb_ld(&bar[XB_TMO])) break; if (sp > XB_SPIN_CAP) { atomicAdd(&bar[XB_TMO], 1u); break; } }
    }
    nloc = mine > 0u ? mine : 1u; nx = cnt > 0u ? cnt : 1u;
}

__device__ __forceinline__ void xcd_barrier(const XcdBarrier& b) {
    asm volatile("s_waitcnt vmcnt(0)" ::: "memory");
    __syncthreads();
    if (threadIdx.x == 0) {
        unsigned* bar = b.bar;
        __builtin_amdgcn_s_waitcnt(0);
        unsigned nloc = b.st[0], nx = b.st[1];
        if (nloc == 0u) { xcd_barrier_complete(bar, b.x, nloc, nx); b.st[0] = nloc; b.st[1] = nx; }
        const unsigned old = xb_add(&bar[XB_XSUB(b.x)], 1u);
        const unsigned gen = old / nloc;
        if (old + 1u == (gen + 1u) * nloc) {
            __builtin_amdgcn_fence(__ATOMIC_RELEASE, "agent");
            asm volatile("s_waitcnt vmcnt(0)" ::: "memory");
            const unsigned og = xb_add(&bar[XB_TOP], 1u);
            const unsigned tg = og / nx;
            if (og + 1u == (tg + 1u) * nx) xb_add(&bar[XB_TOPGEN], 1u);
            else XB_SPIN(xb_ld(&bar[XB_TOPGEN]) == tg, bar);
            __builtin_amdgcn_fence(__ATOMIC_ACQUIRE, "agent");
            xb_add(&bar[XB_XGEN(b.x)], 1u);
            asm volatile("s_waitcnt vmcnt(0)" ::: "memory");
        } else {
            XB_SPIN(xb_ld(&bar[XB_XGEN(b.x)]) == gen, bar);
            __builtin_amdgcn_fence(__ATOMIC_ACQUIRE, "agent");
            asm volatile("s_waitcnt vmcnt(0)" ::: "memory");
        }
    }
    __syncthreads();
}
__device__ __forceinline__ float bf2f(unsigned short b);
__device__ __forceinline__ float bf2f(unsigned short b) { return __uint_as_float((unsigned)b << 16); }
#define DPP_ADD(v, ctrl) ((v) + __builtin_bit_cast(float, __builtin_amdgcn_update_dpp(0, __builtin_bit_cast(int, (v)), (ctrl), 0xf, 0xf, false)))
#define DPP_ROR_ADD(v, n) ((v) + __builtin_bit_cast(float, __builtin_amdgcn_update_dpp(0, __builtin_bit_cast(int, (v)), 0x120 + (n), 0xf, 0xf, false)))
__device__ __forceinline__ float swap16_add(float a, float b) { auto r = __builtin_amdgcn_permlane16_swap(__float_as_uint(a), __float_as_uint(b), false, false); return __uint_as_float(r[0]) + __uint_as_float(r[1]); }
__device__ __forceinline__ float swap32_add(float a, float b) { auto r = __builtin_amdgcn_permlane32_swap(__float_as_uint(a), __float_as_uint(b), false, false); return __uint_as_float(r[0]) + __uint_as_float(r[1]); }
#define DPP_MAX(v, ctrl) fmaxf((v), __builtin_bit_cast(float, __builtin_amdgcn_update_dpp(0, __builtin_bit_cast(int, (v)), (ctrl), 0xf, 0xf, false)))
__device__ __forceinline__ float wave_max_abs(float v) {
    v = DPP_MAX(v, 0x128); v = DPP_MAX(v, 0x124); v = DPP_MAX(v, 0x122); v = DPP_MAX(v, 0x121);
    { auto r = __builtin_amdgcn_permlane16_swap(__float_as_uint(v), __float_as_uint(v), false, false); v = fmaxf(__uint_as_float(r[0]), __uint_as_float(r[1])); }
    { auto r = __builtin_amdgcn_permlane32_swap(__float_as_uint(v), __float_as_uint(v), false, false); v = fmaxf(__uint_as_float(r[0]), __uint_as_float(r[1])); }
    return v;
}
__device__ __forceinline__ float wave_sum(float v) {
    v = DPP_ROR_ADD(v, 8); v = DPP_ROR_ADD(v, 4); v = DPP_ROR_ADD(v, 2); v = DPP_ROR_ADD(v, 1);
    v = swap16_add(v, v); return swap32_add(v, v);
}
typedef short sg_bf16x8 __attribute__((ext_vector_type(8)));
typedef float sg_f32x16 __attribute__((ext_vector_type(16)));
typedef float sg_f32x4 __attribute__((ext_vector_type(4)));
__device__ __forceinline__ void sg_partial(const bf16* A, int lda, const bf16* Bt, int ldb, int ksteps  , LAS float* part, int lane) {
    const int i = lane & 15, g = lane >> 4;
    const bf16* ap = A + (size_t)i * lda + 8 * g; const bf16* bp = Bt + (size_t)i * ldb + 8 * g;
    sg_f32x4 acc[2][2];
#pragma unroll
    for (int a = 0; a < 2; ++a)
#pragma unroll
        for (int b = 0; b < 2; ++b) acc[a][b] = (sg_f32x4){0.f, 0.f, 0.f, 0.f};
#pragma unroll 8
    for (int s = 0; s < ksteps / 2; ++s) {
        const sg_bf16x8 a0 = *(const GAS sg_bf16x8*)(ap + 32 * s), a1 = *(const GAS sg_bf16x8*)(ap + (size_t)16 * lda + 32 * s), b0 = *(const GAS sg_bf16x8*)(bp + 32 * s), b1 = *(const GAS sg_bf16x8*)(bp + (size_t)16 * ldb + 32 * s);
        acc[0][0] = __builtin_amdgcn_mfma_f32_16x16x32_bf16(a0, b0, acc[0][0], 0, 0, 0); acc[0][1] = __builtin_amdgcn_mfma_f32_16x16x32_bf16(a0, b1, acc[0][1], 0, 0, 0);
        acc[1][0] = __builtin_amdgcn_mfma_f32_16x16x32_bf16(a1, b0, acc[1][0], 0, 0, 0); acc[1][1] = __builtin_amdgcn_mfma_f32_16x16x32_bf16(a1, b1, acc[1][1], 0, 0, 0); }
#pragma unroll
    for (int a = 0; a < 2; ++a)
#pragma unroll
        for (int b = 0; b < 2; ++b)
#pragma unroll
            for (int r = 0; r < 4; ++r) part[(16 * a + 4 * g + r) * 33 + 16 * b + i] = acc[a][b][r];
}
__device__ __forceinline__ void sg_tile(const bf16* A, int lda, const bf16* Bt, int ldb, int K, LAS float* part, int tid, float& c0, float& c1) {
    const int lane = tid & 63, wv = __builtin_amdgcn_readfirstlane(tid >> 6), kw = K / 8;
    __syncthreads();
    sg_partial(A + wv * kw, lda, Bt + wv * kw, ldb, kw / 16, part + wv * (32 * 33), lane);
    __syncthreads();
    const int row = tid >> 4, cc = (tid & 15) * 2; float s0 = 0.f, s1 = 0.f;
#pragma unroll
    for (int w = 0; w < 8; ++w) { s0 += part[w * (32 * 33) + row * 33 + cc]; s1 += part[w * (32 * 33) + row * 33 + cc + 1]; }
    c0 = s0; c1 = s1;
}
__device__ __forceinline__ void sg_merge(unsigned char* ws, LAS float* part, int tid, int vcu, int G) {
    const bf16 *AM = (const bf16*)(ws + WS_AM) + (size_t)TOKP * 1536, *WMT = (const bf16*)(ws + WS_WMT); const unsigned char* Gb = (const unsigned char*)(ws + WS_G); bf16* MM = (bf16*)(ws + WS_MM);
    const int lane = tid & 63, wv = __builtin_amdgcn_readfirstlane(tid >> 6);
    for (int t = vcu; t < 8 * 32; t += G) { const int tm = t & 7, tn = t >> 3; const int row = TOKP + tm * 32 + (tid >> 4), n = tn * 32 + (tid & 15) * 2;
        __syncthreads();
        if (wv < 6) { const int b = wv >> 1, kh = wv & 1; sg_partial(AM + (size_t)tm * 32 * 1536 + b * 512 + kh * 256, 1536, WMT + (size_t)tn * 32 * 1536 + b * 512 + kh * 256, 1536, 16, part + wv * (32 * 33), lane); }
        __syncthreads();
        const int r33 = (tid >> 4) * 33 + (tid & 15) * 2; float m0 = 0.f, m1 = 0.f;
#pragma unroll
        for (int b = 0; b < 3; ++b) { const LAS float* p0 = part + (2 * b) * (32 * 33) + r33; const LAS float* p1 = p0 + 32 * 33;
            const unsigned g = *(const GAS unsigned short*)(Gb + (size_t)row * 3072 + b * 1024 + n); m0 += (float)(g & 255u) * (1.0f / 255.0f) * (p0[0] + p1[0]); m1 += (float)(g >> 8) * (1.0f / 255.0f) * (p0[1] + p1[1]); }
        *(GAS unsigned*)(MM + (size_t)row * DM + n) = pk2(m0, m1); }
}
__device__ __forceinline__ void sg_wout(unsigned char* ws, float* out, const float* xs, LAS float* part, int tid, int vcu, int G) {
    const bf16 *MM = (const bf16*)(ws + WS_MM) + (size_t)TOKP * DM, *WOT = (const bf16*)(ws + WS_WOT); bf16* HB = (bf16*)(ws + WS_HB); float* ssq = (float*)(ws + WS_CTL) + CW_SSQ1;
    for (int t = vcu; t < 8 * 32; t += G) { const int tm = t & 7, tn = t >> 3; const int rs = tm * 32 + (tid >> 4), row = TOKP + rs, n = tn * 32 + (tid & 15) * 2; float c0, c1;
        sg_tile(MM + (size_t)tm * 32 * DM, DM, WOT + (size_t)tn * 32 * DM, DM, DM, part, tid, c0, c1);
        const float h0 = xs[(size_t)rs * DM + n] + c0, h1 = xs[(size_t)rs * DM + n + 1] + c1;
        out[(size_t)row * DM + n] = h0; out[(size_t)row * DM + n + 1] = h1; *(GAS unsigned*)(HB + (size_t)row * DM + n) = pk2(h0, h1);
        float s = h0 * h0 + h1 * h1; s += __shfl_xor(s, 1); s += __shfl_xor(s, 2); s += __shfl_xor(s, 4); s += __shfl_xor(s, 8);
        if ((tid & 15) == 0) atomicAdd(ssq + row, s); }
}
__device__ __forceinline__ void sg_up(unsigned char* ws, LAS float* part, int tid, int vcu, int G) {
    const bf16 *HB = (const bf16*)(ws + WS_HB) + (size_t)TOKP * DM, *WUT = (const bf16*)(ws + WS_WUT); bf16* A2 = (bf16*)(ws + WS_A2); const float* ssq = (const float*)(ws + WS_CTL) + CW_SSQ1;
    const int lane = tid & 63, wv = __builtin_amdgcn_readfirstlane(tid >> 6), i = lane & 15, g = lane >> 4; constexpr int PW = 132;
    for (int t = vcu; t < 8 * 32; t += G) { const int tm = t & 7, tn = t >> 3;
        __syncthreads();
        const bf16* ap = HB + (size_t)(tm * 32 + i) * DM + wv * 128 + 8 * g; const bf16* bp = WUT + (size_t)(tn * 128 + i) * DM + wv * 128 + 8 * g;
        sg_f32x4 acc[2][8];
#pragma unroll
        for (int a = 0; a < 2; ++a)
#pragma unroll
            for (int c = 0; c < 8; ++c) acc[a][c] = (sg_f32x4){0.f, 0.f, 0.f, 0.f};
#pragma unroll
        for (int s = 0; s < 4; ++s) { const sg_bf16x8 a0 = *(const GAS sg_bf16x8*)(ap + 32 * s), a1 = *(const GAS sg_bf16x8*)(ap + (size_t)16 * DM + 32 * s); sg_bf16x8 b[8];
#pragma unroll
            for (int c = 0; c < 8; ++c) b[c] = *(const GAS sg_bf16x8*)(bp + (size_t)(16 * c) * DM + 32 * s);
#pragma unroll
            for (int c = 0; c < 8; ++c) { acc[0][c] = __builtin_amdgcn_mfma_f32_16x16x32_bf16(a0, b[c], acc[0][c], 0, 0, 0); acc[1][c] = __builtin_amdgcn_mfma_f32_16x16x32_bf16(a1, b[c], acc[1][c], 0, 0, 0); } }
        LAS float* pw = part + wv * (32 * PW);
#pragma unroll
        for (int a = 0; a < 2; ++a)
#pragma unroll
            for (int c = 0; c < 8; ++c)
#pragma unroll
                for (int r = 0; r < 4; ++r) pw[(16 * a + 4 * g + r) * PW + 16 * c + i] = acc[a][c][r];
        __syncthreads();
        const int row = tid >> 4, c0 = (tid & 15) * 8; float sum[8];
#pragma unroll
        for (int e = 0; e < 8; ++e) sum[e] = 0.f;
#pragma unroll
        for (int w = 0; w < 8; ++w) { const LAS float* p = part + w * (32 * PW) + row * PW + c0; const sg_f32x4 x0 = *(const LAS sg_f32x4*)p, x1 = *(const LAS sg_f32x4*)(p + 4);
#pragma unroll
            for (int e = 0; e < 4; ++e) { sum[e] += x0[e]; sum[4 + e] += x1[e]; } }
        const size_t grow = (size_t)TOKP + tm * 32 + row;
        const float rs = 1.0f / sqrtf(ssq[grow] * (1.0f / 1024.0f) + 1e-6f);
#pragma unroll
        for (int e = 0; e < 8; ++e) { const float v = fmaxf(sum[e] * rs, 0.f); sum[e] = v * v; }
        *(GAS v4u*)(A2 + grow * FFP + tn * 128 + c0) = (v4u){pk2(sum[0], sum[1]), pk2(sum[2], sum[3]), pk2(sum[4], sum[5]), pk2(sum[6], sum[7])}; }
}
__device__ __forceinline__ void sg_down(unsigned char* ws, float* out, const float* gfin, LAS float* part, int tid, int vcu, int G) {
    const bf16 *A2 = (const bf16*)(ws + WS_A2) + (size_t)TOKP * FFP, *WDT = (const bf16*)(ws + WS_WDT); float* ssq = (float*)(ws + WS_CTL) + CW_SSQ2; unsigned* cnt = (unsigned*)(ws + WS_CTL) + CW_CNT + 64 * 128;
    for (int t = vcu; t < 8 * 32; t += G) { const int tm = t & 7, tn = t >> 3; const int row = TOKP + tm * 32 + (tid >> 4), n = tn * 32 + (tid & 15) * 2; float c0, c1;
        sg_tile(A2 + (size_t)tm * 32 * FFP, FFP, WDT + (size_t)tn * 32 * FFP, FFP, FF, part, tid, c0, c1);
        const float x0 = out[(size_t)row * DM + n] + c0, x1 = out[(size_t)row * DM + n + 1] + c1;
        float s = x0 * x0 + x1 * x1; s += __shfl_xor(s, 1); s += __shfl_xor(s, 2); s += __shfl_xor(s, 4); s += __shfl_xor(s, 8);
        if ((tid & 15) == 0) atomicAdd(ssq + row, s);
        asm volatile("s_waitcnt vmcnt(0)" ::: "memory");
        __syncthreads();
        if (tid < 64) { if (tid == 0) __hip_atomic_fetch_add(cnt + 64 * tm, 1u, __ATOMIC_RELAXED, __HIP_MEMORY_SCOPE_AGENT);
            for (unsigned sp = 0; sp < (1u << 18); ++sp) { if (__builtin_amdgcn_readfirstlane((int)__hip_atomic_load(cnt + 64 * tm, __ATOMIC_RELAXED, __HIP_MEMORY_SCOPE_AGENT)) >= 32) break; __builtin_amdgcn_s_sleep(2); } }
        __syncthreads();
        float tot = 0.f; if ((tid & 15) == 0) tot = __hip_atomic_load(ssq + row, __ATOMIC_RELAXED, __HIP_MEMORY_SCOPE_AGENT);
        tot = __shfl(tot, (tid & 63) & ~15);
        const float rs = 1.0f / sqrtf(tot * (1.0f / DM) + EPS);
        out[(size_t)row * DM + n] = x0 * rs * gfin[n]; out[(size_t)row * DM + n + 1] = x1 * rs * gfin[n + 1]; }
}
__device__ __forceinline__ void p0_transpose_item(const float* W, int src_pitch, int src_col, int k0, bf16* WT, int dst_pitch, int dst_row, int dst_k0, const float* kscale, LAS float* scr, int lane_, unsigned* cmax = nullptr) {
    int lane = lane_; asm volatile("" : "+v"(lane));
    float mx = 0.f;
#pragma unroll 16
    for (int kk = 0; kk < 64; ++kk) { float v = __builtin_nontemporal_load(W + (size_t)(k0 + kk) * src_pitch + src_col + lane); mx = fmaxf(mx, fabsf(v)); if (kscale) v *= kscale[k0 + kk]; scr[kk * 65 + lane] = v; }
    if (cmax) atomicMax(cmax + lane, __float_as_uint(mx));
    LDS_WAIT(); asm volatile("" ::: "memory");
    const int c = lane & 7;
#pragma unroll
    for (int j = 0; j < 8; ++j) { const int n = (lane >> 3) + 8 * j; const LAS float* s = scr + (8 * c) * 65 + n;
        v4u o; o.x = pk2(s[0 * 65], s[1 * 65]); o.y = pk2(s[2 * 65], s[3 * 65]); o.z = pk2(s[4 * 65], s[5 * 65]); o.w = pk2(s[6 * 65], s[7 * 65]);
        *(GAS v4u*)(WT + (size_t)(dst_row + n) * dst_pitch + dst_k0 + k0 + 8 * c) = o; }
    LDS_WAIT(); asm volatile("" ::: "memory");
}
__device__ __forceinline__ void p0_tblock_item(const float* W, int src_pitch, int src_col, int k0, bf16* WT, int dst_pitch, int dst_row, int dst_k0, const float* kscale, LAS float* tile, int tid_, unsigned* cmax = nullptr) {
    int tid = tid_; asm volatile("" : "+v"(tid));
    const int lane = tid & 63, wv = __builtin_amdgcn_readfirstlane(tid >> 6);
    f32x4 v[8];
#pragma unroll
    for (int i = 0; i < 8; ++i) v[i] = __builtin_nontemporal_load((const GAS f32x4*)(W + (size_t)(k0 + wv * 8 + i) * src_pitch + src_col + 4 * lane));
    f32x4 mx = (f32x4){0.f, 0.f, 0.f, 0.f};
#pragma unroll
    for (int i = 0; i < 8; ++i) { const int kk = wv * 8 + i; f32x4 x = v[i];
#pragma unroll
        for (int e = 0; e < 4; ++e) mx[e] = fmaxf(mx[e], fabsf(x[e]));
        if (kscale) x = x * kscale[k0 + kk];
        LAS float* p = tile + kk * 257 + 4 * lane; p[0] = x[0]; p[1] = x[1]; p[2] = x[2]; p[3] = x[3]; }
    if (cmax) {
#pragma unroll
        for (int e = 0; e < 4; ++e) atomicMax(cmax + 4 * lane + e, __float_as_uint(mx[e])); }
    __syncthreads();
    const int c = tid & 7;
#pragma unroll
    for (int j = 0; j < 4; ++j) { const int n = (tid >> 3) + 64 * j; const LAS float* s = tile + (8 * c) * 257 + n;
        v4u o; o.x = pk2(s[0 * 257], s[1 * 257]); o.y = pk2(s[2 * 257], s[3 * 257]); o.z = pk2(s[4 * 257], s[5 * 257]); o.w = pk2(s[6 * 257], s[7 * 257]);
        *(GAS v4u*)(WT + (size_t)(dst_row + n) * dst_pitch + dst_k0 + k0 + 8 * c) = o; }
    __syncthreads();
}
__device__ __forceinline__ void p1_w8_item(const float* w_in, const unsigned* cmax, signed char* W8, float* sw, int kb, int nb, LAS float* scr, int lane_) {
    int lane = lane_; asm volatile("" : "+v"(lane));
#pragma unroll 16
    for (int kk = 0; kk < 64; ++kk) scr[kk * 65 + lane] = w_in[(size_t)(kb * 64 + kk) * 5640 + 2568 + nb * 64 + lane];
    LDS_WAIT(); asm volatile("" ::: "memory");
    const int c = lane & 3;
#pragma unroll
    for (int j = 0; j < 4; ++j) { const int n = (lane >> 2) + 16 * j; const float cm = fmaxf(__uint_as_float(cmax[nb * 64 + n]), 1e-30f), qs = 127.0f / cm; const LAS float* s = scr + (16 * c) * 65 + n;
        unsigned w[4];
#pragma unroll
        for (int q = 0; q < 4; ++q) { const int a0 = (int)__builtin_rintf(s[(4 * q + 0) * 65] * qs), a1 = (int)__builtin_rintf(s[(4 * q + 1) * 65] * qs), a2 = (int)__builtin_rintf(s[(4 * q + 2) * 65] * qs), a3 = (int)__builtin_rintf(s[(4 * q + 3) * 65] * qs);
            w[q] = (unsigned)(a0 & 255) | ((unsigned)(a1 & 255) << 8) | ((unsigned)(a2 & 255) << 16) | ((unsigned)(a3 & 255) << 24); }
        *(GAS v4u*)(W8 + (size_t)(nb * 64 + n) * 1024 + kb * 64 + 16 * c) = (v4u){w[0], w[1], w[2], w[3]};
        if (kb == 0 && c == 0) sw[nb * 64 + n] = cm * (1.0f / 127.0f); }
    LDS_WAIT(); asm volatile("" ::: "memory");
}
__device__ __forceinline__ void p0_weff_item(int id, const float* w_pool, const float* s_pool, const float* w_br_pool, bf16* WMT, LAS float* scr, int lane_) {
    int lane = lane_; asm volatile("" : "+v"(lane));
    const int g = id >> 9, cb = (id >> 4) & 31, nb = id & 15, n = nb * 64 + lane;
    const float* wp = w_pool + (size_t)(g * 128 + cb * 4) * 128;
    const float sp0 = s_pool[g * 128 + lane], sp1 = s_pool[g * 128 + 64 + lane];
#pragma unroll
    for (int i = 0; i < 4; ++i) { scr[i * 128 + lane] = wp[i * 128 + lane] * sp0; scr[i * 128 + 64 + lane] = wp[i * 128 + 64 + lane] * sp1; }
    float acc[4];
#pragma unroll
    for (int i = 0; i < 4; ++i) acc[i] = 0.f;
#pragma unroll
    for (int hh = 0; hh < 2; ++hh) { float wv[64];
#pragma unroll
        for (int d = 0; d < 64; ++d) wv[d] = w_br_pool[(size_t)(g * 128 + hh * 64 + d) * 1024 + n];
#pragma unroll
        for (int d4 = 0; d4 < 16; ++d4)
#pragma unroll
            for (int i = 0; i < 4; ++i) { const f32x4 c4 = *(const LAS f32x4*)(scr + i * 128 + hh * 64 + d4 * 4);
                acc[i] = fmaf(c4[0], wv[d4 * 4 + 0], acc[i]); acc[i] = fmaf(c4[1], wv[d4 * 4 + 1], acc[i]); acc[i] = fmaf(c4[2], wv[d4 * 4 + 2], acc[i]); acc[i] = fmaf(c4[3], wv[d4 * 4 + 3], acc[i]); } }
    *(GAS unsigned long long*)(WMT + (size_t)n * 1536 + 512 + g * 128 + cb * 4) = (unsigned long long)pk2(acc[0], acc[1]) | ((unsigned long long)pk2(acc[2], acc[3]) << 32);
    LDS_WAIT(); asm volatile("" ::: "memory");
}
__device__ __forceinline__ void p0_token_rows(const float* xp, const float* xs, const float* g_attn, const float* w_in, const float* b_f, bf16* XN, float* out, signed char* XN8, float* sx, int gw, int NGW, int lane) {
    f32x4 wfa[16], wfb[16], gv[4];
#pragma unroll
    for (int j = 0; j < 4; ++j) { gv[j] = *(const GAS f32x4*)(g_attn + 256 * j + 4 * lane);
#pragma unroll
        for (int e = 0; e < 4; ++e) { const float* p = w_in + (size_t)(256 * j + 4 * lane + e) * 5640 + 1536; wfa[j * 4 + e] = *(const GAS f32x4*)p; wfb[j * 4 + e] = *(const GAS f32x4*)(p + 4); } }
    const float bfv = b_f[lane >> 3];
    f32x4 nx[4], nx2[4];
    { const int r0_ = gw < TOK ? gw : 0, r1_ = gw + NGW < TOK ? gw + NGW : 0;
      const float* xa = r0_ < TOKP ? xp + (size_t)r0_ * DM : xs + (size_t)(r0_ - TOKP) * DM; const float* xb = r1_ < TOKP ? xp + (size_t)r1_ * DM : xs + (size_t)(r1_ - TOKP) * DM;
#pragma unroll
      for (int j = 0; j < 4; ++j) { nx[j] = __builtin_nontemporal_load((const GAS f32x4*)(xa + 256 * j + 4 * lane)); nx2[j] = __builtin_nontemporal_load((const GAS f32x4*)(xb + 256 * j + 4 * lane)); } }
    for (int m = gw; m < TOK; m += NGW) {
        f32x4 v[4]; float ss = 0.f;
#pragma unroll
        for (int j = 0; j < 4; ++j) { v[j] = nx[j]; nx[j] = nx2[j]; ss += (v[j].x * v[j].x + v[j].y * v[j].y) + (v[j].z * v[j].z + v[j].w * v[j].w); }
        { const int mn = m + 2 * NGW < TOK ? m + 2 * NGW : 0; const float* xr = mn < TOKP ? xp + (size_t)mn * DM : xs + (size_t)(mn - TOKP) * DM;
#pragma unroll
          for (int j = 0; j < 4; ++j) nx2[j] = __builtin_nontemporal_load((const GAS f32x4*)(xr + 256 * j + 4 * lane)); }
        const float rstd = __builtin_amdgcn_rsqf(wave_sum(ss) * (1.0f / DM) + EPS);
        f32x4 fa = (f32x4){0.f, 0.f, 0.f, 0.f}, fb = (f32x4){0.f, 0.f, 0.f, 0.f};
        GAS unsigned long long* o8 = (GAS unsigned long long*)(XN + (size_t)m * DM) + lane;
        float amax = 0.f;
#pragma unroll
        for (int j = 0; j < 4; ++j) { v[j] = v[j] * rstd * gv[j];
            o8[64 * j] = (unsigned long long)pk2(v[j].x, v[j].y) | ((unsigned long long)pk2(v[j].z, v[j].w) << 32);
            amax = fmaxf(fmaxf(amax, fmaxf(fabsf(v[j].x), fabsf(v[j].y))), fmaxf(fabsf(v[j].z), fabsf(v[j].w)));
#pragma unroll
            for (int e = 0; e < 4; ++e) { fa += wfa[j * 4 + e] * v[j][e]; fb += wfb[j * 4 + e] * v[j][e]; } }
        if (m < TOKP) {
            amax = fmaxf(wave_max_abs(amax), 1e-20f); const float qs = 127.0f / amax;
            GAS unsigned* q8 = (GAS unsigned*)(XN8 + (size_t)m * DM) + lane;
#pragma unroll
            for (int j = 0; j < 4; ++j) { const int q0 = (int)__builtin_rintf(v[j].x * qs), q1 = (int)__builtin_rintf(v[j].y * qs), q2 = (int)__builtin_rintf(v[j].z * qs), q3 = (int)__builtin_rintf(v[j].w * qs);
                q8[64 * j] = (unsigned)(q0 & 255) | ((unsigned)(q1 & 255) << 8) | ((unsigned)(q2 & 255) << 16) | ((unsigned)(q3 & 255) << 24); }
            if (lane == 0) sx[m] = amax * (1.0f / 127.0f); }
        const bool b3 = lane & 8;
        f32x4 q4;
#pragma unroll
        for (int i = 0; i < 4; ++i) q4[i] = swap32_add(fa[i], fb[i]);
        const float q2a = swap16_add(q4[0], q4[2]), q2b = swap16_add(q4[1], q4[3]);
        const float s8a = DPP_ROR_ADD(q2a, 8), s8b = DPP_ROR_ADD(q2b, 8);
        float fz = b3 ? s8b : s8a;
        fz = DPP_ADD(fz, 0xB1); fz = DPP_ADD(fz, 0x4E); fz = DPP_ADD(fz, 0x141);
        if ((lane & 7) == 0) { const int fi = lane >> 3;
            const float z = fz + bfv;
            const float lf = fminf(z, 0.f) - log1pf(expf(-fabsf(z)));
            out[(m < TOKP ? pg8::O_LFP + (size_t)m * 8 : pg8::O_LFS + (size_t)(m - TOKP) * 8) + fi] = lf; }
    }
}
__device__ __forceinline__ void p0_mem_rows(const float* mem, const float* g_mem, bf16* MEMN, int gw, int NGW, int lane) {
    f32x4 gv[4];
#pragma unroll
    for (int j = 0; j < 4; ++j) gv[j] = *(const GAS f32x4*)(g_mem + 256 * j + 4 * lane);
    for (int m = gw; m < NMEMROWS; m += NGW) {
        const float* xr = mem + (size_t)m * DM; f32x4 v[4]; float ss = 0.f;
#pragma unroll
        for (int j = 0; j < 4; ++j) { v[j] = __builtin_nontemporal_load((const GAS f32x4*)(xr + 256 * j + 4 * lane)); ss += (v[j].x * v[j].x + v[j].y * v[j].y) + (v[j].z * v[j].z + v[j].w * v[j].w); }
        const float rstd = __builtin_amdgcn_rsqf(wave_sum(ss) * (1.0f / DM) + EPS);
        GAS unsigned long long* o8 = (GAS unsigned long long*)(MEMN + (size_t)m * DM) + lane;
#pragma unroll
        for (int j = 0; j < 4; ++j) { v[j] = v[j] * rstd * gv[j]; o8[64 * j] = (unsigned long long)pk2(v[j].x, v[j].y) | ((unsigned long long)pk2(v[j].z, v[j].w) << 32); }
    }
}
__device__ __forceinline__ void p1_cumsum(int seq, const float* out, const float* cache_logf, float* DP, float* DS, LAS unsigned char* lds, int tid) {
    const bool samp = seq >= 64; const int sidx = samp ? seq - 64 : seq, b = sidx >> 3, h = sidx & 7, L = samp ? 2064 : 4096, per = samp ? 5 : 8;
    const int lane = tid & 63, wv = tid >> 6;
    double loc[8]; double run = 0.0;
#pragma unroll
    for (int e = 0; e < 8; ++e) { loc[e] = 0.0; if (e < per) { const int idx = tid * per + e; float v = 0.f;
        if (idx < L) v = samp ? (idx < 2048 ? cache_logf[(size_t)(b * 2048 + idx) * 8 + h] : out[pg8::O_LFS + (size_t)(b * 16 + idx - 2048) * 8 + h]) : out[pg8::O_LFP + (size_t)(b * 4096 + idx) * 8 + h];
        run += (double)v; loc[e] = run; } }
    double incl = run;
#pragma unroll
    for (int o = 1; o < 64; o <<= 1) { const double t = __shfl_up(incl, o); if (lane >= o) incl += t; }
    LAS double* wt = (LAS double*)lds;
    if (lane == 63) wt[wv] = incl;
    __syncthreads();
    double base = incl - run;
#pragma unroll
    for (int w = 0; w < 8; ++w) if (w < wv) base += wt[w];
    float* D = samp ? DS + (size_t)sidx * 2064 : DP + (size_t)sidx * 4096;
#pragma unroll
    for (int e = 0; e < 8; ++e) if (e < per) { const int idx = tid * per + e; if (idx < L) D[idx] = (float)(-(base + loc[e]) * 1.4426950408889634); }
    __syncthreads();
}
__device__ __forceinline__ void p2_pool_item(int it, const bf16* U, const float* cache_pool, bf16* AM, int tid) {
    const int cc = tid & 63, tg = tid >> 6, g = cc >> 4, col = cc * 8, m0 = it * 64 + tg * 8; const bool samp = m0 >= TOKP;
    const int rs = m0 - TOKP, b = rs >> 4, t0 = samp ? (rs & 15) : (m0 & 4095);
    v4u rw[23];
    if (!samp) {
#pragma unroll
        for (int i = 0; i < 23; ++i) { const int t = t0 - 15 + i; rw[i] = *(const GAS v4u*)(U + (size_t)(t >= 0 ? m0 - 15 + i : m0) * 512 + col); }
#pragma unroll
        for (int i = 0; i < 15; ++i) if (t0 - 15 + i < 0) rw[i] = (v4u){0u, 0u, 0u, 0u};
    } else
#pragma unroll
    for (int i = 0; i < 23; ++i) { const int t = t0 - 15 + i;
        if (t >= 0) rw[i] = *(const GAS v4u*)(U + (size_t)(m0 - 15 + i) * 512 + col);
        else if (samp) { const float* cp = cache_pool + (size_t)(b * 15 + 15 + t) * 512 + col; const f32x4 c0 = *(const GAS f32x4*)cp, c1 = *(const GAS f32x4*)(cp + 4);
            rw[i] = (v4u){pk2(c0[0], c0[1]), pk2(c0[2], c0[3]), pk2(c1[0], c1[1]), pk2(c1[2], c1[3])}; }
        else rw[i] = (v4u){0u, 0u, 0u, 0u}; }
    unsigned ow[8][4];
#pragma unroll
    for (int wi = 0; wi < 4; ++wi) {
        float pl[24], ph[24]; pl[0] = 0.f; ph[0] = 0.f;
#pragma unroll
        for (int i = 0; i < 23; ++i) { const unsigned x = rw[i][wi]; pl[i + 1] = pl[i] + __uint_as_float(x << 16); ph[i + 1] = ph[i] + __uint_as_float(x & 0xffff0000u); }
#pragma unroll
        for (int tt = 0; tt < 8; ++tt) { const int e = 16 + tt;
            const float sl = pl[e] - (g == 0 ? pl[e - 2] : g == 1 ? pl[e - 4] : g == 2 ? pl[e - 8] : pl[e - 16]), sh = ph[e] - (g == 0 ? ph[e - 2] : g == 1 ? ph[e - 4] : g == 2 ? ph[e - 8] : ph[e - 16]);
            const int w = 2 << g, t = t0 + tt, cnt = samp ? w : (w < t + 1 ? w : t + 1); const float rc = 1.0f / (float)cnt;
            const unsigned x = rw[15 + tt][wi];
            ow[tt][wi] = pk2(sl * rc - __uint_as_float(x << 16), sh * rc - __uint_as_float(x & 0xffff0000u)); } }
#pragma unroll
    for (int tt = 0; tt < 8; ++tt) *(GAS v4u*)(AM + (size_t)(m0 + tt) * 1536 + 512 + col) = (v4u){ow[tt][0], ow[tt][1], ow[tt][2], ow[tt][3]};
}
struct Args { const float* in[24]; float* out; unsigned char* ws; };
__global__ void __launch_bounds__(NWAVES * 64, 2) fwd_megakernel(Args args) {
    extern __shared__ __attribute__((aligned(16))) unsigned char lds[];
    LAS unsigned char* L = (LAS unsigned char*)lds;
    volatile LAS unsigned* MISC = (volatile LAS unsigned*)(L + MISC_OFF);
    const int tid = threadIdx.x, lane = tid & 63, wave = __builtin_amdgcn_readfirstlane(tid >> 6);
    const int G = gridDim.x, bx = blockIdx.x, vcu = (G % 8 == 0) ? (bx % 8) * (G / 8) + bx / 8 : bx;
    volatile LAS unsigned* PT = (volatile LAS unsigned*)(L + LDSCTL_OFF);
#define PTRI(i) ((const float*)(const GAS float*)(((unsigned long long)(unsigned)__builtin_amdgcn_readfirstlane((int)PT[2 * (i) + 1]) << 32) | (unsigned long long)(unsigned)__builtin_amdgcn_readfirstlane((int)PT[2 * (i)])))
#define OUTP ((float*)PTRI(24))
#define WSP ((unsigned char*)PTRI(25))
    for (int u = tid; u < (LDS_BYTES - LDSCTL_OFF) / 4; u += NWAVES * 64) ((LAS unsigned*)(L + LDSCTL_OFF))[u] = 0u;
    if (tid < 256) ((LAS float*)(L + RTAB_OFF))[tid] = 1.0f / (float)(tid > 0 ? tid : 1);
    for (int k = tid; k < 2304; k += NWAVES * 64) { const float g = 1.0f / (1.0f + exp2f((float)(k - 1152) * (1.0f / 128.0f))); const int q = (int)(g * 255.0f + 0.5f); ((LAS unsigned char*)(L + STAB_OFF))[k] = (unsigned char)(q < 1 ? 1 : q > 255 ? 255 : q); }
    __syncthreads();
    if (tid == 0) {
#define PUT(i, p) do { const unsigned long long v_ = (unsigned long long)(uintptr_t)(p); PT[2 * (i)] = (unsigned)v_; PT[2 * (i) + 1] = (unsigned)(v_ >> 32); } while (0)
        PUT(0, args.in[0]); PUT(1, args.in[1]); PUT(2, args.in[2]); PUT(3, args.in[3]); PUT(4, args.in[4]); PUT(5, args.in[5]); PUT(6, args.in[6]); PUT(7, args.in[7]);
        PUT(8, args.in[8]); PUT(9, args.in[9]); PUT(10, args.in[10]); PUT(11, args.in[11]); PUT(12, args.in[12]); PUT(13, args.in[13]); PUT(14, args.in[14]); PUT(15, args.in[15]);
        PUT(16, args.in[16]); PUT(17, args.in[17]); PUT(18, args.in[18]); PUT(19, args.in[19]); PUT(20, args.in[20]); PUT(21, args.in[21]); PUT(22, args.in[22]); PUT(23, args.in[23]);
        PUT(24, args.out); PUT(25, args.ws);
#undef PUT
    }
    __syncthreads();
    XcdBarrier bar = xcd_barrier_post((unsigned*)(WSP + WS_CTL) + CW_BAR, MISC + 8);
    const int gw = vcu * NWAVES + wave, NGW = G * NWAVES;

    {
        LAS float* scr = (LAS float*)(L + wave * TSCR_WAVE);
        unsigned char* ws = WSP; float* out = OUTP;
        bf16* XN = (bf16*)out; bf16* MEMN = XN + (size_t)TOK * DM;
        bf16* W1T = (bf16*)(ws + WS_W1T);
        const float *w_in = PTRI(10), *w_mkv = PTRI(15);
        constexpr int I_IN = 16 * 88, I_MKV = 16 * 16, I_BF = 8 * 16, I_UP = 16 * 64, I_WE = 1024;
        const float *w_bf = PTRI(16), *w_bp = PTRI(17), *w_bm = PTRI(18), *w_up = PTRI(21), *g_mlp = PTRI(20), *w_pool = PTRI(12), *s_pool = PTRI(13);
        bf16 *WMT = (bf16*)(ws + WS_WMT), *WUT = (bf16*)(ws + WS_WUT);
        { LAS float* tile = (LAS float*)(L + RING_OFF);
          constexpr int B_IN = 16 * 22, B_MKV = 16 * 4, B_BF = 8 * 4, B_UP = 16 * 16;
          for (int it = vcu; it < B_IN + B_MKV + 2 * B_BF + B_UP; it += G) { int r = it;
            if (r < B_IN) { const int kb = r / 22, nb = r % 22, n0 = nb * 256; p0_tblock_item(w_in, 5640, n0 + (n0 >= 1536 ? 8 : 0), kb * 64, W1T, 1024, n0, 0, nullptr, tile, tid, n0 >= 2560 ? (unsigned*)(ws + WS_CTL) + CW_CMAX + (n0 - 2560) : nullptr); continue; } r -= B_IN;
            if (r < B_MKV) { const int kb = r / 4, nb = r % 4; p0_tblock_item(w_mkv, 1024, nb * 256, kb * 64, W1T, 1024, NIN + nb * 256, 0, nullptr, tile, tid); continue; } r -= B_MKV;
            if (r < B_BF) { const int kb = r / 4, nb = r % 4; p0_tblock_item(w_bf, 1024, nb * 256, kb * 64, WMT, 1536, nb * 256, 0, nullptr, tile, tid); continue; } r -= B_BF;
            if (r < B_BF) { const int kb = r / 4, nb = r % 4; p0_tblock_item(w_bm, 1024, nb * 256, kb * 64, WMT, 1536, nb * 256, 1024, nullptr, tile, tid); continue; } r -= B_BF;
            { const int kb = r / 16, nb = r % 16; p0_tblock_item(w_up, 4096, nb * 256, kb * 64, WUT, 1024, nb * 256, 0, g_mlp, tile, tid); } }
          for (int it = gw; it < 2048; it += NGW) p0_weff_item(it, w_pool, s_pool, w_bp, WMT, scr, lane); }
        p0_mem_rows(PTRI(2), PTRI(14), MEMN, gw, NGW, lane);
        p0_token_rows(PTRI(0), PTRI(1), PTRI(9), w_in, PTRI(11), XN, out, (signed char*)(ws + WS_XN8), (float*)(ws + WS_SX), gw, NGW, lane);
    }
    xcd_barrier(bar);

    {
        unsigned char* ws = WSP; float* out = OUTP;
        bf16* XN = (bf16*)out; bf16* W1T = (bf16*)(ws + WS_W1T);
        for (int s = bx; s < 192; s += G) p1_cumsum(s, out, PTRI(5), (float*)(ws + WS_DP), (float*)(ws + WS_DS), L, tid);
        { LAS float* scr = (LAS float*)(L + wave * TSCR_WAVE);
          for (int it = gw; it < 16 * 48; it += NGW) p1_w8_item(PTRI(10), (const unsigned*)(ws + WS_CTL) + CW_CMAX, (signed char*)(ws + WS_W8), (float*)(ws + WS_SW), it / 48, it % 48, scr, lane);
          asm volatile("s_waitcnt vmcnt(0)" ::: "memory"); __syncthreads();
          if (tid == 0) { __builtin_amdgcn_fence(__ATOMIC_RELEASE, "agent"); asm volatile("s_waitcnt vmcnt(0)" ::: "memory"); __hip_atomic_fetch_add((unsigned*)(ws + WS_CTL) + CW_W8RDY, 1u, __ATOMIC_RELAXED, __HIP_MEMORY_SCOPE_AGENT); } }
        if (bx < 22) { struct OneUnit { int pm, pn; __device__ __forceinline__ bool next(int i, pg8::Unit& u) const { if (i) return false; u.pm = pm; u.pn = pn; u.kc = 0; return true; }
                                        __device__ __forceinline__ void a_ready(const pg8::Unit&) const {} __device__ __forceinline__ void done(const pg8::Unit&) const {} __device__ __forceinline__ void mid(int) const {} };
          pg8::Gemm g{XN, W1T, TOK, NIN, DM, DM}; OneUnit S{TOKP / 256, bx};
          pg8::EpiInProj E{(bf16*)(ws + WS_Q), (bf16*)(ws + WS_K), (bf16*)(ws + WS_V), (bf16*)(ws + WS_U), (bf16*)(ws + WS_QM), (bf16*)(ws + WS_G), out, (unsigned*)(ws + WS_CTL) + CW_NRM};
          pg8::gemm_phase<pg8::EpiInProj, OneUnit, true, true>(L + RING_OFF, g, S, E); }
        { pg8::Gemm g{XN + (size_t)TOK * DM, W1T + (size_t)NIN * DM, NMEMROWS, 1024, DM, DM}; pg8::StaticOrder S; S.init(NMEMROWS, 1024, G, (bx + G - 22) % G);
          pg8::EpiMemKV E{(bf16*)(ws + WS_MK), (bf16*)(ws + WS_MV), out};
          pg8::gemm_phase<pg8::EpiMemKV, pg8::StaticOrder, true, true>(L + RING_OFF, g, S, E); }
        { pg8::Gemm g{XN, W1T, TOKP, 2560, DM, DM}; pg8::QueueOrder S; S.init(TOKP, 2560, bx % 8, (unsigned*)(ws + WS_CTL) + CW_Q1 + 16 * (bx % 8), (volatile LAS int*)(L + LDSCTL_OFF + 528));
          pg8::EpiInProj E{(bf16*)(ws + WS_Q), (bf16*)(ws + WS_K), (bf16*)(ws + WS_V), (bf16*)(ws + WS_U), (bf16*)(ws + WS_QM), (bf16*)(ws + WS_G), out, (unsigned*)(ws + WS_CTL) + CW_NRM};
          pg8::gemm_phase<pg8::EpiInProj, pg8::QueueOrder, true, true>(L + RING_OFF, g, S, E); }
        { if (tid == 0) { unsigned* rdy = (unsigned*)(ws + WS_CTL) + CW_W8RDY;
              for (unsigned sp = 0; __hip_atomic_load(rdy, __ATOMIC_RELAXED, __HIP_MEMORY_SCOPE_AGENT) < (unsigned)G && sp < (1u << 20); ++sp) __builtin_amdgcn_s_sleep(4);
              __builtin_amdgcn_fence(__ATOMIC_ACQUIRE, "agent"); asm volatile("s_waitcnt vmcnt(0)" ::: "memory"); }
          __syncthreads();
          pg8::Gemm g{(const bf16*)(ws + WS_XN8), (const bf16*)(ws + WS_W8), TOKP, 3072, 512, 512}; pg8::QueueOrder S; S.init(TOKP, 3072, bx % 8, (unsigned*)(ws + WS_CTL) + CW_Q2 + 16 * (bx % 8), (volatile LAS int*)(L + LDSCTL_OFF + 544));
          pg8::EpiGates8 E{(unsigned char*)(ws + WS_G), (const float*)(ws + WS_SX), (const float*)(ws + WS_SW), (const LAS unsigned char*)(L + STAB_OFF)};
          pg8::gemm_phase<pg8::EpiGates8, pg8::QueueOrder, true, true, true>(L + RING_OFF, g, S, E); }
        { LAS float* scr = (LAS float*)(L + wave * TSCR_WAVE); bf16 *WOT = (bf16*)(ws + WS_WOT), *WDT = (bf16*)(ws + WS_WDT); const float *w_out = PTRI(19), *w_down = PTRI(22);
          constexpr int I_OUT = 16 * 16, I_DN = 64 * 16; unsigned* q3 = (unsigned*)(ws + WS_CTL) + CW_Q3;
          for (;;) { int it = 0; if (lane == 0) it = (int)__hip_atomic_fetch_add(q3, 1u, __ATOMIC_RELAXED, __HIP_MEMORY_SCOPE_AGENT); it = __builtin_amdgcn_readfirstlane(it);
              if (it >= I_OUT + I_DN) break; int r = it;
              if (r < I_OUT) { const int kb = r / 16, nb = r % 16; p0_transpose_item(w_out, 1024, nb * 64, kb * 64, WOT, 1024, nb * 64, 0, nullptr, scr, lane); continue; } r -= I_OUT;
              { const int kb = r / 16, nb = r % 16; p0_transpose_item(w_down, 1024, nb * 64, kb * 64, WDT, FFP, nb * 64, 0, nullptr, scr, lane); } } }

    }
    xcd_barrier(bar);

    {
        unsigned char* ws = WSP;
        bf16 *Qb = (bf16*)(ws + WS_Q), *Kb = (bf16*)(ws + WS_K), *Vb = (bf16*)(ws + WS_V), *QMb = (bf16*)(ws + WS_QM), *AM = (bf16*)(ws + WS_AM);
        for (int v = vcu; v < 192; v += G) {
            if (v < 128) { const int b = v >> 3, h = v & 7; const size_t r0 = (size_t)(TOKP + b * 16);
                small_attn::unit<64, true>(Qb + r0 * 512 + h * 64, PTRI(3) + ((size_t)b * 2048 * 8 + h) * 64, PTRI(4) + ((size_t)b * 2048 * 8 + h) * 64, Kb + r0 * 512 + h * 64, Vb + r0 * 512 + h * 64,
                                           (const float*)(ws + WS_DS) + (size_t)v * 2064, AM + r0 * 1536 + h * 64, 1.0f, L + RING_OFF); }
            else { const int u = v - 128, b = u >> 2, h = u & 3; const size_t r0 = (size_t)(TOKP + b * 16);
                small_attn::unit<128, false>(QMb + r0 * 512 + h * 128, PTRI(7) + ((size_t)b * 256 * 4 + h) * 128, PTRI(8) + ((size_t)b * 256 * 4 + h) * 128, nullptr, nullptr,
                                             nullptr, AM + r0 * 1536 + 1024 + h * 128, 0.08838834764831845f * 1.4426950408889634f, L + RING_OFF); }
        }
        for (int it = vcu; it < 512; it += G) p2_pool_item(it, (const bf16*)(ws + WS_U), PTRI(6), AM, tid);
        for (int it = 512 + (vcu - 252); it >= 512 && it < TOK / 64; it += G) p2_pool_item(it, (const bf16*)(ws + WS_U), PTRI(6), AM, tid);
        for (int id = 2 * vcu; id < 512; id += 2 * G) { const int bh = id >> 4, b = bh >> 2, h = bh & 3;
            char* kvl = (char*)lds + RING_OFF; char* scl = (char*)lds + MEMSC_OFF; char* stl = (char*)lds + MEMST_OFF;
            dense_body::mem_stage_kv((const dense_body::bf16*)((bf16*)(ws + WS_MK) + (size_t)b * 256 * 512 + h * 128), (const dense_body::bf16*)((bf16*)(ws + WS_MV) + (size_t)b * 256 * 512 + h * 128), kvl);
            for (int k = 0; k < 2; ++k) { const int qblk = (id + k) & 15; const size_t r0 = (size_t)b * 4096 + qblk * 256;
                dense_body::mem_qblock((const dense_body::bf16*)(QMb + r0 * 512 + h * 128), (dense_body::bf16*)(AM + r0 * 1536 + 1024 + h * 128), kvl, scl, stl); }
            __syncthreads(); }
        { volatile LAS int* uq = (volatile LAS int*)(L + LDSCTL_OFF + 512); unsigned* qctr = (unsigned*)(ws + WS_CTL) + CW_QUEUE;
          if (tid == 0) uq[0] = (int)__hip_atomic_fetch_add(qctr, 1u, __ATOMIC_RELAXED, __HIP_MEMORY_SCOPE_AGENT);
          __syncthreads();
          int u = __builtin_amdgcn_readfirstlane(uq[0]);
          while (u < 1024) {
            int z_; asm volatile("v_mov_b32 %0, 0" : "=v"(z_)); int pend = 0;
            if (tid == 0) pend = (int)__hip_atomic_fetch_add(qctr + z_, 1u, __ATOMIC_RELAXED, __HIP_MEMORY_SCOPE_AGENT);
            int p, qb; if (u < 896) { p = u / 14; qb = 2 + u % 14; } else { const int c = u - 896; p = c & 63; qb = 1 - (c >> 6); }
            const int b = p >> 3, h = p & 7; int ts;
            { int ln = lane; asm volatile("" : "+v"(ln));
              const float* dpp = (const float*)(ws + WS_DP) + (size_t)p * 4096; const unsigned* nq = (const unsigned*)(ws + WS_CTL) + CW_NRM + (size_t)p * 2; const unsigned* nk = nq + 128;
              const float qn2 = __uint_as_float(__hip_atomic_load(nq, __ATOMIC_RELAXED, __HIP_MEMORY_SCOPE_AGENT)) + __uint_as_float(__hip_atomic_load(nq + 1, __ATOMIC_RELAXED, __HIP_MEMORY_SCOPE_AGENT));
              const float kn2 = __uint_as_float(__hip_atomic_load(nk, __ATOMIC_RELAXED, __HIP_MEMORY_SCOPE_AGENT)) + __uint_as_float(__hip_atomic_load(nk + 1, __ATOMIC_RELAXED, __HIP_MEMORY_SCOPE_AGENT));
              const float Bq = 1.02f * pg8::C2F * sqrtf(qn2 * kn2); const int ntile = 4 * qb;
              const bool skip = ln < ntile && (2.0f * Bq + (dpp[64 * ln + 63] - dpp[256 * qb]) < -32.0f);
              const unsigned long long msk = __ballot(skip); int first = (int)__builtin_ctzll(~msk); first = first < ntile ? first : ntile;
              ts = __builtin_amdgcn_readfirstlane(first & ~1); }
            attn_body::attn_unit<8>(b, h, qb, ts, (const attn_body::bf16*)Qb, (const attn_body::bf16*)Kb, (const attn_body::bf16*)Vb, (attn_body::bf16*)AM, (const float*)(ws + WS_DP) + (size_t)p * 4096, (char*)lds + RING_OFF);
            if (tid == 0) uq[0] = pend;
            __syncthreads();
            u = __builtin_amdgcn_readfirstlane(uq[0]);
          }
          __syncthreads(); }
    }
    xcd_barrier(bar);

    { unsigned char* ws = WSP; sg_merge(ws, (LAS float*)(L + RING_OFF), tid, vcu, G); __syncthreads();
      pg8::Gemm g{(bf16*)(ws + WS_AM), (bf16*)(ws + WS_WMT), TOKP, DM, 1536, 1536}; pg8::StaticOrder S; S.init(TOKP, DM, G, bx);
      pg8::EpiMerge E{(const unsigned char*)(ws + WS_G), (bf16*)(ws + WS_MM), (const LAS unsigned char*)(L + RTAB_OFF)};
      pg8::gemm_phase<pg8::EpiMerge, pg8::StaticOrder, true, true>(L + RING_OFF, g, S, E); }
    xcd_barrier(bar);

    { unsigned char* ws = WSP; sg_wout(ws, OUTP, PTRI(1), (LAS float*)(L + RING_OFF), tid, vcu, G); __syncthreads();
      pg8::Gemm g{(bf16*)(ws + WS_MM), (bf16*)(ws + WS_WOT), TOKP, DM, DM, DM}; pg8::StaticOrder S; S.init(TOKP, DM, G, bx);
      pg8::EpiWout E{PTRI(0), PTRI(1), OUTP, (bf16*)(ws + WS_HB), (float*)(ws + WS_CTL) + CW_SSQ1};
      pg8::gemm_phase<pg8::EpiWout, pg8::StaticOrder, true, true>(L + RING_OFF, g, S, E); }
    xcd_barrier(bar);

    { unsigned char* ws = WSP; sg_up(ws, (LAS float*)(L + RING_OFF), tid, vcu, G); __syncthreads();
      pg8::Gemm g{(bf16*)(ws + WS_HB), (bf16*)(ws + WS_WUT), TOKP, FF, DM, DM}; pg8::StaticOrder S; S.init(TOKP, FF, G, bx);
      pg8::EpiUp E{(float*)(ws + WS_CTL) + CW_SSQ1, (bf16*)(ws + WS_A2)};
      pg8::gemm_phase<pg8::EpiUp, pg8::StaticOrder, true, true>(L + RING_OFF, g, S, E); }
    xcd_barrier(bar);

    { unsigned char* ws = WSP; sg_down(ws, OUTP, PTRI(23), (LAS float*)(L + RING_OFF), tid, vcu, G); __syncthreads();
      pg8::Gemm g{(bf16*)(ws + WS_A2), (bf16*)(ws + WS_WDT), TOKP, DM, FF, FFP}; pg8::StaticOrder S; S.init(TOKP, DM, G, bx);
      pg8::EpiDown E{OUTP, (const bf16*)(ws + WS_HB), (float*)(ws + WS_CTL) + CW_SSQ2, (unsigned*)(ws + WS_CTL) + CW_CNT, PTRI(23), (const float*)(ws + WS_CTL) + CW_SSQ1};
      pg8::gemm_phase<pg8::EpiDown, pg8::StaticOrder, true, true>(L + RING_OFF, g, S, E); }
}

extern "C" void kernel_launch(void* const* d_in, const int* in_sizes, int n_in, void* d_out, int out_size, void* d_ws, size_t ws_size, hipStream_t stream) {
    static int grid = 0;
    if (grid == 0) {
        if (n_in != 24 || in_sizes[0] != TOKP * DM || (size_t)out_size != pg8::O_END || ws_size < WS_END) {
            fprintf(stderr, "kernel_launch: built for 24 inputs, x_prompt of %d floats, out of %zu floats, >= %zu bytes of workspace; got n_in %d, in0 %d, out %d, ws %zu; nothing launched\n",
                    TOKP * DM, (size_t)pg8::O_END, (size_t)WS_END, n_in, n_in > 0 ? in_sizes[0] : -1, out_size, ws_size); grid = -1; return; }
        int dev = 0, cus = 0, per_cu = 0;
        if (hipGetDevice(&dev) != hipSuccess || hipDeviceGetAttribute(&cus, hipDeviceAttributeMultiprocessorCount, dev) != hipSuccess) { fprintf(stderr, "kernel_launch: hipGetDevice / hipDeviceGetAttribute failed\n"); grid = -1; return; }
        if (hipFuncSetAttribute((const void*)fwd_megakernel, hipFuncAttributeMaxDynamicSharedMemorySize, LDS_BYTES) != hipSuccess) { fprintf(stderr, "kernel_launch: hipFuncSetAttribute failed\n"); grid = -1; return; }
        if (hipOccupancyMaxActiveBlocksPerMultiprocessor(&per_cu, (const void*)fwd_megakernel, NWAVES * 64, LDS_BYTES) != hipSuccess || per_cu < 1) {
            fprintf(stderr, "kernel_launch: occupancy query reports %d workgroups per CU; nothing launched\n", per_cu); (void)hipGetLastError(); grid = -1; return; }
        grid = cus;
        if (grid % 8 != 0) fprintf(stderr, "kernel_launch: note: %d CUs\n", grid);
    }
    if (grid < 0) return;
    if (hipMemsetAsync((char*)d_ws + WS_CTL, 0, CTL_ZERO_BYTES, stream) != hipSuccess) { fprintf(stderr, "kernel_launch: hipMemsetAsync failed\n"); return; }
    Args a{};
    for (int i = 0; i < 24; ++i) a.in[i] = (const float*)d_in[i];
    a.out = (float*)d_out; a.ws = (unsigned char*)d_ws;
    hipLaunchKernelGGL(fwd_megakernel, dim3(grid), dim3(NWAVES * 64), LDS_BYTES, stream, a);
    const hipError_t le = hipPeekAtLastError();
    if (le != hipSuccess) fprintf(stderr, "kernel_launch: launch failed: %s\n", hipGetErrorName(le));
}
```

```cpp
#include <hip/hip_runtime.h>
#include <hip/hip_bf16.h>
#include <cstdio>
#include <cstdint>
#include <cmath>
namespace pg8 {
#define PG8_LAS __attribute__((address_space(3)))
typedef unsigned short bf16_t;
typedef short bf16x8 __attribute__((ext_vector_type(8)));
typedef float f32x4 __attribute__((ext_vector_type(4)));
typedef unsigned u32x4 __attribute__((ext_vector_type(4)));
typedef int i32x4 __attribute__((ext_vector_type(4)));
constexpr int BM = 256, BK = 64, HALF = 128, HTB = HALF * BK * 2  , STAGE_BYTES = 8 * HTB, NXCD = 8, WGM = 8;

__host__ __device__ __forceinline__ int lds_byte(int r, int c) { const int st = (r >> 4) * 2 + (c >> 5), rr = r & 15, cc = c & 31, ob = rr * 64 + cc * 2; return st * 1024 + (ob ^ (((ob >> 9) & 1) << 5)); }
__host__ __device__ __forceinline__ void stage_rc(int b, int& R, int& C) { const int st = b / 1024, sb = b % 1024, swz = sb ^ (((sb >> 9) & 1) << 5); R = (st >> 1) * 16 + swz / 64; C = (st & 1) * 32 + (swz % 64) / 2; }
__host__ __device__ __forceinline__ int perm32(int rho) { const int n = rho >> 4, i = rho & 15; return 8 * (i >> 2) + 4 * n + (i & 3); }

struct Unit { int pm, pn, kc; };
struct Gemm { const bf16_t* A; const bf16_t* Bt; int M, N, K, ld; };

struct StaticOrder {
    int nM, nN, nwg, G, c;
    __host__ __device__ void init(int M, int N, int G_, int c_) { nM = M / BM; nN = N / BM; nwg = nM * nN; G = G_; c = c_; }
    __host__ __device__ bool next(int i, Unit& u) const {
        const long L = (long)i * G + c; if (L >= nwg) return false;
        int wgid = (int)L; { const int q = nwg / NXCD, r = nwg % NXCD, xcd = wgid % NXCD, off = wgid / NXCD; wgid = (xcd < r ? xcd * (q + 1) : r * (q + 1) + (xcd - r) * q) + off; }
        const int nig = WGM * nN, gid = wgid / nig, fm = gid * WGM, gsz = (nM - fm) < WGM ? (nM - fm) : WGM;
        u.pm = fm + ((wgid % nig) % gsz); u.pn = (wgid % nig) / gsz; u.kc = 0; return true;
    }
    __device__ __forceinline__ void a_ready(const Unit&) const {}
    __device__ __forceinline__ void done(const Unit&) const {}
    __device__ __forceinline__ void mid(int) const {}
};
struct QueueOrder {
    int nM, nN, nwg, xcd, cnt; unsigned* ctr; volatile __attribute__((address_space(3))) int* slot; mutable int pend;
    __device__ __forceinline__ void init(int M, int N, int xcd_, unsigned* ctr_, volatile __attribute__((address_space(3))) int* slot_) {
        nM = M / BM; nN = N / BM; nwg = nM * nN; xcd = xcd_; cnt = nwg / NXCD + (xcd_ < nwg % NXCD ? 1 : 0); ctr = ctr_; slot = slot_; pend = 0;
        if (threadIdx.x == 0) { const int r = (int)__hip_atomic_fetch_add(ctr, 2u, __ATOMIC_RELAXED, __HIP_MEMORY_SCOPE_AGENT); slot[0] = r; slot[1] = r + 1; }
        __syncthreads(); }
    __device__ __forceinline__ bool next(int i, Unit& u) const {
        const int off = __builtin_amdgcn_readfirstlane(slot[i & 1]); if (off >= cnt) return false;
        int wgid; { const int q = nwg / NXCD, r = nwg % NXCD; wgid = (xcd < r ? xcd * (q + 1) : r * (q + 1) + (xcd - r) * q) + off; }
        const int nig = WGM * nN, gid = wgid / nig, fm = gid * WGM, gsz = (nM - fm) < WGM ? (nM - fm) : WGM;
        u.pm = fm + ((wgid % nig) % gsz); u.pn = (wgid % nig) / gsz; u.kc = 0;
        if (i >= 1 && threadIdx.x == 0) slot[(i + 1) & 1] = (int)__hip_atomic_fetch_add(ctr, 1u, __ATOMIC_RELAXED, __HIP_MEMORY_SCOPE_AGENT);
        return true; }
    __device__ __forceinline__ void mid(int ui) const { }
    __device__ __forceinline__ void a_ready(const Unit&) const {}
    __device__ __forceinline__ void done(const Unit&) const {}
};

typedef float f32x2_t __attribute__((ext_vector_type(2))); typedef __bf16 bf16x2_t __attribute__((ext_vector_type(2)));
__device__ __forceinline__ unsigned cvt_pk_bf16(float lo, float hi) { f32x2_t v = {lo, hi}; bf16x2_t b = __builtin_convertvector(v, bf16x2_t); return __builtin_bit_cast(unsigned, b); }
__device__ __forceinline__ u32x4 pack8(const f32x4 v0, const f32x4 v1) { u32x4 w; w.x = cvt_pk_bf16(v0[0], v0[1]); w.y = cvt_pk_bf16(v0[2], v0[3]); w.z = cvt_pk_bf16(v1[0], v1[1]); w.w = cvt_pk_bf16(v1[2], v1[3]); return w; }
__device__ __forceinline__ float bflo(unsigned w) { return __uint_as_float(w << 16); }
__device__ __forceinline__ float bfhi(unsigned w) { return __uint_as_float(w & 0xffff0000u); }
__device__ __forceinline__ unsigned gate_q8x4_y(float y0, float y1, float y2, float y3) {
    unsigned b[4]; const float yy[4] = {y0, y1, y2, y3};
#pragma unroll
    for (int j = 0; j < 4; ++j) { const float g = __builtin_amdgcn_rcpf(1.0f + __builtin_amdgcn_exp2f(fminf(yy[j], 8.9f))); b[j] = __float_as_uint(fmaf(g, 255.0f, 8388608.0f)); }
    const unsigned p01 = __builtin_amdgcn_perm(b[1], b[0], 0x0c0c0400u), p23 = __builtin_amdgcn_perm(b[3], b[2], 0x0c0c0400u);
    return __builtin_amdgcn_perm(p23, p01, 0x05040100u);
}
__device__ __forceinline__ unsigned gate_tab4(const __attribute__((address_space(3))) unsigned char* tab, float y0, float y1, float y2, float y3) {
    unsigned b[4]; const float yy[4] = {y0, y1, y2, y3};
#pragma unroll
    for (int j = 0; j < 4; ++j) { const float t = fmaf(__builtin_amdgcn_fmed3f(yy[j], -9.0f, 8.99f), 128.0f, 12582912.0f + 1152.0f); b[j] = (unsigned)tab[__float_as_uint(t) & 0xfffu]; }
    return b[0] | (b[1] << 8) | (b[2] << 16) | (b[3] << 24);
}
__device__ __forceinline__ unsigned gate_q8(float x) { const float g = __builtin_amdgcn_rcpf(1.0f + __builtin_amdgcn_exp2f(-1.4426950408889634f * x)); const int q = (int)(g * 255.0f + 0.5f); return (unsigned)(q < 1 ? 1 : q > 255 ? 255 : q); }
__device__ __forceinline__ float sigmoid_f(float x) { return __builtin_amdgcn_rcpf(1.0f + __builtin_amdgcn_exp2f(-1.4426950408889634f * x)); }

constexpr int TOK_P = 32768, TOK = 33024;
constexpr size_t O_YP = 0, O_YS = 33554432, O_KP = 33816576, O_VP = 50593792, O_LFP = 67371008, O_PLP = 67633152, O_MKP = 67694592, O_MVP = 68743168,
                 O_KS = 69791744, O_VS = 69922816, O_LFS = 70053888, O_PLS = 70055936, O_END = 70178816;
constexpr float C2F = 0.125f * 1.4426950408889634f;

struct EpiInProj {
    static constexpr bool PERM = true, AFTER_DRAIN = false, HAS_HOOK = false; static constexpr int HOOK_T0 = -1, HOOK_T1 = -1;
    bf16_t *Q, *K, *V, *U, *QM, *G; float* out; unsigned* nrm;
    __device__ __forceinline__ void hook(f32x4 (&)[2][2][4][2], const Unit&, int, int, int, int, int) const {}
    __device__ __forceinline__ void operator()(const f32x4 (&acc)[2][2][4][2], const Unit& u, int wr, int wc, int fr, int fq) const {
        const int pn = u.pn, row0 = u.pm * BM + wr * 64 + fr; const bool samp = u.pm >= TOK_P / BM;
        if (pn < 4 && !samp) {
#pragma unroll
            for (int bj = 0; bj < 2; ++bj) { float mx = 0.f;
#pragma unroll
                for (int ai = 0; ai < 2; ++ai)
#pragma unroll
                    for (int m = 0; m < 4; ++m) { const f32x4 v0 = acc[ai][bj][m][0], v1 = acc[ai][bj][m][1];
                        float sq = (v0[0] * v0[0] + v0[1] * v0[1]) + (v0[2] * v0[2] + v0[3] * v0[3]) + (v1[0] * v1[0] + v1[1] * v1[1]) + (v1[2] * v1[2] + v1[3] * v1[3]);
                        sq += __shfl_xor(sq, 16); sq += __shfl_xor(sq, 32); mx = fmaxf(mx, sq); }
                mx = fmaxf(mx, __shfl_xor(mx, 1)); mx = fmaxf(mx, __shfl_xor(mx, 2)); mx = fmaxf(mx, __shfl_xor(mx, 4)); mx = fmaxf(mx, __shfl_xor(mx, 8));
                if ((fr | fq) == 0) { const int b = u.pm >> 4, head = (pn & 1) * 4 + bj * 2 + (wc >> 1);
                    atomicMax(nrm + (((pn >> 1) * 8 + b) * 8 + head) * 2 + (wc & 1), __float_as_uint(mx)); } }
        }
        const int ct = wc * 32 + 8 * fq;
        if (pn >= 10) {
            const int cb = (pn - 10) * 256 + ct; unsigned char* G8 = (unsigned char*)G;
#pragma unroll
            for (int ai = 0; ai < 2; ++ai)
#pragma unroll
                for (int m = 0; m < 4; ++m) { unsigned char* rowp = G8 + (size_t)(row0 + ai * HALF + m * 16) * 3072 + cb;
#pragma unroll
                    for (int bj = 0; bj < 2; ++bj) { const f32x4 v0 = acc[ai][bj][m][0], v1 = acc[ai][bj][m][1]; unsigned lo = 0u, hi = 0u;
#pragma unroll
                        for (int j = 0; j < 4; ++j) { lo |= gate_q8(v0[j]) << (8 * j); hi |= gate_q8(v1[j]) << (8 * j); }
                        *(unsigned long long*)(rowp + bj * HALF) = (unsigned long long)lo | ((unsigned long long)hi << 32); } }
            return;
        }
        const int seg = pn >> 1, cb = (pn & 1) * 256 + ct;
        bf16_t* dst = seg == 0 ? Q : seg == 1 ? K : seg == 2 ? V : seg == 3 ? U : QM;
        const float sc = seg == 0 ? C2F : 1.0f;
        float* fo = nullptr;
        if (seg == 1) fo = out + (samp ? O_KS : O_KP); else if (seg == 2) fo = out + (samp ? O_VS : O_VP);
#pragma unroll
        for (int ai = 0; ai < 2; ++ai)
#pragma unroll
            for (int m = 0; m < 4; ++m) { const int row = row0 + ai * HALF + m * 16; bf16_t* rowp = dst + (size_t)row * 512 + cb;
                const int rowo = samp ? row - TOK_P : row;
                float* pool = nullptr;
                if (seg == 3) { if (!samp) { const int t = row & 4095, b = row >> 12; if (t >= 4096 - 15) pool = out + O_PLP + (size_t)(b * 15 + t - (4096 - 15)) * 512 + cb; }
                                else { const int t = rowo & 15, b = rowo >> 4; if (t >= 1) pool = out + O_PLS + (size_t)(b * 15 + t - 1) * 512 + cb; } }
#pragma unroll
                for (int bj = 0; bj < 2; ++bj) { const f32x4 v0 = acc[ai][bj][m][0], v1 = acc[ai][bj][m][1];
                    *(u32x4*)(rowp + bj * HALF) = pack8(v0 * sc, v1 * sc);
                    if (fo) { float* p = fo + (size_t)rowo * 512 + cb + bj * HALF; *(f32x4*)p = v0; *(f32x4*)(p + 4) = v1; }
                    if (pool) { float* p = pool + bj * HALF; *(f32x4*)p = v0; *(f32x4*)(p + 4) = v1; } } }
    }
};
struct EpiGates8 {
    static constexpr bool PERM = true, AFTER_DRAIN = false, HAS_HOOK = false; static constexpr int HOOK_T0 = -1, HOOK_T1 = -1;
    unsigned char* G; const float* sx; const float* sw; const __attribute__((address_space(3))) unsigned char* stab;
    __device__ __forceinline__ void hook(i32x4 (&)[2][2][4][2], const Unit&, int, int, int, int, int) const {}
    __device__ __forceinline__ void operator()(const i32x4 (&acc)[2][2][4][2], const Unit& u, int wr, int wc, int fr, int fq) const {
        const int row0 = u.pm * BM + wr * 64 + fr, cb = u.pn * BM + wc * 32 + 8 * fq;
        f32x4 w0[2], w1[2];
#pragma unroll
        for (int bj = 0; bj < 2; ++bj) { w0[bj] = *(const f32x4*)(sw + cb + bj * HALF) * -1.4426950408889634f; w1[bj] = *(const f32x4*)(sw + cb + bj * HALF + 4) * -1.4426950408889634f; }
        unsigned char* gt = G + (size_t)((u.pm * 4 + (u.pn & 3)) * 3 + (u.pn >> 2)) * 65536 + (size_t)(((wr * 4 + wc) * 8) * 64 + fq * 16 + fr) * 16;
        float sxv[2][4];
#pragma unroll
        for (int ai = 0; ai < 2; ++ai)
#pragma unroll
            for (int m = 0; m < 4; ++m) sxv[ai][m] = sx[(size_t)(row0 + ai * HALF + m * 16)];
#pragma unroll
        for (int ai = 0; ai < 2; ++ai)
#pragma unroll
            for (int m = 0; m < 4; ++m) { const float s = sxv[ai][m]; unsigned q[4];
#pragma unroll
                for (int bj = 0; bj < 2; ++bj) { const i32x4 a0 = acc[ai][bj][m][0], a1 = acc[ai][bj][m][1]; const f32x4 s0 = w0[bj] * s, s1 = w1[bj] * s;
                    q[2 * bj] = gate_tab4(stab, (float)a0[0] * s0[0], (float)a0[1] * s0[1], (float)a0[2] * s0[2], (float)a0[3] * s0[3]);
                    q[2 * bj + 1] = gate_tab4(stab, (float)a1[0] * s1[0], (float)a1[1] * s1[1], (float)a1[2] * s1[2], (float)a1[3] * s1[3]); }
                *(u32x4*)(gt + (size_t)(ai * 4 + m) * 1024) = (u32x4){q[0], q[1], q[2], q[3]}; }
    }
};
struct EpiMemKV {
    static constexpr bool PERM = true, AFTER_DRAIN = false, HAS_HOOK = false; static constexpr int HOOK_T0 = -1, HOOK_T1 = -1;
    bf16_t *MK, *MV; float* out;
    __device__ __forceinline__ void hook(f32x4 (&)[2][2][4][2], const Unit&, int, int, int, int, int) const {}
    __device__ __forceinline__ void operator()(const f32x4 (&acc)[2][2][4][2], const Unit& u, int wr, int wc, int fr, int fq) const {
        const int pn = u.pn, row0 = u.pm * BM + wr * 64 + fr, cb = (pn & 1) * 256 + wc * 32 + 8 * fq;
        bf16_t* dst = pn < 2 ? MK : MV; float* fo = out + (pn < 2 ? O_MKP : O_MVP);
#pragma unroll
        for (int ai = 0; ai < 2; ++ai)
#pragma unroll
            for (int m = 0; m < 4; ++m) { const int row = row0 + ai * HALF + m * 16;
#pragma unroll
                for (int bj = 0; bj < 2; ++bj) { const f32x4 v0 = acc[ai][bj][m][0], v1 = acc[ai][bj][m][1];
                    *(u32x4*)(dst + (size_t)row * 512 + cb + bj * HALF) = pack8(v0, v1);
                    float* p = fo + (size_t)row * 512 + cb + bj * HALF; *(f32x4*)p = v0; *(f32x4*)(p + 4) = v1; } }
    }
};
struct EpiMerge {
    static constexpr bool PERM = true, AFTER_DRAIN = false, HAS_HOOK = true; static constexpr int HOOK_T0 = 8, HOOK_T1 = 16;
    const unsigned char* G; bf16_t* MM; const __attribute__((address_space(3))) unsigned char* rtab;
    __device__ __forceinline__ void hook(f32x4 (&acc)[2][2][4][2], const Unit& u, int t, int wr, int wc, int fr, int fq) const {
        int fr_ = fr, fq_ = fq; asm volatile("" : "+v"(fr_), "+v"(fq_));
        const int seg = t >> 3;
        const unsigned char* gt = G + (size_t)((u.pm * 4 + u.pn) * 3 + (seg - 1)) * 65536 + (size_t)(((wr * 4 + wc) * 8) * 64 + fq_ * 16 + fr_) * 16;
        u32x4 gp[8], gn[8];
#pragma unroll
        for (int c = 0; c < 8; ++c) { gp[c] = __builtin_nontemporal_load((const u32x4*)(gt + (size_t)c * 1024)); gn[c] = __builtin_nontemporal_load((const u32x4*)(gt + 65536 + (size_t)c * 1024)); }
#pragma unroll
        for (int ai = 0; ai < 2; ++ai)
#pragma unroll
            for (int m = 0; m < 4; ++m)
#pragma unroll
                for (int bj = 0; bj < 2; ++bj) { const u32x4 p4 = gp[ai * 4 + m], n4 = gn[ai * 4 + m];
#pragma unroll
                    for (int h = 0; h < 2; ++h) { const unsigned p = p4[2 * bj + h], n = n4[2 * bj + h];
#pragma unroll
                        for (int j = 0; j < 4; ++j) acc[ai][bj][m][h][j] *= (float)((p >> (8 * j)) & 255u) * *(const __attribute__((address_space(3))) float*)(rtab + (j == 0 ? (n << 2) & 0x3fcu : (n >> (8 * j - 2)) & 0x3fcu)); } }
    }
    __device__ __forceinline__ void operator()(const f32x4 (&acc)[2][2][4][2], const Unit& u, int wr, int wc, int fr, int fq) const {
        const int row0 = u.pm * BM + wr * 64 + fr, cb = u.pn * BM + wc * 32 + 8 * fq;
        const unsigned char* gt = G + (size_t)((u.pm * 4 + u.pn) * 3 + 2) * 65536 + (size_t)(((wr * 4 + wc) * 8) * 64 + fq * 16 + fr) * 16;
        u32x4 g2[8];
#pragma unroll
        for (int c = 0; c < 8; ++c) g2[c] = __builtin_nontemporal_load((const u32x4*)(gt + (size_t)c * 1024));
#pragma unroll
        for (int ai = 0; ai < 2; ++ai)
#pragma unroll
            for (int m = 0; m < 4; ++m) { const size_t row = (size_t)(row0 + ai * HALF + m * 16);
#pragma unroll
                for (int bj = 0; bj < 2; ++bj) { const unsigned glo = g2[ai * 4 + m][2 * bj], ghi = g2[ai * 4 + m][2 * bj + 1]; f32x4 v0 = acc[ai][bj][m][0], v1 = acc[ai][bj][m][1];
#pragma unroll
                    for (int j = 0; j < 4; ++j) { v0[j] *= (float)((glo >> (8 * j)) & 255u) * (1.0f / 255.0f); v1[j] *= (float)((ghi >> (8 * j)) & 255u) * (1.0f / 255.0f); }
                    *(u32x4*)(MM + row * 1024 + cb + bj * HALF) = pack8(v0, v1); } }
    }
};
struct EpiWout {
    static constexpr bool PERM = true, AFTER_DRAIN = false, HAS_HOOK = false; static constexpr int HOOK_T0 = -1, HOOK_T1 = -1;
    const float *xp, *xs; float* H; bf16_t* HB; float* ssq;
    __device__ __forceinline__ void hook(f32x4 (&)[2][2][4][2], const Unit&, int, int, int, int, int) const {}
    __device__ __forceinline__ void operator()(const f32x4 (&acc)[2][2][4][2], const Unit& u, int wr, int wc, int fr, int fq) const {
        const int row0 = u.pm * BM + wr * 64 + fr, cb = u.pn * BM + wc * 32 + 8 * fq; const bool samp = u.pm >= TOK_P / BM;
        const float* xb = samp ? xs - (size_t)TOK_P * 1024 : xp;
#pragma unroll
        for (int ai = 0; ai < 2; ++ai) {
            f32x4 xv[4][2][2];
#pragma unroll
            for (int m = 0; m < 4; ++m)
#pragma unroll
                for (int bj = 0; bj < 2; ++bj) { const float* p = xb + (size_t)(row0 + ai * HALF + m * 16) * 1024 + cb + bj * HALF; xv[m][bj][0] = __builtin_nontemporal_load((const f32x4*)p); xv[m][bj][1] = __builtin_nontemporal_load((const f32x4*)(p + 4)); }
#pragma unroll
            for (int m = 0; m < 4; ++m) { const size_t row = (size_t)(row0 + ai * HALF + m * 16); float s = 0.f;
#pragma unroll
                for (int bj = 0; bj < 2; ++bj) { const size_t off = row * 1024 + cb + bj * HALF;
                    const f32x4 h0 = xv[m][bj][0] + acc[ai][bj][m][0], h1 = xv[m][bj][1] + acc[ai][bj][m][1];
                    *(u32x4*)(HB + off) = pack8(h0, h1);
                    s += (h0[0] * h0[0] + h0[1] * h0[1]) + (h0[2] * h0[2] + h0[3] * h0[3]) + (h1[0] * h1[0] + h1[1] * h1[1]) + (h1[2] * h1[2] + h1[3] * h1[3]); }
                s += __shfl_xor(s, 16); s += __shfl_xor(s, 32);
                if (fq == 0) atomicAdd(ssq + row, s); } }
    }
};
struct EpiUp {
    static constexpr bool PERM = true, AFTER_DRAIN = false, HAS_HOOK = false; static constexpr int HOOK_T0 = -1, HOOK_T1 = -1;
    const float* ssq; bf16_t* A2;
    __device__ __forceinline__ void hook(f32x4 (&)[2][2][4][2], const Unit&, int, int, int, int, int) const {}
    __device__ __forceinline__ void operator()(const f32x4 (&acc)[2][2][4][2], const Unit& u, int wr, int wc, int fr, int fq) const {
        const int row0 = u.pm * BM + wr * 64 + fr, cb = u.pn * BM + wc * 32 + 8 * fq;
#pragma unroll
        for (int ai = 0; ai < 2; ++ai)
#pragma unroll
            for (int m = 0; m < 4; ++m) { const size_t row = (size_t)(row0 + ai * HALF + m * 16);
#pragma unroll
                for (int bj = 0; bj < 2; ++bj) { f32x4 v0 = acc[ai][bj][m][0], v1 = acc[ai][bj][m][1];
#pragma unroll
                    for (int j = 0; j < 4; ++j) { const float a = fmaxf(v0[j], 0.f), b = fmaxf(v1[j], 0.f); v0[j] = a * a; v1[j] = b * b; }
                    *(u32x4*)(A2 + row * (4096 + 64)   + cb + bj * HALF) = pack8(v0, v1); } }
    }
};
struct EpiDown {
    static constexpr bool PERM = true, AFTER_DRAIN = false, HAS_HOOK = false; static constexpr int HOOK_T0 = -1, HOOK_T1 = -1;
    float* Y; const bf16_t* HB; float* ssq; unsigned* cnt; const float* gfin; const float* ssq1;
    __device__ __forceinline__ void hook(f32x4 (&)[2][2][4][2], const Unit&, int, int, int, int, int) const {}
    __device__ __forceinline__ void operator()(const f32x4 (&acc_)[2][2][4][2], const Unit& u, int wr, int wc, int fr, int fq) const {
        f32x4 (&acc)[2][2][4][2] = const_cast<f32x4 (&)[2][2][4][2]>(acc_);
        const int row0 = u.pm * BM + wr * 64 + fr, cb = u.pn * BM + wc * 32 + 8 * fq;
        u32x4 hbv[2][4][2];
#pragma unroll
        for (int ai = 0; ai < 2; ++ai)
#pragma unroll
            for (int m = 0; m < 4; ++m)
#pragma unroll
                for (int bj = 0; bj < 2; ++bj) hbv[ai][m][bj] = __builtin_nontemporal_load((const u32x4*)(HB + (size_t)(row0 + ai * HALF + m * 16) * 1024 + cb + bj * HALF));
        float s1v[2][4];
#pragma unroll
        for (int ai = 0; ai < 2; ++ai)
#pragma unroll
            for (int m = 0; m < 4; ++m) s1v[ai][m] = __hip_atomic_load(ssq1 + (size_t)(row0 + ai * HALF + m * 16), __ATOMIC_RELAXED, __HIP_MEMORY_SCOPE_AGENT);
#pragma unroll
        for (int ai = 0; ai < 2; ++ai)
#pragma unroll
            for (int m = 0; m < 4; ++m) { const size_t row = (size_t)(row0 + ai * HALF + m * 16); float s = 0.f; const float r2 = 1.0f / (s1v[ai][m] * (1.0f / 1024.0f) + 1e-6f);
#pragma unroll
                for (int bj = 0; bj < 2; ++bj) { const u32x4 hb = hbv[ai][m][bj];
                    const f32x4 h0 = (f32x4){bflo(hb.x), bfhi(hb.x), bflo(hb.y), bfhi(hb.y)} + acc[ai][bj][m][0] * r2, h1 = (f32x4){bflo(hb.z), bfhi(hb.z), bflo(hb.w), bfhi(hb.w)} + acc[ai][bj][m][1] * r2;
                    acc[ai][bj][m][0] = h0; acc[ai][bj][m][1] = h1;
                    s += (h0[0] * h0[0] + h0[1] * h0[1]) + (h0[2] * h0[2] + h0[3] * h0[3]) + (h1[0] * h1[0] + h1[1] * h1[1]) + (h1[2] * h1[2] + h1[3] * h1[3]); }
                s += __shfl_xor(s, 16); s += __shfl_xor(s, 32);
                if (fq == 0) atomicAdd(ssq + row, s); }
        asm volatile("s_waitcnt vmcnt(0)" ::: "memory");
        unsigned* pc = cnt + 64 * u.pm;
        if ((fr | fq) == 0) __hip_atomic_fetch_add(pc, 1u, __ATOMIC_RELAXED, __HIP_MEMORY_SCOPE_AGENT);
        for (unsigned sp = 0; sp < (1u << 18); ++sp) { if (__builtin_amdgcn_readfirstlane((int)__hip_atomic_load(pc, __ATOMIC_RELAXED, __HIP_MEMORY_SCOPE_AGENT)) >= 32) break; __builtin_amdgcn_s_sleep(2); }
        f32x4 g0[2], g1[2];
#pragma unroll
        for (int bj = 0; bj < 2; ++bj) { g0[bj] = *(const f32x4*)(gfin + cb + bj * HALF); g1[bj] = *(const f32x4*)(gfin + cb + bj * HALF + 4); }
        float totv[2][4];
#pragma unroll
        for (int ai = 0; ai < 2; ++ai)
#pragma unroll
            for (int m = 0; m < 4; ++m) { float tot = 0.f; if (fq == 0) tot = __hip_atomic_load(ssq + (size_t)(row0 + ai * HALF + m * 16), __ATOMIC_RELAXED, __HIP_MEMORY_SCOPE_AGENT); totv[ai][m] = tot; }
#pragma unroll
        for (int ai = 0; ai < 2; ++ai)
#pragma unroll
            for (int m = 0; m < 4; ++m) { const size_t row = (size_t)(row0 + ai * HALF + m * 16);
                float tot = totv[ai][m];
                tot = __shfl(tot, fr);
                const float rs = 1.0f / sqrtf(tot * (1.0f / 1024.0f) + 1e-6f);
#pragma unroll
                for (int bj = 0; bj < 2; ++bj) { float* p = Y + row * 1024 + cb + bj * HALF; *(f32x4*)p = acc[ai][bj][m][0] * rs * g0[bj]; *(f32x4*)(p + 4) = acc[ai][bj][m][1] * rs * g1[bj]; } }
    }
};
__device__ __forceinline__ f32x4 mma16(bf16x8 b, bf16x8 a, f32x4 c) { return __builtin_amdgcn_mfma_f32_16x16x32_bf16(b, a, c, 0, 0, 0); }
__device__ __forceinline__ i32x4 mma16(bf16x8 b, bf16x8 a, i32x4 c) { return __builtin_amdgcn_mfma_i32_16x16x64_i8(__builtin_bit_cast(i32x4, b), __builtin_bit_cast(i32x4, a), c, 0, 0, 0); }
template <bool I8> struct AccT { typedef f32x4 type; }; template <> struct AccT<true> { typedef i32x4 type; };
template <class Epi, class Sched, bool ALIGN_EPI = false, bool SP2 = false, bool I8 = false>
__device__ __forceinline__ void gemm_phase(PG8_LAS unsigned char* lds, const Gemm g, const Sched& S, const Epi& E) {
    int tid_ = threadIdx.x; asm volatile("" : "+v"(tid_));
    const int tid = tid_, wid = __builtin_amdgcn_readfirstlane(tid >> 6), lane = tid & 63, wr = wid >> 2, wc = wid & 3, fr = lane & 15, fq = lane >> 4;
    const int K = g.K, LD = g.ld, nt = K / BK;
    unsigned voffA[2], voffB[2];
#pragma unroll
    for (int i = 0; i < 2; ++i) { int R, C; stage_rc(tid * 16 + i * 8192, R, C); const int Rb = Epi::PERM ? ((R & ~31) + perm32(R & 31)) : R;
        voffA[i] = (unsigned)(R * LD + C) * 2u; voffB[i] = (unsigned)(Rb * LD + C) * 2u; }
    const size_t kstep = (size_t)(BK * 2);
    const size_t hstep = (size_t)HALF * LD * 2;
    const size_t tstep = 2 * hstep;
    const unsigned ldsw = (unsigned)wid * 1024u;
    const int aoff = lds_byte(wr * 64 + fr, fq * 8), boff = lds_byte(wc * 32 + fr, fq * 8);
#define PG8_SA(b, h) (((b) * 2 + (h)) * HTB)
#define PG8_SB(b, h) ((4 + (b) * 2 + (h)) * HTB)
#define PG8_STAGE(bufoff, gbase, voff) do { _Pragma("unroll") for (int _i = 0; _i < 2; ++_i) \
        __builtin_amdgcn_global_load_lds((const unsigned*)((const char*)(gbase) + (voff)[_i]), (PG8_LAS unsigned*)(lds + (bufoff) + ldsw + _i * 8192), 16, 0, 0); } while (0)
#define PG8_LDA(dst, b, h) do { _Pragma("unroll") for (int m = 0; m < 4; ++m) _Pragma("unroll") for (int k = 0; k < 2; ++k) dst[m][k] = *(const PG8_LAS bf16x8*)(lds + PG8_SA(b, h) + aoff + m * 2048 + k * 1024); } while (0)
#define PG8_LDB(dst, b, h) do { _Pragma("unroll") for (int n = 0; n < 2; ++n) _Pragma("unroll") for (int k = 0; k < 2; ++k) dst[n][k] = *(const PG8_LAS bf16x8*)(lds + PG8_SB(b, h) + boff + n * 2048 + k * 1024); } while (0)
#define PG8_MMA(ai, bj, At, Bt) do { __builtin_amdgcn_s_setprio(1); _Pragma("unroll") for (int m = 0; m < 4; ++m) _Pragma("unroll") for (int n = 0; n < 2; ++n) _Pragma("unroll") for (int k = 0; k < 2; ++k) \
        acc[ai][bj][m][n] = mma16(Bt[n][k], At[m][k], acc[ai][bj][m][n]); __builtin_amdgcn_s_setprio(0); } while (0)
#define PG8_WAIT_V(n) asm volatile("s_waitcnt vmcnt(" #n ")" ::: "memory")
#define PG8_WAIT_L(n) asm volatile("s_waitcnt lgkmcnt(" #n ")" ::: "memory")
#define PG8_BAR __builtin_amdgcn_s_barrier()
#define PG8_SCHED __builtin_amdgcn_sched_barrier(0)
    Unit cur, nxt; int ui = 0;
    if (!S.next(0, cur)) return;
    typedef typename AccT<I8>::type acc_t; acc_t acc[2][2][4][2];
#pragma unroll
    for (int a = 0; a < 2; ++a)
#pragma unroll
        for (int b = 0; b < 2; ++b)
#pragma unroll
            for (int m = 0; m < 4; ++m)
#pragma unroll
                for (int n = 0; n < 2; ++n) acc[a][b][m][n] = acc_t{};
    bf16x8 At[4][2], B0[2][2], B1[2][2];
    const size_t cstep = (size_t)K * 2;
    const char* cA = (const char*)g.A + (size_t)cur.pm * tstep + (size_t)cur.kc * cstep; const char* cB = (const char*)g.Bt + (size_t)cur.pn * tstep + (size_t)cur.kc * cstep;
    S.a_ready(cur);
    if constexpr (SP2) {
        PG8_STAGE(PG8_SB(0, 0), cB, voffB); PG8_STAGE(PG8_SB(0, 1), cB + hstep, voffB); PG8_STAGE(PG8_SA(0, 0), cA, voffA); PG8_STAGE(PG8_SA(0, 1), cA + hstep, voffA);
        if (wr == 1) PG8_BAR;
        PG8_WAIT_V(2); PG8_BAR;
        PG8_STAGE(PG8_SB(1, 0), cB + kstep, voffB); PG8_STAGE(PG8_SA(1, 0), cA + kstep, voffA); PG8_STAGE(PG8_SB(1, 1), cB + hstep + kstep, voffB);
        PG8_WAIT_V(6); PG8_BAR;
    } else {
        PG8_STAGE(PG8_SB(0, 0), cB, voffB); PG8_STAGE(PG8_SA(0, 0), cA, voffA); PG8_STAGE(PG8_SB(0, 1), cB + hstep, voffB); PG8_STAGE(PG8_SA(0, 1), cA + hstep, voffA);
        if (wr == 1) PG8_BAR;
        PG8_WAIT_V(4); PG8_BAR;
        PG8_STAGE(PG8_SB(1, 0), cB + kstep, voffB); PG8_STAGE(PG8_SA(1, 0), cA + kstep, voffA); PG8_STAGE(PG8_SB(1, 1), cB + hstep + kstep, voffB);
        PG8_WAIT_V(6); PG8_BAR;
    }
    for (;;) {
        const bool has_next = S.next(ui + 1, nxt);
        const char* nA = has_next ? (const char*)g.A + (size_t)nxt.pm * tstep + (size_t)nxt.kc * cstep : cA; const char* nB = has_next ? (const char*)g.Bt + (size_t)nxt.pn * tstep + (size_t)nxt.kc * cstep : cB;
        for (int t = 0; t < nt; t += 2) {
            if constexpr (Epi::HAS_HOOK) { if (t == Epi::HOOK_T0 || t == Epi::HOOK_T1) E.hook(acc, cur, t, wr, wc, fr, fq); }
            if (t == 2) S.mid(ui);
            const bool last = (t == nt - 2);
            const char* a1 = cA + (size_t)(t + 1) * kstep;
            const char* a2 = last ? nA : cA + (size_t)(t + 2) * kstep; const char* b2 = last ? nB : cB + (size_t)(t + 2) * kstep;
            const char* a3 = a2 + kstep; const char* b3 = b2 + kstep;
            if (last && has_next) S.a_ready(nxt);
            if constexpr (SP2) {
            PG8_LDB(B0, 0, 0); PG8_LDB(B1, 0, 1); PG8_SCHED; PG8_LDA(At, 0, 0); PG8_STAGE(PG8_SA(1, 1), a1 + hstep, voffA);
            PG8_WAIT_V(8); PG8_WAIT_L(0); PG8_BAR; PG8_MMA(0, 0, At, B0); PG8_MMA(0, 1, At, B1); PG8_BAR; PG8_SCHED;
            PG8_LDA(At, 0, 1); PG8_STAGE(PG8_SB(0, 0), b2, voffB); PG8_STAGE(PG8_SB(0, 1), b2 + hstep, voffB); PG8_STAGE(PG8_SA(0, 0), a2, voffA);
            PG8_WAIT_V(8); PG8_WAIT_L(0); PG8_BAR; PG8_MMA(1, 0, At, B0); PG8_MMA(1, 1, At, B1); PG8_BAR; PG8_SCHED;
            PG8_LDB(B0, 1, 0); PG8_LDB(B1, 1, 1); PG8_SCHED; PG8_LDA(At, 1, 0); PG8_STAGE(PG8_SA(0, 1), a2 + hstep, voffA);
            PG8_WAIT_V(8); PG8_WAIT_L(0); PG8_BAR; PG8_MMA(0, 0, At, B0); PG8_MMA(0, 1, At, B1); PG8_BAR; PG8_SCHED;
            PG8_LDA(At, 1, 1); PG8_STAGE(PG8_SB(1, 0), b3, voffB); PG8_STAGE(PG8_SB(1, 1), b3 + hstep, voffB); PG8_STAGE(PG8_SA(1, 0), a3, voffA);
            PG8_WAIT_V(8); PG8_WAIT_L(0); PG8_BAR; PG8_MMA(1, 0, At, B0); PG8_MMA(1, 1, At, B1); PG8_BAR; PG8_SCHED;
            } else {
            PG8_LDB(B0, 0, 0); PG8_SCHED; PG8_LDA(At, 0, 0); PG8_STAGE(PG8_SA(1, 1), a1 + hstep, voffA);
            PG8_WAIT_L(8); PG8_BAR; PG8_WAIT_L(0); PG8_MMA(0, 0, At, B0); PG8_BAR; PG8_SCHED;
            PG8_LDB(B1, 0, 1); PG8_STAGE(PG8_SB(0, 0), b2, voffB);
            PG8_BAR; PG8_WAIT_L(0); PG8_MMA(0, 1, At, B1); PG8_BAR;
            PG8_LDA(At, 0, 1); PG8_STAGE(PG8_SA(0, 0), a2, voffA);
            PG8_BAR; PG8_WAIT_L(0); PG8_MMA(1, 0, At, B0); PG8_BAR; PG8_SCHED;
            PG8_STAGE(PG8_SB(0, 1), b2 + hstep, voffB);
            PG8_WAIT_V(6); PG8_BAR; PG8_MMA(1, 1, At, B1); PG8_BAR;
            PG8_LDB(B0, 1, 0); PG8_SCHED; PG8_LDA(At, 1, 0); PG8_STAGE(PG8_SA(0, 1), a2 + hstep, voffA);
            PG8_WAIT_L(8); PG8_BAR; PG8_WAIT_L(0); PG8_MMA(0, 0, At, B0); PG8_BAR; PG8_SCHED;
            PG8_LDB(B1, 1, 1); PG8_STAGE(PG8_SB(1, 0), b3, voffB);
            PG8_BAR; PG8_WAIT_L(0); PG8_MMA(0, 1, At, B1); PG8_BAR;
            PG8_LDA(At, 1, 1); PG8_STAGE(PG8_SA(1, 0), a3, voffA);
            PG8_BAR; PG8_WAIT_L(0); PG8_MMA(1, 0, At, B0); PG8_BAR; PG8_SCHED;
            PG8_STAGE(PG8_SB(1, 1), b3 + hstep, voffB);
            PG8_WAIT_V(6); PG8_BAR; PG8_MMA(1, 1, At, B1); PG8_BAR;
            }
        }
        if constexpr (ALIGN_EPI) { if (wr == 0) PG8_BAR; }
        if constexpr (!Epi::AFTER_DRAIN) { E(acc, cur, wr, wc, fr, fq); S.done(cur); }
        if (!has_next) break;
#pragma unroll
        for (int a = 0; a < 2; ++a)
#pragma unroll
            for (int b = 0; b < 2; ++b)
#pragma unroll
                for (int m = 0; m < 4; ++m)
#pragma unroll
                    for (int n = 0; n < 2; ++n) acc[a][b][m][n] = acc_t{};
        cur = nxt; cA = nA; cB = nB; ++ui;
        if constexpr (ALIGN_EPI) { if (wr == 1) PG8_BAR; }
    }
    PG8_WAIT_V(0);
    if constexpr (!ALIGN_EPI) { if (wr == 0) PG8_BAR; }
    PG8_BAR;
    if constexpr (Epi::AFTER_DRAIN) { E.fused(acc, cur, wr, wc, fr, fq, lds, wid, lane); S.done(cur); }
#undef PG8_SA
#undef PG8_SB
#undef PG8_STAGE
#undef PG8_LDA
#undef PG8_LDB
#undef PG8_MMA
#undef PG8_WAIT_V
#undef PG8_WAIT_L
#undef PG8_BAR
#undef PG8_SCHED
}
}
namespace attn_body {
using bf16=__hip_bfloat16;
using bf16x8=__attribute__((ext_vector_type(8)))short;
using s16x4=__attribute__((ext_vector_type(4)))short;
using f32x16=__attribute__((ext_vector_type(16)))float;
using u32x4=__attribute__((ext_vector_type(4)))unsigned;
constexpr int NHEAD=8,SEQ=4096,D=64,DM=NHEAD*D,OP=1536;
constexpr int NW=8,QBLK=32,QB=QBLK*NW,KVBLK=64,NQB=SEQ/QB;
constexpr int ATTN_PITCH=DM, ATTN_UNIT_ROWS=QB;
__device__ __forceinline__ int crow(int r,int hi){return (r&3)+8*(r>>2)+4*hi;}
#define SBAR() __builtin_amdgcn_sched_barrier(0)
__device__ __forceinline__ void cmask(f32x16&p0,f32x16&p1,int jb,int qrel,int hi){
  const float NEG=-INFINITY; int kb=64*jb+4*hi;
  #pragma unroll
  for(int r=0;r<16;++r){int kv=kb+(r&3)+8*(r>>2); if(kv>qrel)p0[r]=NEG; if(kv+32>qrel)p1[r]=NEG;}
}

constexpr int NSLOT=3, SLOTB=8192;
constexpr int LDS_K=0, LDS_V=NSLOT*SLOTB, LDS_WS=2*NSLOT*SLOTB, LDS_OST=LDS_WS+NW*64*4, LDS_DL=LDS_OST+NW*4096, LDS_BYTES=LDS_DL+SEQ*4;
constexpr float C2=0.125f*1.4426950408889634f;
__device__ __forceinline__ void glds16(const void*gsrc,unsigned lds_dst){unsigned keep;
  asm volatile("s_mov_b32 %0, m0\n\ts_mov_b32 m0, %2\n\ts_nop 0\n\tglobal_load_lds_dwordx4 %1, off\n\ts_mov_b32 m0, %0":"=&s"(keep):"v"(gsrc),"s"(lds_dst):"memory");}
__device__ __forceinline__ float max3f(float a,float b,float c){float r;asm("v_max3_f32 %0, %1, %2, %3":"=v"(r):"v"(a),"v"(b),"v"(c));return r;}
__device__ __forceinline__ float max2f(float a,float b){float r;asm("v_max_f32_e32 %0, %1, %2":"=v"(r):"v"(a),"v"(b));return r;}
__device__ __forceinline__ float fadd_s(float a,float b){float r;asm("v_add_f32_e32 %0, %1, %2":"=v"(r):"v"(a),"v"(b));return r;}
__device__ __forceinline__ float fsub_s(float a,float b){float r;asm("v_sub_f32_e32 %0, %1, %2":"=v"(r):"v"(a),"v"(b));return r;}
typedef float f32x4_t __attribute__((ext_vector_type(4))); typedef float f32x2_t __attribute__((ext_vector_type(2))); typedef __bf16 bf16x2_t __attribute__((ext_vector_type(2)));
__device__ __forceinline__ unsigned cvtpk_s(float lo,float hi){f32x2_t v={lo,hi};bf16x2_t b=__builtin_convertvector(v,bf16x2_t);return __builtin_bit_cast(unsigned,b);}
#define WAIT_BAR(N) asm volatile("s_waitcnt vmcnt(" #N ") lgkmcnt(0)\n\ts_barrier":::"memory")

__device__ __forceinline__ void qkt(f32x16&p0,f32x16&p1,const char*Kslot,const bf16x8*qr,const f32x16&negm,int r32,int hi){
  const char*kb=Kslot+hi*1024+r32*16;
  #pragma unroll
  for(int d0=0;d0<4;++d0){
    const bf16x8 b0=*reinterpret_cast<const bf16x8*>(kb+d0*2048);
    const bf16x8 b1=*reinterpret_cast<const bf16x8*>(kb+d0*2048+512);
    if(d0==0){p0=__builtin_amdgcn_mfma_f32_32x32x16_bf16(b0,qr[0],negm,0,0,0);p1=__builtin_amdgcn_mfma_f32_32x32x16_bf16(b1,qr[0],negm,0,0,0);}
    else{p0=__builtin_amdgcn_mfma_f32_32x32x16_bf16(b0,qr[d0],p0,0,0,0);p1=__builtin_amdgcn_mfma_f32_32x32x16_bf16(b1,qr[d0],p1,0,0,0);}}
}
typedef __attribute__((address_space(3))) const char* lds_cptr;
typedef short v4i16_t __attribute__((ext_vector_type(4)));
__device__ __forceinline__ void kload8(bf16x8*kf,lds_cptr kp){
  kf[0]=*(const __attribute__((address_space(3))) bf16x8*)(kp);      kf[1]=*(const __attribute__((address_space(3))) bf16x8*)(kp+512);
  kf[2]=*(const __attribute__((address_space(3))) bf16x8*)(kp+2048); kf[3]=*(const __attribute__((address_space(3))) bf16x8*)(kp+2560);
  kf[4]=*(const __attribute__((address_space(3))) bf16x8*)(kp+4096); kf[5]=*(const __attribute__((address_space(3))) bf16x8*)(kp+4608);
  kf[6]=*(const __attribute__((address_space(3))) bf16x8*)(kp+6144); kf[7]=*(const __attribute__((address_space(3))) bf16x8*)(kp+6656);
}
__device__ __forceinline__ void kload2(bf16x8*kf,lds_cptr kp,int j){ kf[2*j]=*(const __attribute__((address_space(3))) bf16x8*)(kp+j*2048); kf[2*j+1]=*(const __attribute__((address_space(3))) bf16x8*)(kp+j*2048+512); }
__device__ __forceinline__ s16x4 vtr(lds_cptr p){ return __builtin_bit_cast(s16x4,__builtin_amdgcn_ds_read_tr16_b64_v4i16((__attribute__((address_space(3))) v4i16_t*)p)); }
__device__ __forceinline__ float rowmax(const f32x16&p0,const f32x16&p1){
  float a=max3f(p0[0],p0[1],p1[0]),b=max3f(p0[2],p0[3],p1[1]);a=max3f(a,p1[2],p1[3]);
  #pragma unroll
  for(int r=4;r<16;r+=4){a=max3f(a,p0[r],p0[r+1]);b=max3f(b,p0[r+2],p0[r+3]);a=max3f(a,p1[r],p1[r+1]);b=max3f(b,p1[r+2],p1[r+3]);}
  const float m=max2f(a,b);
  auto rr=__builtin_amdgcn_permlane32_swap(__float_as_uint(m),__float_as_uint(m),false,false);
  return max2f(__uint_as_float(rr[0]),__uint_as_float(rr[1]));
}
__device__ __forceinline__ void pv(f32x16*o,int vb,bf16x8 pa0,bf16x8 pa1,bf16x8 pa2,bf16x8 pa3){
  #pragma unroll
  for(int d0=0;d0<2;++d0){s16x4 lo[4],hi[4];
    #pragma unroll
    for(int ks=0;ks<4;++ks){
      asm volatile("ds_read_b64_tr_b16 %0,%1 offset:%c2":"=&v"(lo[ks]):"v"(vb),"i"(d0*4096+ks*1024):"memory");
      asm volatile("ds_read_b64_tr_b16 %0,%1 offset:%c2":"=&v"(hi[ks]):"v"(vb),"i"(d0*4096+ks*1024+512):"memory");}
    asm volatile("s_waitcnt lgkmcnt(0)":::"memory");SBAR();
    #define PK(k) (bf16x8){lo[k][0],lo[k][1],lo[k][2],lo[k][3],hi[k][0],hi[k][1],hi[k][2],hi[k][3]}
    o[d0]=__builtin_amdgcn_mfma_f32_32x32x16_bf16(pa0,PK(0),o[d0],0,0,0);
    o[d0]=__builtin_amdgcn_mfma_f32_32x32x16_bf16(pa1,PK(1),o[d0],0,0,0);
    o[d0]=__builtin_amdgcn_mfma_f32_32x32x16_bf16(pa2,PK(2),o[d0],0,0,0);
    o[d0]=__builtin_amdgcn_mfma_f32_32x32x16_bf16(pa3,PK(3),o[d0],0,0,0);
    #undef PK
  }
}

#ifndef ATTN_STORE16
#define ATTN_STORE16(p,v) (*(u32x4*)(p)=(v))
#endif
template<int THRL> __device__ __forceinline__ void attn_unit(int b,int h,int qb,int ts,const bf16*Q,const bf16*__restrict__ K,const bf16*__restrict__ V,bf16*O,const float*dP,char*shm){
  int tid_=threadIdx.x; asm volatile("":"+v"(tid_));
  const int tid=tid_,lane=tid&63,r32=lane&31,hi=lane>>5; const int wid=__builtin_amdgcn_readfirstlane(tid>>6);
  const long rowbase=(long)b*SEQ; const int q0=qb*QB;
  const bf16*Qw=Q+(rowbase+q0+wid*QBLK)*DM+h*D;
  const bf16*Kh=K+(rowbase+(long)ts*KVBLK)*DM+h*D,*Vh=V+(rowbase+(long)ts*KVBLK)*DM+h*D;
  const unsigned lds0=(unsigned)(uintptr_t)shm;
  float*wsf=(float*)(shm+LDS_WS)+wid*64;
  const bf16*ksrc=Kh+(long)lane*DM+wid*8;
  const bf16*vsrc=Vh+(long)(16*(wid&3)+(lane>>2))*DM+(wid>>2)*32+(lane&3)*8;
  const unsigned kdst=lds0+LDS_K+wid*1024, vdst=lds0+LDS_V+wid*1024;
  #define DMA_K(t,slot) glds16(ksrc+(long)(t)*KVBLK*DM,(unsigned)__builtin_amdgcn_readfirstlane(kdst+(slot)))
  #define DMA_V(t,slot) glds16(vsrc+(long)(t)*KVBLK*DM,(unsigned)__builtin_amdgcn_readfirstlane(vdst+(slot)))
  const int vb0=(int)(lds0+LDS_V)+((lane>>4)&1)*32+(lane&3)*8+(4*hi+((lane&15)>>2))*64;
  const char*Kbase=shm+LDS_K; bf16x8 kf[8];
  const lds_cptr shm3=(lds_cptr)shm; const lds_cptr kp0=shm3+LDS_K+hi*1024+r32*16; const lds_cptr vp0=shm3+LDS_V+((lane>>4)&1)*32+(lane&3)*8+(4*hi+((lane&15)>>2))*64;
  const int NT=(q0+QB)/KVBLK-ts;
  const int nk=NT*KVBLK; float dlv[8]; const float dref=dP[q0+QB-1];
  _Pragma("unroll") for(int j=0;j<8;++j){ const int i=tid+j*NW*64; dlv[j]=dP[ts*KVBLK+(i<nk?i:0)]; }
  #define DLSTORE() do{ __attribute__((address_space(3))) float*dlw=(__attribute__((address_space(3))) float*)(shm3+LDS_DL); \
    _Pragma("unroll") for(int j=0;j<8;++j){ const int i=tid+j*NW*64; if(i<nk)dlw[i]=dlv[j]-dref; } }while(0)
  #define ADDB(P0,P1,t) do{ const __attribute__((address_space(3))) f32x4_t*dp_=(const __attribute__((address_space(3))) f32x4_t*)(shm3+LDS_DL+(t)*256+hi*16); \
    _Pragma("unroll") for(int rr=0;rr<4;++rr){ const f32x4_t a_=dp_[rr*2],b_=dp_[8+rr*2]; \
      _Pragma("unroll") for(int j=0;j<4;++j){P0[4*rr+j]+=a_[j];P1[4*rr+j]+=b_[j];} SBAR(); } }while(0)
  DMA_K(0,0);DMA_V(0,0);DMA_K(1,SLOTB);
  bf16x8 qr[4];
  #pragma unroll
  for(int d0=0;d0<4;++d0)qr[d0]=__builtin_nontemporal_load(reinterpret_cast<const bf16x8*>(&Qw[(long)r32*DM+d0*16+hi*8]));
  float z0_; asm volatile("v_mov_b32 %0, 0":"=v"(z0_));
  float mhat=0.f,l_reg=0.f;f32x16 o[2],negm;
  _Pragma("unroll") for(int r=0;r<16;++r){o[0][r]=z0_;o[1][r]=z0_;negm[r]=z0_;} asm volatile("":"+v"(negm));
  const int qrel=wid*QBLK+r32;
  #define CMASK(P0,P1,t) do{int jb_=(t)-(NT-4); if(jb_>=0)cmask(P0,P1,jb_,qrel,hi);}while(0)
  bool resc=false;
  #define START(P0,P1) do{ const float rm=rowmax(P0,P1); resc=false; \
    { const float dl=rm; mhat=fadd_s(mhat,dl); \
      _Pragma("unroll") for(int r=0;r<16;++r){P0[r]=fsub_s(P0[r],dl);P1[r]=fsub_s(P1[r],dl);} \
      _Pragma("unroll") for(int r=0;r<16;++r)negm[r]=-mhat; asm volatile("":"+v"(negm)); } \
    _Pragma("unroll") for(int r=0;r<16;++r)P0[r]=__builtin_amdgcn_exp2f(P0[r]); }while(0)
  #define RESC() do{ if(resc){ asm volatile("s_waitcnt lgkmcnt(0)":::"memory"); \
      _Pragma("unroll") for(int d_=0;d_<2;++d_) _Pragma("unroll") for(int r=0;r<16;++r)o[d_][r]*=wsf[crow(r,hi)]; } }while(0)
  f32x16 pA0,pA1,pB0,pB1;
  int sl_prev=0,sl_cur=0,sl_next=SLOTB;
  #define ROT() do{sl_prev=sl_cur;sl_cur=sl_next;sl_next=(sl_next==(NSLOT-1)*SLOTB)?0:sl_next+SLOTB;}while(0)
  DMA_K(2,2*SLOTB);
  DLSTORE();
  WAIT_BAR(3);
  qkt(pA0,pA1,Kbase,qr,negm,r32,hi);asm volatile("s_nop 15\n\ts_nop 7":"+v"(pA0),"+v"(pA1));CMASK(pA0,pA1,0);ADDB(pA0,pA1,0);
  START(pA0,pA1);
  _Pragma("unroll") for(int r=0;r<16;++r)pA1[r]=__builtin_amdgcn_exp2f(pA1[r]);
  WAIT_BAR(0);
  DMA_K(3,0);DMA_V(1,SLOTB);
  ROT();
  kload8(kf,kp0+sl_cur);
  WAIT_BAR(2);
  s16x4 vlo[8],vhi[8]; u32x4 pw0,pw1,pw2,pw3;
  #define PKW(P,B) cvtpk_s(P[B],P[B+1])
  #define PAF(k) __builtin_bit_cast(bf16x8,pw##k)
  #define VFR(i) (bf16x8){vlo[i][0],vlo[i][1],vlo[i][2],vlo[i][3],vhi[i][0],vhi[i][1],vhi[i][2],vhi[i][3]}
  #define PIN(x) asm volatile("":"+v"(x))
  #define MX3(a,b,c) __builtin_fmaxf(__builtin_fmaxf((a),(b)),(c))
  #define GAPA(MF,A0,A1,A2,A3,W0,W1,PW) do{ MF; sacc+=A0; sacc+=A1; sacc+=A2; sacc+=A3; PIN(sacc); W0; W1; PIN(PW); SBAR(); }while(0)
  #define EX(v) __builtin_amdgcn_exp2f(v)
  #define GAPB(MF,X,B) do{ MF; X[B]=EX(X[B]); X[B+1]=EX(X[B+1]); X[B+2]=EX(X[B+2]); X[B+3]=EX(X[B+3]); PIN(X); SBAR(); }while(0)
  #define VRD(i) do{ vlo[i]=vtr(vp_+(((i)>>2)*4096+((i)&3)*1024)); vhi[i]=vtr(vp_+(((i)>>2)*4096+((i)&3)*1024+512)); }while(0)
  #define KRD(G,j) do{ if(G){ kload2(kf,kp0+sl_next,j); SBAR(); } }while(0)
  #define STEP(C0,C1,P0,P1,t,GK,GV,GL) do{ SBAR(); \
    const lds_cptr vp_=vp0+sl_prev; \
    VRD(0); SBAR(); float sacc=(P0[0]+P0[1]); \
    GAPA(C0=__builtin_amdgcn_mfma_f32_32x32x16_bf16(kf[0],qr[0],negm,0,0,0), P0[2],P0[3],P0[4],P0[5],     pw0[0]=PKW(P0,0), pw0[1]=PKW(P0,2), pw0); \
    VRD(4); SBAR(); GAPA(C1=__builtin_amdgcn_mfma_f32_32x32x16_bf16(kf[1],qr[0],negm,0,0,0), P0[6],P0[7],P0[8],P0[9],     pw0[2]=PKW(P0,4), pw0[3]=PKW(P0,6), pw0); \
    VRD(1); SBAR(); GAPA(C0=__builtin_amdgcn_mfma_f32_32x32x16_bf16(kf[2],qr[1],C0,0,0,0),   P0[10],P0[11],P0[12],P0[13], pw1[0]=PKW(P0,8), pw1[1]=PKW(P0,10), pw1); \
    VRD(5); SBAR(); GAPA(C1=__builtin_amdgcn_mfma_f32_32x32x16_bf16(kf[3],qr[1],C1,0,0,0),   P0[14],P0[15],P1[0],P1[1],   pw1[2]=PKW(P0,12),pw1[3]=PKW(P0,14), pw1); \
    VRD(2); SBAR(); GAPA(C0=__builtin_amdgcn_mfma_f32_32x32x16_bf16(kf[4],qr[2],C0,0,0,0),   P1[2],P1[3],P1[4],P1[5],     pw2[0]=PKW(P1,0), pw2[1]=PKW(P1,2), pw2); \
    VRD(6); SBAR(); GAPA(C1=__builtin_amdgcn_mfma_f32_32x32x16_bf16(kf[5],qr[2],C1,0,0,0),   P1[6],P1[7],P1[8],P1[9],     pw2[2]=PKW(P1,4), pw2[3]=PKW(P1,6), pw2); \
    VRD(3); SBAR(); GAPA(C0=__builtin_amdgcn_mfma_f32_32x32x16_bf16(kf[6],qr[3],C0,0,0,0),   P1[10],P1[11],P1[12],P1[13], pw3[0]=PKW(P1,8), pw3[1]=PKW(P1,10), pw3); \
    VRD(7); SBAR(); GAPA(C1=__builtin_amdgcn_mfma_f32_32x32x16_bf16(kf[7],qr[3],C1,0,0,0),   P1[14],P1[15],0.f,0.f,       pw3[2]=PKW(P1,12),pw3[3]=PKW(P1,14), pw3); \
    l_reg+=sacc; \
    if(GK){DMA_K((t)+3,sl_cur);} if(GV){DMA_V((t)+1,sl_next);} \
    CMASK(C0,C1,t); ADDB(C0,C1,t); \
    { float a=MX3(C0[0],C0[1],C1[0]),b=MX3(C0[2],C0[3],C1[1]); a=MX3(a,C1[2],C1[3]); \
      _Pragma("unroll") for(int r=4;r<16;r+=4){a=MX3(a,C0[r],C0[r+1]);b=MX3(b,C0[r+2],C0[r+3]);a=MX3(a,C1[r],C1[r+1]);b=MX3(b,C1[r+2],C1[r+3]);} \
      float rm=__builtin_fmaxf(a,b); { auto rr=__builtin_amdgcn_permlane32_swap(__float_as_uint(rm),__float_as_uint(rm),false,false); rm=__builtin_fmaxf(__uint_as_float(rr[0]),__uint_as_float(rr[1])); } \
      resc=false; \
      if(__builtin_expect(__any(rm>(float)THRL),0)){ const float dl=__builtin_fmaxf(rm,0.f); mhat+=dl; \
        _Pragma("unroll") for(int r=0;r<16;++r){C0[r]-=dl;C1[r]-=dl;} \
        _Pragma("unroll") for(int r=0;r<16;++r)negm[r]=-mhat; asm volatile("":"+v"(negm)); \
        const float f=__builtin_amdgcn_exp2f(-dl); l_reg*=f; if(hi==0)wsf[r32]=f; resc=true; } } \
    SBAR(); \
    GAPB(o[0]=__builtin_amdgcn_mfma_f32_32x32x16_bf16(PAF(0),VFR(0),o[0],0,0,0), C0,0); \
    GAPB(o[1]=__builtin_amdgcn_mfma_f32_32x32x16_bf16(PAF(0),VFR(4),o[1],0,0,0), C0,4); \
    KRD(GL,0); GAPB(o[0]=__builtin_amdgcn_mfma_f32_32x32x16_bf16(PAF(1),VFR(1),o[0],0,0,0), C0,8); \
    KRD(GL,1); GAPB(o[1]=__builtin_amdgcn_mfma_f32_32x32x16_bf16(PAF(1),VFR(5),o[1],0,0,0), C0,12); \
    KRD(GL,2); GAPB(o[0]=__builtin_amdgcn_mfma_f32_32x32x16_bf16(PAF(2),VFR(2),o[0],0,0,0), C1,0); \
    KRD(GL,3); GAPB(o[1]=__builtin_amdgcn_mfma_f32_32x32x16_bf16(PAF(2),VFR(6),o[1],0,0,0), C1,4); \
    GAPB(o[0]=__builtin_amdgcn_mfma_f32_32x32x16_bf16(PAF(3),VFR(3),o[0],0,0,0), C1,8); \
    GAPB(o[1]=__builtin_amdgcn_mfma_f32_32x32x16_bf16(PAF(3),VFR(7),o[1],0,0,0), C1,12); \
    }while(0)
  int t=1;
  #undef CMASK
  #define CMASK(P0,P1,t) do{}while(0)
  for(;t+5<NT;t+=2){
    STEP(pB0,pB1,pA0,pA1,t,true,true,true);     WAIT_BAR(2); RESC(); ROT();
    STEP(pA0,pA1,pB0,pB1,t+1,true,true,true);   WAIT_BAR(2); RESC(); ROT();
  }
  #undef CMASK
  #define CMASK(P0,P1,t) do{int jb_=(t)-(NT-4); if(jb_>=0)cmask(P0,P1,jb_,qrel,hi);}while(0)
  #define ENDW(tt) do{ if((tt)+3<NT){WAIT_BAR(2);} else if((tt)+2<NT){WAIT_BAR(1);} else {WAIT_BAR(0);} }while(0)
  for(;t+1<NT;t+=2){
    STEP(pB0,pB1,pA0,pA1,t,(t+3<NT),(t+1<NT),(t+1<NT));       ENDW(t);   RESC(); ROT();
    STEP(pA0,pA1,pB0,pB1,t+1,(t+4<NT),(t+2<NT),(t+2<NT));     ENDW(t+1); RESC(); ROT();
  }
  STEP(pB0,pB1,pA0,pA1,NT-1,false,false,false); RESC();
  { float sacc=pB0[0]+pB0[1]; _Pragma("unroll") for(int r=2;r<16;++r)sacc+=pB0[r]; _Pragma("unroll") for(int r=0;r<16;++r)sacc+=pB1[r]; l_reg+=sacc;
    pw0=(u32x4){PKW(pB0,0),PKW(pB0,2),PKW(pB0,4),PKW(pB0,6)};pw1=(u32x4){PKW(pB0,8),PKW(pB0,10),PKW(pB0,12),PKW(pB0,14)};pw2=(u32x4){PKW(pB1,0),PKW(pB1,2),PKW(pB1,4),PKW(pB1,6)};pw3=(u32x4){PKW(pB1,8),PKW(pB1,10),PKW(pB1,12),PKW(pB1,14)};
    SBAR(); pv(o,vb0+sl_cur,PAF(0),PAF(1),PAF(2),PAF(3)); }
  #undef PKW
  #undef PAF
  #undef VFR
  #undef PIN
  #undef MX3
  #undef GAPA
  #undef GAPB
  #undef EX
  #undef VRD
  #undef KRD
  #undef STEP
  #undef ENDW
  {auto rr=__builtin_amdgcn_permlane32_swap(__float_as_uint(l_reg),__float_as_uint(l_reg),false,false);l_reg=__uint_as_float(rr[0])+__uint_as_float(rr[1]);}
  if(hi==0)wsf[32+r32]=l_reg;asm volatile("s_waitcnt lgkmcnt(0)":::"memory");
  float rli[16];
  #pragma unroll
  for(int r=0;r<16;++r)rli[r]=__builtin_amdgcn_rcpf(wsf[32+crow(r,hi)]);
  bf16*Ow=O+(rowbase+q0+wid*QBLK)*OP+h*D;
  { bf16*stg=(bf16*)(shm+LDS_OST)+wid*2048;
    #pragma unroll
    for(int r=0;r<16;++r){const int orow=crow(r,hi);
      #pragma unroll
      for(int d0=0;d0<2;++d0)stg[orow*64+d0*32+r32]=__float2bfloat16(o[d0][r]*rli[r]);}
    asm volatile("s_waitcnt lgkmcnt(0)":::"memory");
    #pragma unroll
    for(int i=0;i<4;++i){const int row=i*8+(lane>>3),ch=lane&7; const u32x4 v=*(const u32x4*)(stg+row*64+ch*8); ATTN_STORE16(Ow+(long)row*OP+ch*8,v);} }
  asm volatile("s_waitcnt lgkmcnt(0)\n\ts_barrier":::"memory");
  #undef ADDB
  #undef DLSTORE
  #undef DMA_K
  #undef DMA_V
  #undef CMASK
  #undef START
  #undef RESC
  #undef ROT
}
constexpr int ATTN_LDS_BYTES=LDS_BYTES;
#undef SBAR
#undef WAIT_BAR
}
namespace dense_body {
using bf16 = __hip_bfloat16;
constexpr int   D = 128, NW = 8, QBLK = 32, KVBLK = 64;
constexpr float SCALE = 0.088388347648318440f;
constexpr float THR = 8.f;
constexpr int SDEPTH = 2;
constexpr int LDQ = 512, LDK = 512, LDO = 1536;
constexpr size_t SHM_V = KVBLK * D * 2, SHM_K = KVBLK * D * 2, SHM_ATTN = 2 * SHM_V + 2 * SHM_K + NW * 64 * 4;
using bf16x8 = __attribute__((ext_vector_type(8))) short;
using s16x4  = __attribute__((ext_vector_type(4))) short;
using f32x16 = __attribute__((ext_vector_type(16))) float;
using f32x8  = __attribute__((ext_vector_type(8))) float;
using u32x4  = __attribute__((ext_vector_type(4))) unsigned;
#define KSWZ(row, colB) ((row) * 256 + ((colB) ^ (((row) & 7) << 4)))
#define SBAR() __builtin_amdgcn_sched_barrier(0)
__device__ __forceinline__ int crow(int r, int hi) { return (r & 3) + 8 * (r >> 2) + 4 * hi; }
__device__ __forceinline__ unsigned cvtpk(float lo, float hi) {
  unsigned r; asm volatile("v_cvt_pk_bf16_f32 %0, %1, %2" : "=v"(r) : "v"(lo), "v"(hi)); return r;
}
template <typename TIn> struct Stage;
template <> struct Stage<bf16>  { using T = bf16x8;
  __device__ static __forceinline__ T ld8(const bf16* p) { return *reinterpret_cast<const bf16x8*>(p); }
  __device__ static __forceinline__ bf16x8 tobf(T x) { return x; } };
template <> struct Stage<float> { using T = f32x8;
  __device__ static __forceinline__ T ld8(const float* p) { return *reinterpret_cast<const f32x8*>(p); }
  __device__ static __forceinline__ bf16x8 tobf(T x) {
    u32x4 w = {cvtpk(x[0], x[1]), cvtpk(x[2], x[3]), cvtpk(x[4], x[5]), cvtpk(x[6], x[7])}; return *reinterpret_cast<bf16x8*>(&w); } };

__device__ __forceinline__ void partialSM(f32x16& p0, f32x16& p1, float& m_reg, float& mn, float& alpha) {
  constexpr float C = SCALE * 1.4426950408889634f;
  float pmax = p0[0]; for (int r = 1; r < 16; ++r) pmax = fmaxf(pmax, p0[r]); for (int r = 0; r < 16; ++r) pmax = fmaxf(pmax, p1[r]);
  { auto rr = __builtin_amdgcn_permlane32_swap(__float_as_uint(pmax), __float_as_uint(pmax), false, false);
    pmax = fmaxf(__uint_as_float(rr[0]), __uint_as_float(rr[1])); }
  if (__builtin_expect(__all(pmax - m_reg <= THR / SCALE), 1)) { mn = m_reg; alpha = 1.f; }
  else { mn = fmaxf(m_reg, pmax); alpha = __builtin_amdgcn_exp2f((m_reg - mn) * C); m_reg = mn; }
  float mnC = -mn * C;
  for (int r = 0; r < 16; ++r) p0[r] = fmaf(p0[r], C, mnC); for (int r = 0; r < 16; ++r) p1[r] = fmaf(p1[r], C, mnC);
  for (int r = 0; r < 16; ++r) p0[r] = __builtin_amdgcn_exp2f(p0[r]);
}
__device__ __forceinline__ void finishSM(f32x16& p0, f32x16& p1, float alpha, float& l_reg, bf16x8& pa0, bf16x8& pa1, bf16x8& pa2, bf16x8& pa3) {
  for (int r = 0; r < 16; ++r) p1[r] = __builtin_amdgcn_exp2f(p1[r]);
  float ps = 0; for (int r = 0; r < 16; ++r) ps += p0[r]; for (int r = 0; r < 16; ++r) ps += p1[r];
  { auto rr = __builtin_amdgcn_permlane32_swap(__float_as_uint(ps), __float_as_uint(ps), false, false);
    ps = __uint_as_float(rr[0]) + __uint_as_float(rr[1]); }
  l_reg = l_reg * alpha + ps;
#define PK4(P, BASE, OUT) do { unsigned a0 = cvtpk(P[BASE + 0], P[BASE + 1]), a1 = cvtpk(P[BASE + 2], P[BASE + 3]);   \
    unsigned b0 = cvtpk(P[BASE + 4], P[BASE + 5]), b1 = cvtpk(P[BASE + 6], P[BASE + 7]);                              \
    auto r0 = __builtin_amdgcn_permlane32_swap(a0, b0, false, false); auto r1 = __builtin_amdgcn_permlane32_swap(a1, b1, false, false); \
    u32x4 w = {r0[0], r1[0], r0[1], r1[1]}; OUT = *reinterpret_cast<bf16x8*>(&w); } while (0)
  PK4(p0, 0, pa0); PK4(p0, 8, pa1); PK4(p1, 0, pa2); PK4(p1, 8, pa3);
#undef PK4
}
__device__ __forceinline__ void qkt(f32x16& p0, f32x16& p1, const bf16* Ks, const bf16x8* qr, int r32, int hi) {
  p0 = f32x16{}; p1 = f32x16{};
  for (int d0 = 0; d0 < 8; ++d0) { int cb = (d0 * 16 + hi * 8) * 2;
    bf16x8 b0 = *reinterpret_cast<const bf16x8*>((const char*)Ks + KSWZ(r32, cb));
    bf16x8 b1 = *reinterpret_cast<const bf16x8*>((const char*)Ks + KSWZ(32 + r32, cb));
    p0 = __builtin_amdgcn_mfma_f32_32x32x16_bf16(b0, qr[d0], p0, 0, 0, 0);
    p1 = __builtin_amdgcn_mfma_f32_32x32x16_bf16(b1, qr[d0], p1, 0, 0, 0); }
}
__device__ __forceinline__ int v_st(int k, int c) { const int kk = (k & ~0xC) | ((k & 4) << 1) | ((k & 8) >> 1); return ((kk >> 3) * 4 + (c >> 5)) * 512 + ((kk & 7) * 32 + (c & 31)) * 2; }
__device__ __forceinline__ int v_rd_base(int lane) { return ((lane & 3) << 3) | (((lane >> 2) & 3) << 6) | (((lane >> 4) & 1) << 5) | (((lane >> 5) & 1) << 8); }
constexpr int v_rd_off(int d0, int ks, int half) { return d0 * 512 + ks * 4096 + half * 2048; }
template <int OFF> __device__ __forceinline__ s16x4 tr_read(int vb) {
  s16x4 r; asm volatile("ds_read_b64_tr_b16 %0, %1 offset:%2" : "=&v"(r) : "v"(vb), "i"(OFF) : "memory"); return r;
}
template <int D0> __device__ __forceinline__ void pv_one(f32x16& od, int vb, bf16x8 pa0, bf16x8 pa1, bf16x8 pa2, bf16x8 pa3) {
  const s16x4 l0 = tr_read<v_rd_off(D0, 0, 0)>(vb), h0 = tr_read<v_rd_off(D0, 0, 1)>(vb), l1 = tr_read<v_rd_off(D0, 1, 0)>(vb), h1 = tr_read<v_rd_off(D0, 1, 1)>(vb);
  const s16x4 l2 = tr_read<v_rd_off(D0, 2, 0)>(vb), h2 = tr_read<v_rd_off(D0, 2, 1)>(vb), l3 = tr_read<v_rd_off(D0, 3, 0)>(vb), h3 = tr_read<v_rd_off(D0, 3, 1)>(vb);
  asm volatile("s_waitcnt lgkmcnt(0)" ::: "memory"); SBAR();
#define PK(L, H) (bf16x8){L[0], L[1], L[2], L[3], H[0], H[1], H[2], H[3]}
  od = __builtin_amdgcn_mfma_f32_32x32x16_bf16(pa0, PK(l0, h0), od, 0, 0, 0);
  od = __builtin_amdgcn_mfma_f32_32x32x16_bf16(pa1, PK(l1, h1), od, 0, 0, 0);
  od = __builtin_amdgcn_mfma_f32_32x32x16_bf16(pa2, PK(l2, h2), od, 0, 0, 0);
  od = __builtin_amdgcn_mfma_f32_32x32x16_bf16(pa3, PK(l3, h3), od, 0, 0, 0);
#undef PK
}
__device__ __forceinline__ void pv_d0(f32x16* o, int vb, bf16x8 pa0, bf16x8 pa1, bf16x8 pa2, bf16x8 pa3) {
  pv_one<0>(o[0], vb, pa0, pa1, pa2, pa3); pv_one<1>(o[1], vb, pa0, pa1, pa2, pa3); pv_one<2>(o[2], vb, pa0, pa1, pa2, pa3); pv_one<3>(o[3], vb, pa0, pa1, pa2, pa3);
}

__device__ __forceinline__ void mem_stage_kv(const bf16* __restrict__ Kh, const bf16* __restrict__ Vh, char* kv) {
  const int tid = threadIdx.x, sr = tid >> 4, sc = (tid & 15) * 8;
  bf16x8 kr[4][2], vr[4][2];
#pragma unroll
  for (int t = 0; t < 4; ++t) { kr[t][0] = *reinterpret_cast<const bf16x8*>(&Kh[(long)(t * 64 + sr) * LDK + sc]); kr[t][1] = *reinterpret_cast<const bf16x8*>(&Kh[(long)(t * 64 + 32 + sr) * LDK + sc]);
                                vr[t][0] = *reinterpret_cast<const bf16x8*>(&Vh[(long)(t * 64 + sr) * LDK + sc]); vr[t][1] = *reinterpret_cast<const bf16x8*>(&Vh[(long)(t * 64 + 32 + sr) * LDK + sc]); }
#pragma unroll
  for (int t = 0; t < 4; ++t) { char* kb = kv + t * SHM_K; char* vb = kv + 4 * SHM_K + t * SHM_V; const int kc = sc * 2;
    *(bf16x8*)(kb + KSWZ(sr, kc)) = kr[t][0]; *(bf16x8*)(kb + KSWZ(32 + sr, kc)) = kr[t][1];
    *(bf16x8*)(vb + v_st(sr, sc)) = vr[t][0]; *(bf16x8*)(vb + v_st(32 + sr, sc)) = vr[t][1]; }
  __syncthreads();
}
__device__ __forceinline__ void mem_qblock(const bf16* __restrict__ Qb, bf16* __restrict__ Ob, char* kv, char* scr, char* stg_all) {
  int tid_ = threadIdx.x; asm volatile("" : "+v"(tid_));
  const int tid = tid_, wid = tid >> 6, lane = tid & 63, r32 = lane & 31, hi = lane >> 5;
  float* ws = (float*)scr + wid * 64; float* li_l = ws; float* al_l = ws + 32;
  float m_reg = -1e30f, l_reg = 0; f32x16 o[4] = {}; bf16x8 qr[8];
  const bf16* Qw = Qb + (long)(wid * QBLK + r32) * LDQ + hi * 8;
#pragma unroll
  for (int d0 = 0; d0 < 8; ++d0) qr[d0] = *reinterpret_cast<const bf16x8*>(Qw + d0 * 16);
  const int vb0 = (int)(uintptr_t)(kv + 4 * SHM_K) + v_rd_base(lane);
#pragma unroll
  for (int t = 0; t < 4; ++t) {
    f32x16 p0, p1; float mn, al; bf16x8 pa0, pa1, pa2, pa3;
    qkt(p0, p1, (const bf16*)(kv + t * SHM_K), qr, r32, hi);
    partialSM(p0, p1, m_reg, mn, al);
    if (__any(al < 1.f)) { if (hi == 0) al_l[r32] = al; asm volatile("s_waitcnt lgkmcnt(0)" ::: "memory");
#pragma unroll
      for (int d = 0; d < 4; ++d)
#pragma unroll
        for (int r = 0; r < 16; ++r) o[d][r] *= al_l[crow(r, hi)]; }
    finishSM(p0, p1, al, l_reg, pa0, pa1, pa2, pa3); SBAR();
    pv_d0(o, vb0 + t * (int)SHM_V, pa0, pa1, pa2, pa3);
  }
  if (hi == 0) li_l[r32] = l_reg; asm volatile("s_waitcnt lgkmcnt(0)" ::: "memory");
  float rli[16];
#pragma unroll
  for (int r = 0; r < 16; ++r) rli[r] = __builtin_amdgcn_rcpf(li_l[crow(r, hi)]);
  bf16* stg = (bf16*)stg_all + wid * 1024;
  bf16* Ow = Ob + (long)(wid * QBLK) * LDO;
#pragma unroll
  for (int d0 = 0; d0 < 4; ++d0) {
#pragma unroll
    for (int r = 0; r < 16; ++r) stg[crow(r, hi) * 32 + r32] = __float2bfloat16(o[d0][r] * rli[r]);
    asm volatile("s_waitcnt lgkmcnt(0)" ::: "memory");
#pragma unroll
    for (int i = 0; i < 2; ++i) { const int row = i * 16 + (lane >> 2), ch = lane & 3; const u32x4 v = *(const u32x4*)(stg + row * 32 + ch * 8); *(u32x4*)(Ow + (long)row * LDO + d0 * 32 + ch * 8) = v; }
    asm volatile("s_waitcnt lgkmcnt(0)" ::: "memory");
  }
}
#undef KSWZ
#undef SBAR
}
namespace small_attn {
typedef float f32x4 __attribute__((ext_vector_type(4)));
typedef unsigned u32x4 __attribute__((ext_vector_type(4)));
typedef unsigned short bf16_t;
#define SA_LAS __attribute__((address_space(3)))
__device__ __forceinline__ float bf2f(unsigned short b) { return __uint_as_float((unsigned)b << 16); }
typedef float sa_f32x2 __attribute__((ext_vector_type(2))); typedef __bf16 sa_bf16x2 __attribute__((ext_vector_type(2)));
__device__ __forceinline__ unsigned pk2s(float lo, float hi) { sa_f32x2 v = {lo, hi}; sa_bf16x2 b = __builtin_convertvector(v, sa_bf16x2); return __builtin_bit_cast(unsigned, b); }
__device__ __forceinline__ unsigned short f2bf(float f) { unsigned u = __float_as_uint(f); return (unsigned short)((u + 0x7fffu + ((u >> 16) & 1u)) >> 16); }
template <int DH, bool FOX>
__device__ __forceinline__ void unit(const bf16_t* Q, const float* Kc, const float* Vc, const bf16_t* Kn, const bf16_t* Vn, const float* dS, bf16_t* O, float qscale, SA_LAS unsigned char* lds) {
    constexpr int DB = DH / 16, NBC = FOX ? 16 : 2, NB = FOX ? 17 : 2, CP = 512;
    const int tid = threadIdx.x, lane = tid & 63, i = lane & 15, g = lane >> 4; const int wid = __builtin_amdgcn_readfirstlane(tid >> 6);
    typedef short bf16x8s __attribute__((ext_vector_type(8)));
    constexpr int NT32 = DH / 32;
    bf16x8s qf[NT32];
#pragma unroll
    for (int t = 0; t < NT32; ++t) qf[t] = *(const bf16x8s*)(Q + (size_t)i * 512 + 32 * t + 8 * g);
    const float dref = FOX ? dS[2063] : 0.f;
    f32x4 s[NB];
    const int kb0 = wid * NBC * 16;
    constexpr int GB = FOX ? 4 : 2;
    f32x4 kb[2][GB][NT32][2];
#define SA_LOADK(buf, grp) do { _Pragma("unroll") for (int b_ = 0; b_ < GB; ++b_) { const float* kp_ = Kc + (size_t)(kb0 + ((grp) * GB + b_) * 16 + i) * CP + 8 * g; \
        _Pragma("unroll") for (int t_ = 0; t_ < NT32; ++t_) { kb[buf][b_][t_][0] = __builtin_nontemporal_load((const f32x4*)(kp_ + 32 * t_)); kb[buf][b_][t_][1] = __builtin_nontemporal_load((const f32x4*)(kp_ + 32 * t_ + 4)); } } } while (0)
    SA_LOADK(0, 0);
#pragma unroll
    for (int grp = 0; grp < NBC / GB; ++grp) {
        if (grp + 1 < NBC / GB) SA_LOADK((grp + 1) & 1, grp + 1);
#pragma unroll
        for (int b_ = 0; b_ < GB; ++b_) { f32x4 a = (f32x4){0.f, 0.f, 0.f, 0.f};
#pragma unroll
            for (int t = 0; t < NT32; ++t) { const f32x4 k0 = kb[grp & 1][b_][t][0], k1 = kb[grp & 1][b_][t][1];
                u32x4 w; w.x = pk2s(k0[0], k0[1]); w.y = pk2s(k0[2], k0[3]); w.z = pk2s(k1[0], k1[1]); w.w = pk2s(k1[2], k1[3]);
                a = __builtin_amdgcn_mfma_f32_16x16x32_bf16(__builtin_bit_cast(bf16x8s, w), qf[t], a, 0, 0, 0); }
            const int blk = grp * GB + b_;
            if (FOX) { const f32x4 bv = *(const f32x4*)(dS + kb0 + blk * 16 + 4 * g); a = a + (bv - dref); } else { a = a * qscale; }
            s[blk] = a; }
    }
#undef SA_LOADK
    if constexpr (FOX) {
        f32x4 a = (f32x4){0.f, 0.f, 0.f, 0.f};
        if (wid == 7) {
#pragma unroll
            for (int t = 0; t < NT32; ++t) a = __builtin_amdgcn_mfma_f32_16x16x32_bf16(*(const bf16x8s*)(Kn + (size_t)i * 512 + 32 * t + 8 * g), qf[t], a, 0, 0, 0);
            const f32x4 bv = *(const f32x4*)(dS + 2048 + 4 * g); a = a + (bv - dref);
#pragma unroll
            for (int r = 0; r < 4; ++r) if (4 * g + r > i) a[r] = -INFINITY;
        } else { a = (f32x4){-INFINITY, -INFINITY, -INFINITY, -INFINITY}; }
        s[NB - 1] = a;
    }
    float mx = -INFINITY;
#pragma unroll
    for (int blk = 0; blk < NB; ++blk) mx = fmaxf(fmaxf(mx, fmaxf(s[blk][0], s[blk][1])), fmaxf(s[blk][2], s[blk][3]));
    mx = fmaxf(mx, __shfl_xor(mx, 16)); mx = fmaxf(mx, __shfl_xor(mx, 32));
    float ls = 0.f;
#pragma unroll
    for (int blk = 0; blk < NB; ++blk)
#pragma unroll
        for (int r = 0; r < 4; ++r) { const float p = __builtin_amdgcn_exp2f(s[blk][r] - mx); s[blk][r] = p; ls += p; }
    ls += __shfl_xor(ls, 16); ls += __shfl_xor(ls, 32);
    f32x4 oacc[DB];
#pragma unroll
    for (int db = 0; db < DB; ++db) oacc[db] = (f32x4){0.f, 0.f, 0.f, 0.f};
    { f32x4 vb[2][GB][4][DB / 4];
#define SA_LOADV(buf, grp) do { _Pragma("unroll") for (int b_ = 0; b_ < GB; ++b_) _Pragma("unroll") for (int st_ = 0; st_ < 4; ++st_) { const float* vp_ = Vc + (size_t)(kb0 + ((grp) * GB + b_) * 16 + 4 * g + st_) * CP + DB * i; \
        _Pragma("unroll") for (int c_ = 0; c_ < DB / 4; ++c_) vb[buf][b_][st_][c_] = __builtin_nontemporal_load((const f32x4*)(vp_ + 4 * c_)); } } while (0)
      SA_LOADV(0, 0);
#pragma unroll
      for (int grp = 0; grp < NBC / GB; ++grp) {
          if (grp + 1 < NBC / GB) SA_LOADV((grp + 1) & 1, grp + 1);
#pragma unroll
          for (int b_ = 0; b_ < GB; ++b_)
#pragma unroll
              for (int st = 0; st < 4; ++st)
#pragma unroll
                  for (int c = 0; c < DB / 4; ++c) { const f32x4 vv = vb[grp & 1][b_][st][c];
#pragma unroll
                      for (int e = 0; e < 4; ++e) oacc[4 * c + e] = __builtin_amdgcn_mfma_f32_16x16x4f32(s[grp * GB + b_][st], vv[e], oacc[4 * c + e], 0, 0, 0); } }
#undef SA_LOADV
    }
    if constexpr (FOX) { if (wid == 7) {
#pragma unroll
        for (int st = 0; st < 4; ++st) { const bf16_t* vp = Vn + (size_t)(4 * g + st) * 512 + DB * i;
            const unsigned long long w = *(const unsigned long long*)vp;
            const float vf[4] = {__uint_as_float((unsigned)(w << 16) & 0xffff0000u), __uint_as_float((unsigned)w & 0xffff0000u), __uint_as_float((unsigned)(w >> 16) & 0xffff0000u), __uint_as_float((unsigned)(w >> 32) & 0xffff0000u)};
#pragma unroll
            for (int e = 0; e < 4; ++e) oacc[e] = __builtin_amdgcn_mfma_f32_16x16x4f32(s[NB - 1][st], vf[e], oacc[e], 0, 0, 0); } } }
    SA_LAS float* Ml = (SA_LAS float*)lds; SA_LAS float* Ll = Ml + 128; SA_LAS float* Ol = Ll + 128;
    if (g == 0) { Ml[wid * 16 + i] = mx; Ll[wid * 16 + i] = ls; }
#pragma unroll
    for (int r = 0; r < 4; ++r)
#pragma unroll
        for (int c = 0; c < DB / 4; ++c) *(SA_LAS f32x4*)(Ol + (size_t)(wid * 16 + 4 * g + r) * DH + DB * i + 4 * c) = (f32x4){oacc[4 * c + 0][r], oacc[4 * c + 1][r], oacc[4 * c + 2][r], oacc[4 * c + 3][r]};
    __syncthreads();
    for (int e = tid; e < 16 * DH; e += 512) { const int q = e / DH, d = e % DH;
        float M = Ml[q];
#pragma unroll
        for (int w = 1; w < 8; ++w) M = fmaxf(M, Ml[w * 16 + q]);
        float num = 0.f, den = 0.f;
#pragma unroll
        for (int w = 0; w < 8; ++w) { const float f = __builtin_amdgcn_exp2f(Ml[w * 16 + q] - M); num += f * Ol[(size_t)(w * 16 + q) * DH + d]; den += f * Ll[w * 16 + q]; }
        O[(size_t)q * 1536 + d] = f2bf(num / den); }
    __syncthreads();
}
#undef SA_LAS
}
constexpr int NWAVES = 8;
constexpr int DM = 1024, FF = 4096, TOKP = 32768, TOKS = 256, TOK = TOKP + TOKS, NMEMROWS = 2048, NIN = 5632;
constexpr float EPS = 1e-6f;
constexpr size_t MiB = 1u << 20;
constexpr size_t WS_CTL = 0, CTL_ZERO_BYTES = 1 * MiB;
constexpr size_t WS_W1T = 1 * MiB;
constexpr size_t WS_WMT = 14 * MiB;
constexpr size_t WS_WOT = 17 * MiB;
constexpr size_t WS_WUT = 19 * MiB;
constexpr int FFP = FF + 64;
constexpr size_t WS_WDT = 497 * MiB;
constexpr size_t WS_DP = 35 * MiB;
constexpr size_t WS_DS = 36 * MiB;
constexpr size_t WS_Q = 40 * MiB, ACT512 = (size_t)TOK * 512 * 2;
constexpr size_t WS_K = WS_Q + ACT512, WS_V = WS_K + ACT512, WS_U = WS_V + ACT512, WS_QM = WS_U + ACT512;
constexpr size_t WS_MK = 202 * MiB, WS_MV = 204 * MiB;
constexpr size_t WS_G = 206 * MiB;
constexpr size_t WS_XN8 = 304 * MiB;
constexpr size_t WS_W8 = 340 * MiB, WS_SX = 344 * MiB, WS_SW = 345 * MiB;
constexpr size_t WS_AM = 400 * MiB;
constexpr size_t WS_END = 506 * MiB;
constexpr size_t WS_MM = WS_Q;
constexpr size_t WS_HB = WS_V;
constexpr size_t WS_A2 = WS_G;
static_assert(WS_QM + ACT512 <= WS_MK && WS_G + (size_t)TOK * 3072 * 2 <= WS_AM && WS_AM + (size_t)TOK * 1536 * 2 <= WS_END && WS_A2 + (size_t)TOK * FFP * 2 <= WS_AM + (size_t)TOK * 1536 * 2 && WS_WDT + (size_t)1024 * FFP * 2 <= WS_END, "d_ws map");
static_assert(WS_MM + (size_t)TOK * 2048 <= WS_V && WS_HB + (size_t)TOK * 2048 <= WS_QM && WS_DS + 128 * 2064 * 4 <= WS_Q, "d_ws overlays");
constexpr int CW_BAR = 4096, CW_SSQ1 = 65536, CW_SSQ2 = 131072, CW_NRM = 2304, CW_QUEUE = 2600, CW_W8RDY = 2664, CW_Q1 = 2700, CW_Q2 = 2832, CW_Q3 = 2976, CW_CMAX = 32768, CW_CNT = 16384;
static_assert((CW_SSQ2 + TOK) * 4 <= (int)CTL_ZERO_BYTES, "CTL words inside the memset region");
constexpr int RING_OFF = 0, RING_BYTES = 131072, LDS_BYTES = 163840, LDSCTL_OFF = LDS_BYTES - 1024, MISC_OFF = LDSCTL_OFF + 320;
constexpr int TSCR_WAVE = 64 * 65 * 4, MEMSC_OFF = 8 * TSCR_WAVE, MEMST_OFF = MEMSC_OFF + 2048;
static_assert(MEMSC_OFF >= RING_BYTES && MEMST_OFF + 16384 <= LDSCTL_OFF, "LDS map");
constexpr int RTAB_OFF = MEMST_OFF + 16384;
constexpr int STAB_OFF = RTAB_OFF + 1024;
static_assert(STAB_OFF + 2304 <= LDSCTL_OFF, "LDS map");

#define GAS __attribute__((address_space(1)))
#define LAS __attribute__((address_space(3)))
typedef unsigned short bf16;
typedef unsigned v4u __attribute__((ext_vector_type(4)));
typedef float f32x4 __attribute__((ext_vector_type(4)));
typedef short bf16x8 __attribute__((ext_vector_type(8)));
typedef GAS unsigned gu32;
typedef GAS unsigned long long gu64;
#define RLX_AGENT __ATOMIC_RELAXED, __HIP_MEMORY_SCOPE_AGENT
#define LDS_WAIT() asm volatile("s_waitcnt lgkmcnt(0)" ::: "memory")
#define VM_WAIT() asm volatile("s_waitcnt vmcnt(0)" ::: "memory")
__device__ __forceinline__ unsigned long long rt() { return __builtin_amdgcn_s_memrealtime(); }
__device__ __forceinline__ unsigned f2bf(float f) { unsigned u = __builtin_bit_cast(unsigned, f); return (u + 0x7fffu + ((u >> 16) & 1u)) >> 16; }
typedef float pk_f32x2 __attribute__((ext_vector_type(2))); typedef __bf16 pk_bf16x2 __attribute__((ext_vector_type(2)));
__device__ __forceinline__ unsigned pk2(float lo, float hi) { pk_f32x2 v = {lo, hi}; return __builtin_bit_cast(unsigned, __builtin_convertvector(v, pk_bf16x2)); }

#define XB_TMO      128
#define XB_XCNT(j)  (256  + 64 * (j))
#define XB_XSUB(j)  (1280 + 64 * (j))
#define XB_XGEN(j)  (2304 + 64 * (j))
#define XB_TOP      3328
#define XB_TOPGEN   3392
#define XCD_BAR_WORDS 3456
#define XB_SPIN_CAP (1u << 18)

__device__ __forceinline__ unsigned xb_ld(unsigned* p)              { return __hip_atomic_load(p, __ATOMIC_RELAXED, __HIP_MEMORY_SCOPE_AGENT); }
__device__ __forceinline__ unsigned xb_add(unsigned* p, unsigned v) { return __hip_atomic_fetch_add(p, v, __ATOMIC_RELAXED, __HIP_MEMORY_SCOPE_AGENT); }
__device__ __forceinline__ unsigned xb_xcc_id() { return (unsigned)__builtin_amdgcn_s_getreg((3 << 11) | 20) & 0xFu; }
#define XB_SPIN(cond, bar) do { unsigned _sp = 0; while (cond) { __builtin_amdgcn_s_sleep(1); \
    if ((++_sp & 255u) == 0u) { if (xb_ld(&(bar)[XB_TMO])) break; if (_sp > XB_SPIN_CAP) { atomicAdd(&(bar)[XB_TMO], 1u); break; } } } } while (0)

struct XcdBarrier {
    unsigned* bar; unsigned x;
    volatile LAS unsigned* st;
};

__device__ __forceinline__ XcdBarrier xcd_barrier_post(unsigned* bar, volatile LAS unsigned* st) {
    XcdBarrier b; b.bar = bar; b.x = xb_xcc_id(); b.st = st;
    if (threadIdx.x == 0) (void)xb_add(&bar[XB_XCNT(b.x)], 1u);
    return b;
}
__device__ __forceinline__ void xcd_barrier_complete(unsigned* bar, unsigned x, unsigned& nloc, unsigned& nx) {
    const unsigned G = gridDim.x * gridDim.y * gridDim.z;
    unsigned sum, cnt, mine, sp = 0u;
    for (;;) {
        sum = 0u; cnt = 0u; mine = 0u;
#pragma unroll
        for (unsigned j = 0; j < 16; ++j) { const unsigned c = xb_ld(&bar[XB_XCNT(j)]); sum += c; cnt += (c > 0u) ? 1u : 0u; mine = (j == x) ? c : mine; }
        if (sum == G) break;
        __builtin_amdgcn_s_sleep(1);
        if ((++sp & 255u) == 0u) { if (xb_ld(&bar[XB_TMO])) break; if (sp > XB_SPIN_CAP) { atomicAdd(&bar[XB_TMO], 1u); break; } }
    }
    nloc = mine > 0u ? mine : 1u; nx = cnt > 0u ? cnt : 1u;
}

__device__ __forceinline__ void xcd_barrier(const XcdBarrier& b) {
    asm volatile("s_waitcnt vmcnt(0)" ::: "memory");
    __syncthreads();
    if (threadIdx.x == 0) {
        unsigned* bar = b.bar;
        __builtin_amdgcn_s_waitcnt(0);
        unsigned nloc = b.st[0], nx = b.st[1];
        if (nloc == 0u) { xcd_barrier_complete(bar, b.x, nloc, nx); b.st[0] = nloc; b.st[1] = nx; }
        const unsigned old = xb_add(&bar[XB_XSUB(b.x)], 1u);
        const unsigned gen = old / nloc;
        if (old + 1u == (gen + 1u) * nloc) {
            __builtin_amdgcn_fence(__ATOMIC_RELEASE, "agent");
            asm volatile("s_waitcnt vmcnt(0)" ::: "memory");
            const unsigned og = xb_add(&bar[XB_TOP], 1u);
            const unsigned tg = og / nx;
            if (og + 1u == (tg + 1u) * nx) xb_add(&bar[XB_TOPGEN], 1u);
            else XB_SPIN(xb_ld(&bar[XB_TOPGEN]) == tg, bar);
            __builtin_amdgcn_fence(__ATOMIC_ACQUIRE, "agent");
            xb_add(&bar[XB_XGEN(b.x)], 1u);
            asm volatile("s_waitcnt vmcnt(0)" ::: "memory");
        } else {
            XB_SPIN(xb_ld(&bar[XB_XGEN(b.x)]) == gen, bar);
            __builtin_amdgcn_fence(__ATOMIC_ACQUIRE, "agent");
            asm volatile("s_waitcnt vmcnt(0)" ::: "memory");
        }
    }
    __syncthreads();
}
__device__ __forceinline__ float bf2f(unsigned short b);
__device__ __forceinline__ float bf2f(unsigned short b) { return __uint_as_float((unsigned)b << 16); }
#define DPP_ADD(v, ctrl) ((v) + __builtin_bit_cast(float, __builtin_amdgcn_update_dpp(0, __builtin_bit_cast(int, (v)), (ctrl), 0xf, 0xf, false)))
#define DPP_ROR_ADD(v, n) ((v) + __builtin_bit_cast(float, __builtin_amdgcn_update_dpp(0, __builtin_bit_cast(int, (v)), 0x120 + (n), 0xf, 0xf, false)))
__device__ __forceinline__ float swap16_add(float a, float b) { auto r = __builtin_amdgcn_permlane16_swap(__float_as_uint(a), __float_as_uint(b), false, false); return __uint_as_float(r[0]) + __uint_as_float(r[1]); }
__device__ __forceinline__ float swap32_add(float a, float b) { auto r = __builtin_amdgcn_permlane32_swap(__float_as_uint(a), __float_as_uint(b), false, false); return __uint_as_float(r[0]) + __uint_as_float(r[1]); }
#define DPP_MAX(v, ctrl) fmaxf((v), __builtin_bit_cast(float, __builtin_amdgcn_update_dpp(0, __builtin_bit_cast(int, (v)), (ctrl), 0xf, 0xf, false)))
__device__ __forceinline__ float wave_max_abs(float v) {
    v = DPP_MAX(v, 0x128); v = DPP_MAX(v, 0x124); v = DPP_MAX(v, 0x122); v = DPP_MAX(v, 0x121);
    { auto r = __builtin_amdgcn_permlane16_swap(__float_as_uint(v), __float_as_uint(v), false, false); v = fmaxf(__uint_as_float(r[0]), __uint_as_float(r[1])); }
    { auto r = __builtin_amdgcn_permlane32_swap(__float_as_uint(v), __float_as_uint(v), false, false); v = fmaxf(__uint_as_float(r[0]), __uint_as_float(r[1])); }
    return v;
}
__device__ __forceinline__ float wave_sum(float v) {
    v = DPP_ROR_ADD(v, 8); v = DPP_ROR_ADD(v, 4); v = DPP_ROR_ADD(v, 2); v = DPP_ROR_ADD(v, 1);
    v = swap16_add(v, v); return swap32_add(v, v);
}
typedef short sg_bf16x8 __attribute__((ext_vector_type(8)));
typedef float sg_f32x16 __attribute__((ext_vector_type(16)));
typedef float sg_f32x4 __attribute__((ext_vector_type(4)));
__device__ __forceinline__ void sg_partial(const bf16* A, int lda, const bf16* Bt, int ldb, int ksteps  , LAS float* part, int lane) {
    const int i = lane & 15, g = lane >> 4;
    const bf16* ap = A + (size_t)i * lda + 8 * g; const bf16* bp = Bt + (size_t)i * ldb + 8 * g;
    sg_f32x4 acc[2][2];
#pragma unroll
    for (int a = 0; a < 2; ++a)
#pragma unroll
        for (int b = 0; b < 2; ++b) acc[a][b] = (sg_f32x4){0.f, 0.f, 0.f, 0.f};
#pragma unroll 8
    for (int s = 0; s < ksteps / 2; ++s) {
        const sg_bf16x8 a0 = *(const GAS sg_bf16x8*)(ap + 32 * s), a1 = *(const GAS sg_bf16x8*)(ap + (size_t)16 * lda + 32 * s), b0 = *(const GAS sg_bf16x8*)(bp + 32 * s), b1 = *(const GAS sg_bf16x8*)(bp + (size_t)16 * ldb + 32 * s);
        acc[0][0] = __builtin_amdgcn_mfma_f32_16x16x32_bf16(a0, b0, acc[0][0], 0, 0, 0); acc[0][1] = __builtin_amdgcn_mfma_f32_16x16x32_bf16(a0, b1, acc[0][1], 0, 0, 0);
        acc[1][0] = __builtin_amdgcn_mfma_f32_16x16x32_bf16(a1, b0, acc[1][0], 0, 0, 0); acc[1][1] = __builtin_amdgcn_mfma_f32_16x16x32_bf16(a1, b1, acc[1][1], 0, 0, 0); }
#pragma unroll
    for (int a = 0; a < 2; ++a)
#pragma unroll
        for (int b = 0; b < 2; ++b)
#pragma unroll
            for (int r = 0; r < 4; ++r) part[(16 * a + 4 * g + r) * 33 + 16 * b + i] = acc[a][b][r];
}
__device__ __forceinline__ void sg_tile(const bf16* A, int lda, const bf16* Bt, int ldb, int K, LAS float* part, int tid, float& c0, float& c1) {
    const int lane = tid & 63, wv = __builtin_amdgcn_readfirstlane(tid >> 6), kw = K / 8;
    __syncthreads();
    sg_partial(A + wv * kw, lda, Bt + wv * kw, ldb, kw / 16, part + wv * (32 * 33), lane);
    __syncthreads();
    const int row = tid >> 4, cc = (tid & 15) * 2; float s0 = 0.f, s1 = 0.f;
#pragma unroll
    for (int w = 0; w < 8; ++w) { s0 += part[w * (32 * 33) + row * 33 + cc]; s1 += part[w * (32 * 33) + row * 33 + cc + 1]; }
    c0 = s0; c1 = s1;
}
__device__ __forceinline__ void sg_merge(unsigned char* ws, LAS float* part, int tid, int vcu, int G) {
    const bf16 *AM = (const bf16*)(ws + WS_AM) + (size_t)TOKP * 1536, *WMT = (const bf16*)(ws + WS_WMT); const unsigned char* Gb = (const unsigned char*)(ws + WS_G); bf16* MM = (bf16*)(ws + WS_MM);
    const int lane = tid & 63, wv = __builtin_amdgcn_readfirstlane(tid >> 6);
    for (int t = vcu; t < 8 * 32; t += G) { const int tm = t & 7, tn = t >> 3; const int row = TOKP + tm * 32 + (tid >> 4), n = tn * 32 + (tid & 15) * 2;
        __syncthreads();
        if (wv < 6) { const int b = wv >> 1, kh = wv & 1; sg_partial(AM + (size_t)tm * 32 * 1536 + b * 512 + kh * 256, 1536, WMT + (size_t)tn * 32 * 1536 + b * 512 + kh * 256, 1536, 16, part + wv * (32 * 33), lane); }
        __syncthreads();
        const int r33 = (tid >> 4) * 33 + (tid & 15) * 2; float m0 = 0.f, m1 = 0.f;
#pragma unroll
        for (int b = 0; b < 3; ++b) { const LAS float* p0 = part + (2 * b) * (32 * 33) + r33; const LAS float* p1 = p0 + 32 * 33;
            const unsigned g = *(const GAS unsigned short*)(Gb + (size_t)row * 3072 + b * 1024 + n); m0 += (float)(g & 255u) * (1.0f / 255.0f) * (p0[0] + p1[0]); m1 += (float)(g >> 8) * (1.0f / 255.0f) * (p0[1] + p1[1]); }
        *(GAS unsigned*)(MM + (size_t)row * DM + n) = pk2(m0, m1); }
}
__device__ __forceinline__ void sg_wout(unsigned char* ws, float* out, const float* xs, LAS float* part, int tid, int vcu, int G) {
    const bf16 *MM = (const bf16*)(ws + WS_MM) + (size_t)TOKP * DM, *WOT = (const bf16*)(ws + WS_WOT); bf16* HB = (bf16*)(ws + WS_HB); float* ssq = (float*)(ws + WS_CTL) + CW_SSQ1;
    for (int t = vcu; t < 8 * 32; t += G) { const int tm = t & 7, tn = t >> 3; const int rs = tm * 32 + (tid >> 4), row = TOKP + rs, n = tn * 32 + (tid & 15) * 2; float c0, c1;
        sg_tile(MM + (size_t)tm * 32 * DM, DM, WOT + (size_t)tn * 32 * DM, DM, DM, part, tid, c0, c1);
        const float h0 = xs[(size_t)rs * DM + n] + c0, h1 = xs[(size_t)rs * DM + n + 1] + c1;
        out[(size_t)row * DM + n] = h0; out[(size_t)row * DM + n + 1] = h1; *(GAS unsigned*)(HB + (size_t)row * DM + n) = pk2(h0, h1);
        float s = h0 * h0 + h1 * h1; s += __shfl_xor(s, 1); s += __shfl_xor(s, 2); s += __shfl_xor(s, 4); s += __shfl_xor(s, 8);
        if ((tid & 15) == 0) atomicAdd(ssq + row, s); }
}
__device__ __forceinline__ void sg_up(unsigned char* ws, LAS float* part, int tid, int vcu, int G) {
    const bf16 *HB = (const bf16*)(ws + WS_HB) + (size_t)TOKP * DM, *WUT = (const bf16*)(ws + WS_WUT); bf16* A2 = (bf16*)(ws + WS_A2); const float* ssq = (const float*)(ws + WS_CTL) + CW_SSQ1;
    const int lane = tid & 63, wv = __builtin_amdgcn_readfirstlane(tid >> 6), i = lane & 15, g = lane >> 4; constexpr int PW = 132;
    for (int t = vcu; t < 8 * 32; t += G) { const int tm = t & 7, tn = t >> 3;
        __syncthreads();
        const bf16* ap = HB + (size_t)(tm * 32 + i) * DM + wv * 128 + 8 * g; const bf16* bp = WUT + (size_t)(tn * 128 + i) * DM + wv * 128 + 8 * g;
        sg_f32x4 acc[2][8];
#pragma unroll
        for (int a = 0; a < 2; ++a)
#pragma unroll
            for (int c = 0; c < 8; ++c) acc[a][c] = (sg_f32x4){0.f, 0.f, 0.f, 0.f};
#pragma unroll
        for (int s = 0; s < 4; ++s) { const sg_bf16x8 a0 = *(const GAS sg_bf16x8*)(ap + 32 * s), a1 = *(const GAS sg_bf16x8*)(ap + (size_t)16 * DM + 32 * s); sg_bf16x8 b[8];
#pragma unroll
            for (int c = 0; c < 8; ++c) b[c] = *(const GAS sg_bf16x8*)(bp + (size_t)(16 * c) * DM + 32 * s);
#pragma unroll
            for (int c = 0; c < 8; ++c) { acc[0][c] = __builtin_amdgcn_mfma_f32_16x16x32_bf16(a0, b[c], acc[0][c], 0, 0, 0); acc[1][c] = __builtin_amdgcn_mfma_f32_16x16x32_bf16(a1, b[c], acc[1][c], 0, 0, 0); } }
        LAS float* pw = part + wv * (32 * PW);
#pragma unroll
        for (int a = 0; a < 2; ++a)
#pragma unroll
            for (int c = 0; c < 8; ++c)
#pragma unroll
                for (int r = 0; r < 4; ++r) pw[(16 * a + 4 * g + r) * PW + 16 * c + i] = acc[a][c][r];
        __syncthreads();
        const int row = tid >> 4, c0 = (tid & 15) * 8; float sum[8];
#pragma unroll
        for (int e = 0; e < 8; ++e) sum[e] = 0.f;
#pragma unroll
        for (int w = 0; w < 8; ++w) { const LAS float* p = part + w * (32 * PW) + row * PW + c0; const sg_f32x4 x0 = *(const LAS sg_f32x4*)p, x1 = *(const LAS sg_f32x4*)(p + 4);
#pragma unroll
            for (int e = 0; e < 4; ++e) { sum[e] += x0[e]; sum[4 + e] += x1[e]; } }
        const size_t grow = (size_t)TOKP + tm * 32 + row;
        const float rs = 1.0f / sqrtf(__hip_atomic_load(ssq + grow, __ATOMIC_RELAXED, __HIP_MEMORY_SCOPE_AGENT) * (1.0f / 1024.0f) + 1e-6f);
#pragma unroll
        for (int e = 0; e < 8; ++e) { const float v = fmaxf(sum[e] * rs, 0.f); sum[e] = v * v; }
        *(GAS v4u*)(A2 + grow * FFP + tn * 128 + c0) = (v4u){pk2(sum[0], sum[1]), pk2(sum[2], sum[3]), pk2(sum[4], sum[5]), pk2(sum[6], sum[7])}; }
}
__device__ __forceinline__ void sg_down(unsigned char* ws, float* out, const float* gfin, LAS float* part, int tid, int vcu, int G) {
    const bf16 *A2 = (const bf16*)(ws + WS_A2) + (size_t)TOKP * FFP, *WDT = (const bf16*)(ws + WS_WDT); float* ssq = (float*)(ws + WS_CTL) + CW_SSQ2; unsigned* cnt = (unsigned*)(ws + WS_CTL) + CW_CNT + 64 * 128;
    for (int t = vcu; t < 8 * 32; t += G) { const int tm = t & 7, tn = t >> 3; const int row = TOKP + tm * 32 + (tid >> 4), n = tn * 32 + (tid & 15) * 2; float c0, c1;
        sg_tile(A2 + (size_t)tm * 32 * FFP, FFP, WDT + (size_t)tn * 32 * FFP, FFP, FF, part, tid, c0, c1);
        const float x0 = out[(size_t)row * DM + n] + c0, x1 = out[(size_t)row * DM + n + 1] + c1;
        float s = x0 * x0 + x1 * x1; s += __shfl_xor(s, 1); s += __shfl_xor(s, 2); s += __shfl_xor(s, 4); s += __shfl_xor(s, 8);
        if ((tid & 15) == 0) atomicAdd(ssq + row, s);
        asm volatile("s_waitcnt vmcnt(0)" ::: "memory");
        __syncthreads();
        if (tid < 64) { if (tid == 0) __hip_atomic_fetch_add(cnt + 64 * tm, 1u, __ATOMIC_RELAXED, __HIP_MEMORY_SCOPE_AGENT);
            for (unsigned sp = 0; sp < (1u << 18); ++sp) { if (__builtin_amdgcn_readfirstlane((int)__hip_atomic_load(cnt + 64 * tm, __ATOMIC_RELAXED, __HIP_MEMORY_SCOPE_AGENT)) >= 32) break; __builtin_amdgcn_s_sleep(2); } }
        __syncthreads();
        float tot = 0.f; if ((tid & 15) == 0) tot = __hip_atomic_load(ssq + row, __ATOMIC_RELAXED, __HIP_MEMORY_SCOPE_AGENT);
        tot = __shfl(tot, (tid & 63) & ~15);
        const float rs = 1.0f / sqrtf(tot * (1.0f / DM) + EPS);
        out[(size_t)row * DM + n] = x0 * rs * gfin[n]; out[(size_t)row * DM + n + 1] = x1 * rs * gfin[n + 1]; }
}
__device__ __forceinline__ void p0_transpose_item(const float* W, int src_pitch, int src_col, int k0, bf16* WT, int dst_pitch, int dst_row, int dst_k0, const float* kscale, LAS float* scr, int lane_, unsigned* cmax = nullptr) {
    int lane = lane_; asm volatile("" : "+v"(lane));
    float mx = 0.f;
#pragma unroll 16
    for (int kk = 0; kk < 64; ++kk) { float v = __builtin_nontemporal_load(W + (size_t)(k0 + kk) * src_pitch + src_col + lane); mx = fmaxf(mx, fabsf(v)); if (kscale) v *= kscale[k0 + kk]; scr[kk * 65 + lane] = v; }
    if (cmax) atomicMax(cmax + lane, __float_as_uint(mx));
    LDS_WAIT(); asm volatile("" ::: "memory");
    const int c = lane & 7;
#pragma unroll
    for (int j = 0; j < 8; ++j) { const int n = (lane >> 3) + 8 * j; const LAS float* s = scr + (8 * c) * 65 + n;
        v4u o; o.x = pk2(s[0 * 65], s[1 * 65]); o.y = pk2(s[2 * 65], s[3 * 65]); o.z = pk2(s[4 * 65], s[5 * 65]); o.w = pk2(s[6 * 65], s[7 * 65]);
        *(GAS v4u*)(WT + (size_t)(dst_row + n) * dst_pitch + dst_k0 + k0 + 8 * c) = o; }
    LDS_WAIT(); asm volatile("" ::: "memory");
}
__device__ __forceinline__ void p0_tblock_item(const float* W, int src_pitch, int src_col, int k0, bf16* WT, int dst_pitch, int dst_row, int dst_k0, const float* kscale, LAS float* tile, int tid_, unsigned* cmax = nullptr) {
    int tid = tid_; asm volatile("" : "+v"(tid));
    const int lane = tid & 63, wv = __builtin_amdgcn_readfirstlane(tid >> 6);
    f32x4 v[8];
#pragma unroll
    for (int i = 0; i < 8; ++i) v[i] = __builtin_nontemporal_load((const GAS f32x4*)(W + (size_t)(k0 + wv * 8 + i) * src_pitch + src_col + 4 * lane));
    f32x4 mx = (f32x4){0.f, 0.f, 0.f, 0.f};
#pragma unroll
    for (int i = 0; i < 8; ++i) { const int kk = wv * 8 + i; f32x4 x = v[i];
#pragma unroll
        for (int e = 0; e < 4; ++e) mx[e] = fmaxf(mx[e], fabsf(x[e]));
        if (kscale) x = x * kscale[k0 + kk];
        LAS float* p = tile + kk * 257 + 4 * lane; p[0] = x[0]; p[1] = x[1]; p[2] = x[2]; p[3] = x[3]; }
    if (cmax) {
#pragma unroll
        for (int e = 0; e < 4; ++e) atomicMax(cmax + 4 * lane + e, __float_as_uint(mx[e])); }
    __syncthreads();
    const int c = tid & 7;
#pragma unroll
    for (int j = 0; j < 4; ++j) { const int n = (tid >> 3) + 64 * j; const LAS float* s = tile + (8 * c) * 257 + n;
        v4u o; o.x = pk2(s[0 * 257], s[1 * 257]); o.y = pk2(s[2 * 257], s[3 * 257]); o.z = pk2(s[4 * 257], s[5 * 257]); o.w = pk2(s[6 * 257], s[7 * 257]);
        *(GAS v4u*)(WT + (size_t)(dst_row + n) * dst_pitch + dst_k0 + k0 + 8 * c) = o; }
    __syncthreads();
}
__device__ __forceinline__ void p1_w8_item(const float* w_in, const unsigned* cmax, signed char* W8, float* sw, int kb, int nb, LAS float* scr, int lane_) {
    int lane = lane_; asm volatile("" : "+v"(lane));
#pragma unroll 16
    for (int kk = 0; kk < 64; ++kk) scr[kk * 65 + lane] = w_in[(size_t)(kb * 64 + kk) * 5640 + 2568 + nb * 64 + lane];
    LDS_WAIT(); asm volatile("" ::: "memory");
    const int c = lane & 3;
#pragma unroll
    for (int j = 0; j < 4; ++j) { const int n = (lane >> 2) + 16 * j; const float cm = fmaxf(__uint_as_float(cmax[nb * 64 + n]), 1e-30f), qs = 127.0f / cm; const LAS float* s = scr + (16 * c) * 65 + n;
        unsigned w[4];
#pragma unroll
        for (int q = 0; q < 4; ++q) { const int a0 = (int)__builtin_rintf(s[(4 * q + 0) * 65] * qs), a1 = (int)__builtin_rintf(s[(4 * q + 1) * 65] * qs), a2 = (int)__builtin_rintf(s[(4 * q + 2) * 65] * qs), a3 = (int)__builtin_rintf(s[(4 * q + 3) * 65] * qs);
            w[q] = (unsigned)(a0 & 255) | ((unsigned)(a1 & 255) << 8) | ((unsigned)(a2 & 255) << 16) | ((unsigned)(a3 & 255) << 24); }
        *(GAS v4u*)(W8 + (size_t)(nb * 64 + n) * 1024 + kb * 64 + 16 * c) = (v4u){w[0], w[1], w[2], w[3]};
        if (kb == 0 && c == 0) sw[nb * 64 + n] = cm * (1.0f / 127.0f); }
    LDS_WAIT(); asm volatile("" ::: "memory");
}
__device__ __forceinline__ void p0_weff_item(int id, const float* w_pool, const float* s_pool, const float* w_br_pool, bf16* WMT, LAS float* scr, int lane_) {
    int lane = lane_; asm volatile("" : "+v"(lane));
    const int g = id >> 9, cb = (id >> 4) & 31, nb = id & 15, n = nb * 64 + lane;
    const float* wp = w_pool + (size_t)(g * 128 + cb * 4) * 128;
    const float sp0 = s_pool[g * 128 + lane], sp1 = s_pool[g * 128 + 64 + lane];
#pragma unroll
    for (int i = 0; i < 4; ++i) { scr[i * 128 + lane] = wp[i * 128 + lane] * sp0; scr[i * 128 + 64 + lane] = wp[i * 128 + 64 + lane] * sp1; }
    float acc[4];
#pragma unroll
    for (int i = 0; i < 4; ++i) acc[i] = 0.f;
#pragma unroll
    for (int hh = 0; hh < 2; ++hh) { float wv[64];
#pragma unroll
        for (int d = 0; d < 64; ++d) wv[d] = w_br_pool[(size_t)(g * 128 + hh * 64 + d) * 1024 + n];
#pragma unroll
        for (int d4 = 0; d4 < 16; ++d4)
#pragma unroll
            for (int i = 0; i < 4; ++i) { const f32x4 c4 = *(const LAS f32x4*)(scr + i * 128 + hh * 64 + d4 * 4);
                acc[i] = fmaf(c4[0], wv[d4 * 4 + 0], acc[i]); acc[i] = fmaf(c4[1], wv[d4 * 4 + 1], acc[i]); acc[i] = fmaf(c4[2], wv[d4 * 4 + 2], acc[i]); acc[i] = fmaf(c4[3], wv[d4 * 4 + 3], acc[i]); } }
    *(GAS unsigned long long*)(WMT + (size_t)n * 1536 + 512 + g * 128 + cb * 4) = (unsigned long long)pk2(acc[0], acc[1]) | ((unsigned long long)pk2(acc[2], acc[3]) << 32);
    LDS_WAIT(); asm volatile("" ::: "memory");
}
__device__ __forceinline__ void p0_token_rows(const float* xp, const float* xs, const float* g_attn, const LAS float* wfl, const float* b_f, bf16* XN, float* out, signed char* XN8, float* sx, int gw, int NGW, int lane) {
    f32x4 wfa[16], wfb[16], gv[4];
#pragma unroll
    for (int j = 0; j < 4; ++j) { gv[j] = *(const GAS f32x4*)(g_attn + 256 * j + 4 * lane);
#pragma unroll
        for (int e = 0; e < 4; ++e) { const LAS float* p = wfl + (256 * j + 4 * lane + e) * 8; wfa[j * 4 + e] = *(const LAS f32x4*)p; wfb[j * 4 + e] = *(const LAS f32x4*)(p + 4); } }
    const float bfv = b_f[lane >> 3];
    f32x4 nx[4], nx2[4];
    { const int r0_ = gw < TOK ? gw : 0, r1_ = gw + NGW < TOK ? gw + NGW : 0;
      const float* xa = r0_ < TOKP ? xp + (size_t)r0_ * DM : xs + (size_t)(r0_ - TOKP) * DM; const float* xb = r1_ < TOKP ? xp + (size_t)r1_ * DM : xs + (size_t)(r1_ - TOKP) * DM;
#pragma unroll
      for (int j = 0; j < 4; ++j) { nx[j] = __builtin_nontemporal_load((const GAS f32x4*)(xa + 256 * j + 4 * lane)); nx2[j] = __builtin_nontemporal_load((const GAS f32x4*)(xb + 256 * j + 4 * lane)); } }
    for (int m = gw; m < TOK; m += NGW) {
        f32x4 v[4]; float ss = 0.f;
#pragma unroll
        for (int j = 0; j < 4; ++j) { v[j] = nx[j]; nx[j] = nx2[j]; ss += (v[j].x * v[j].x + v[j].y * v[j].y) + (v[j].z * v[j].z + v[j].w * v[j].w); }
        { const int mn = m + 2 * NGW < TOK ? m + 2 * NGW : 0; const float* xr = mn < TOKP ? xp + (size_t)mn * DM : xs + (size_t)(mn - TOKP) * DM;
#pragma unroll
          for (int j = 0; j < 4; ++j) nx2[j] = __builtin_nontemporal_load((const GAS f32x4*)(xr + 256 * j + 4 * lane)); }
        const float rstd = __builtin_amdgcn_rsqf(wave_sum(ss) * (1.0f / DM) + EPS);
        f32x4 fa = (f32x4){0.f, 0.f, 0.f, 0.f}, fb = (f32x4){0.f, 0.f, 0.f, 0.f};
        GAS unsigned long long* o8 = (GAS unsigned long long*)(XN + (size_t)m * DM) + lane;
        float amax = 0.f;
#pragma unroll
        for (int j = 0; j < 4; ++j) { v[j] = v[j] * rstd * gv[j];
            o8[64 * j] = (unsigned long long)pk2(v[j].x, v[j].y) | ((unsigned long long)pk2(v[j].z, v[j].w) << 32);
            amax = fmaxf(fmaxf(amax, fmaxf(fabsf(v[j].x), fabsf(v[j].y))), fmaxf(fabsf(v[j].z), fabsf(v[j].w)));
#pragma unroll
            for (int e = 0; e < 4; ++e) { fa += wfa[j * 4 + e] * v[j][e]; fb += wfb[j * 4 + e] * v[j][e]; } }
        if (m < TOKP) {
            amax = fmaxf(wave_max_abs(amax), 1e-20f); const float qs = 127.0f / amax;
            GAS unsigned* q8 = (GAS unsigned*)(XN8 + (size_t)m * DM) + lane;
#pragma unroll
            for (int j = 0; j < 4; ++j) { const int q0 = (int)__builtin_rintf(v[j].x * qs), q1 = (int)__builtin_rintf(v[j].y * qs), q2 = (int)__builtin_rintf(v[j].z * qs), q3 = (int)__builtin_rintf(v[j].w * qs);
                q8[64 * j] = (unsigned)(q0 & 255) | ((unsigned)(q1 & 255) << 8) | ((unsigned)(q2 & 255) << 16) | ((unsigned)(q3 & 255) << 24); }
            if (lane == 0) sx[m] = amax * (1.0f / 127.0f); }
        const bool b3 = lane & 8;
        f32x4 q4;
#pragma unroll
        for (int i = 0; i < 4; ++i) q4[i] = swap32_add(fa[i], fb[i]);
        const float q2a = swap16_add(q4[0], q4[2]), q2b = swap16_add(q4[1], q4[3]);
        const float s8a = DPP_ROR_ADD(q2a, 8), s8b = DPP_ROR_ADD(q2b, 8);
        float fz = b3 ? s8b : s8a;
        fz = DPP_ADD(fz, 0xB1); fz = DPP_ADD(fz, 0x4E); fz = DPP_ADD(fz, 0x141);
        if ((lane & 7) == 0) { const int fi = lane >> 3;
            const float z = fz + bfv;
            const float lf = fminf(z, 0.f) - log1pf(expf(-fabsf(z)));
            out[(m < TOKP ? pg8::O_LFP + (size_t)m * 8 : pg8::O_LFS + (size_t)(m - TOKP) * 8) + fi] = lf; }
    }
}
__device__ __forceinline__ void p0_mem_rows(const float* mem, const float* g_mem, bf16* MEMN, int gw, int NGW, int lane) {
    f32x4 gv[4];
#pragma unroll
    for (int j = 0; j < 4; ++j) gv[j] = *(const GAS f32x4*)(g_mem + 256 * j + 4 * lane);
    for (int m = gw; m < NMEMROWS; m += NGW) {
        const float* xr = mem + (size_t)m * DM; f32x4 v[4]; float ss = 0.f;
#pragma unroll
        for (int j = 0; j < 4; ++j) { v[j] = __builtin_nontemporal_load((const GAS f32x4*)(xr + 256 * j + 4 * lane)); ss += (v[j].x * v[j].x + v[j].y * v[j].y) + (v[j].z * v[j].z + v[j].w * v[j].w); }
        const float rstd = __builtin_amdgcn_rsqf(wave_sum(ss) * (1.0f / DM) + EPS);
        GAS unsigned long long* o8 = (GAS unsigned long long*)(MEMN + (size_t)m * DM) + lane;
#pragma unroll
        for (int j = 0; j < 4; ++j) { v[j] = v[j] * rstd * gv[j]; o8[64 * j] = (unsigned long long)pk2(v[j].x, v[j].y) | ((unsigned long long)pk2(v[j].z, v[j].w) << 32); }
    }
}
__device__ __forceinline__ void p1_cumsum(int seq, const float* out, const float* cache_logf, float* DP, float* DS, LAS unsigned char* lds, int tid) {
    const bool samp = seq >= 64; const int sidx = samp ? seq - 64 : seq, b = sidx >> 3, h = sidx & 7, L = samp ? 2064 : 4096, per = samp ? 5 : 8;
    const int lane = tid & 63, wv = tid >> 6;
    double loc[8]; double run = 0.0;
#pragma unroll
    for (int e = 0; e < 8; ++e) { loc[e] = 0.0; if (e < per) { const int idx = tid * per + e; float v = 0.f;
        if (idx < L) v = samp ? (idx < 2048 ? cache_logf[(size_t)(b * 2048 + idx) * 8 + h] : out[pg8::O_LFS + (size_t)(b * 16 + idx - 2048) * 8 + h]) : out[pg8::O_LFP + (size_t)(b * 4096 + idx) * 8 + h];
        run += (double)v; loc[e] = run; } }
    double incl = run;
#pragma unroll
    for (int o = 1; o < 64; o <<= 1) { const double t = __shfl_up(incl, o); if (lane >= o) incl += t; }
    LAS double* wt = (LAS double*)lds;
    if (lane == 63) wt[wv] = incl;
    __syncthreads();
    double base = incl - run;
#pragma unroll
    for (int w = 0; w < 8; ++w) if (w < wv) base += wt[w];
    float* D = samp ? DS + (size_t)sidx * 2064 : DP + (size_t)sidx * 4096;
#pragma unroll
    for (int e = 0; e < 8; ++e) if (e < per) { const int idx = tid * per + e; if (idx < L) D[idx] = (float)(-(base + loc[e]) * 1.4426950408889634); }
    __syncthreads();
}
__device__ __forceinline__ void p2_pool_item(int it, const bf16* U, const float* cache_pool, bf16* AM, int tid) {
    const int cc = tid & 63, tg = tid >> 6, g = cc >> 4, col = cc * 8, m0 = it * 64 + tg * 8; const bool samp = m0 >= TOKP;
    const int rs = m0 - TOKP, b = rs >> 4, t0 = samp ? (rs & 15) : (m0 & 4095);
    v4u rw[23];
    if (!samp) {
#pragma unroll
        for (int i = 0; i < 23; ++i) { const int t = t0 - 15 + i; rw[i] = *(const GAS v4u*)(U + (size_t)(t >= 0 ? m0 - 15 + i : m0) * 512 + col); }
#pragma unroll
        for (int i = 0; i < 15; ++i) if (t0 - 15 + i < 0) rw[i] = (v4u){0u, 0u, 0u, 0u};
    } else
#pragma unroll
    for (int i = 0; i < 23; ++i) { const int t = t0 - 15 + i;
        if (t >= 0) rw[i] = *(const GAS v4u*)(U + (size_t)(m0 - 15 + i) * 512 + col);
        else if (samp) { const float* cp = cache_pool + (size_t)(b * 15 + 15 + t) * 512 + col; const f32x4 c0 = *(const GAS f32x4*)cp, c1 = *(const GAS f32x4*)(cp + 4);
            rw[i] = (v4u){pk2(c0[0], c0[1]), pk2(c0[2], c0[3]), pk2(c1[0], c1[1]), pk2(c1[2], c1[3])}; }
        else rw[i] = (v4u){0u, 0u, 0u, 0u}; }
    unsigned ow[8][4];
#pragma unroll
    for (int wi = 0; wi < 4; ++wi) {
        float pl[24], ph[24]; pl[0] = 0.f; ph[0] = 0.f;
#pragma unroll
        for (int i = 0; i < 23; ++i) { const unsigned x = rw[i][wi]; pl[i + 1] = pl[i] + __uint_as_float(x << 16); ph[i + 1] = ph[i] + __uint_as_float(x & 0xffff0000u); }
#pragma unroll
        for (int tt = 0; tt < 8; ++tt) { const int e = 16 + tt;
            const float sl = pl[e] - (g == 0 ? pl[e - 2] : g == 1 ? pl[e - 4] : g == 2 ? pl[e - 8] : pl[e - 16]), sh = ph[e] - (g == 0 ? ph[e - 2] : g == 1 ? ph[e - 4] : g == 2 ? ph[e - 8] : ph[e - 16]);
            const int w = 2 << g, t = t0 + tt, cnt = samp ? w : (w < t + 1 ? w : t + 1); const float rc = 1.0f / (float)cnt;
            const unsigned x = rw[15 + tt][wi];
            ow[tt][wi] = pk2(sl * rc - __uint_as_float(x << 16), sh * rc - __uint_as_float(x & 0xffff0000u)); } }
#pragma unroll
    for (int tt = 0; tt < 8; ++tt) *(GAS v4u*)(AM + (size_t)(m0 + tt) * 1536 + 512 + col) = (v4u){ow[tt][0], ow[tt][1], ow[tt][2], ow[tt][3]};
}
struct Args { const float* in[24]; float* out; unsigned char* ws; };
__global__ void __launch_bounds__(NWAVES * 64, 2) fwd_megakernel(Args args) {
    extern __shared__ __attribute__((aligned(16))) unsigned char lds[];
    LAS unsigned char* L = (LAS unsigned char*)lds;
    volatile LAS unsigned* MISC = (volatile LAS unsigned*)(L + MISC_OFF);
    const int tid = threadIdx.x, lane = tid & 63, wave = __builtin_amdgcn_readfirstlane(tid >> 6);
    const int G = gridDim.x, bx = blockIdx.x, vcu = (G % 8 == 0) ? (bx % 8) * (G / 8) + bx / 8 : bx;
    volatile LAS unsigned* PT = (volatile LAS unsigned*)(L + LDSCTL_OFF);
#define PTRI(i) ((const float*)(const GAS float*)(((unsigned long long)(unsigned)__builtin_amdgcn_readfirstlane((int)PT[2 * (i) + 1]) << 32) | (unsigned long long)(unsigned)__builtin_amdgcn_readfirstlane((int)PT[2 * (i)])))
#define OUTP ((float*)PTRI(24))
#define WSP ((unsigned char*)PTRI(25))
    for (int u = tid; u < (LDS_BYTES - LDSCTL_OFF) / 4; u += NWAVES * 64) ((LAS unsigned*)(L + LDSCTL_OFF))[u] = 0u;
    if (tid < 256) ((LAS float*)(L + RTAB_OFF))[tid] = 1.0f / (float)(tid > 0 ? tid : 1);
    for (int k = tid; k < 2304; k += NWAVES * 64) { const float g = 1.0f / (1.0f + exp2f((float)(k - 1152) * (1.0f / 128.0f))); const int q = (int)(g * 255.0f + 0.5f); ((LAS unsigned char*)(L + STAB_OFF))[k] = (unsigned char)(q < 1 ? 1 : q > 255 ? 255 : q); }
    __syncthreads();
    if (tid == 0) {
#define PUT(i, p) do { const unsigned long long v_ = (unsigned long long)(uintptr_t)(p); PT[2 * (i)] = (unsigned)v_; PT[2 * (i) + 1] = (unsigned)(v_ >> 32); } while (0)
        PUT(0, args.in[0]); PUT(1, args.in[1]); PUT(2, args.in[2]); PUT(3, args.in[3]); PUT(4, args.in[4]); PUT(5, args.in[5]); PUT(6, args.in[6]); PUT(7, args.in[7]);
        PUT(8, args.in[8]); PUT(9, args.in[9]); PUT(10, args.in[10]); PUT(11, args.in[11]); PUT(12, args.in[12]); PUT(13, args.in[13]); PUT(14, args.in[14]); PUT(15, args.in[15]);
        PUT(16, args.in[16]); PUT(17, args.in[17]); PUT(18, args.in[18]); PUT(19, args.in[19]); PUT(20, args.in[20]); PUT(21, args.in[21]); PUT(22, args.in[22]); PUT(23, args.in[23]);
        PUT(24, args.out); PUT(25, args.ws);
#undef PUT
    }
    __syncthreads();
    XcdBarrier bar = xcd_barrier_post((unsigned*)(WSP + WS_CTL) + CW_BAR, MISC + 8);
    const int gw = vcu * NWAVES + wave, NGW = G * NWAVES;

    {
        LAS float* scr = (LAS float*)(L + wave * TSCR_WAVE);
        unsigned char* ws = WSP; float* out = OUTP;
        bf16* XN = (bf16*)out; bf16* MEMN = XN + (size_t)TOK * DM;
        bf16* W1T = (bf16*)(ws + WS_W1T);
        const float *w_in = PTRI(10), *w_mkv = PTRI(15);
        constexpr int I_IN = 16 * 88, I_MKV = 16 * 16, I_BF = 8 * 16, I_UP = 16 * 64, I_WE = 1024;
        const float *w_bf = PTRI(16), *w_bp = PTRI(17), *w_bm = PTRI(18), *w_up = PTRI(21), *g_mlp = PTRI(20), *w_pool = PTRI(12), *s_pool = PTRI(13);
        bf16 *WMT = (bf16*)(ws + WS_WMT), *WUT = (bf16*)(ws + WS_WUT);
        { LAS float* tile = (LAS float*)(L + RING_OFF);
          constexpr int B_IN = 16 * 22, B_MKV = 16 * 4, B_BF = 8 * 4, B_UP = 16 * 16;
          for (int it = vcu; it < B_IN + B_MKV + 2 * B_BF + B_UP; it += G) { int r = it;
            if (r < B_IN) { const int kb = r / 22, nb = r % 22, n0 = nb * 256; p0_tblock_item(w_in, 5640, n0 + (n0 >= 1536 ? 8 : 0), kb * 64, W1T, 1024, n0, 0, nullptr, tile, tid, n0 >= 2560 ? (unsigned*)(ws + WS_CTL) + CW_CMAX + (n0 - 2560) : nullptr); continue; } r -= B_IN;
            if (r < B_MKV) { const int kb = r / 4, nb = r % 4; p0_tblock_item(w_mkv, 1024, nb * 256, kb * 64, W1T, 1024, NIN + nb * 256, 0, nullptr, tile, tid); continue; } r -= B_MKV;
            if (r < B_BF) { const int kb = r / 4, nb = r % 4; p0_tblock_item(w_bf, 1024, nb * 256, kb * 64, WMT, 1536, nb * 256, 0, nullptr, tile, tid); continue; } r -= B_BF;
            if (r < B_BF) { const int kb = r / 4, nb = r % 4; p0_tblock_item(w_bm, 1024, nb * 256, kb * 64, WMT, 1536, nb * 256, 1024, nullptr, tile, tid); continue; } r -= B_BF;
            { const int kb = r / 16, nb = r % 16; p0_tblock_item(w_up, 4096, nb * 256, kb * 64, WUT, 1024, nb * 256, 0, g_mlp, tile, tid); } }
          for (int it = gw; it < 2048; it += NGW) p0_weff_item(it, w_pool, s_pool, w_bp, WMT, scr, lane); }
        p0_mem_rows(PTRI(2), PTRI(14), MEMN, gw, NGW, lane);
        { LAS float* wfl = (LAS float*)(L + RING_OFF);
          __syncthreads();
          for (int r = tid; r < 1024; r += NWAVES * 64) { const float* p = w_in + (size_t)r * 5640 + 1536; const f32x4 a = *(const GAS f32x4*)p, b = *(const GAS f32x4*)(p + 4); *(LAS f32x4*)(wfl + r * 8) = a; *(LAS f32x4*)(wfl + r * 8 + 4) = b; }
          __syncthreads(); }
        p0_token_rows(PTRI(0), PTRI(1), PTRI(9), (const LAS float*)(L + RING_OFF), PTRI(11), XN, out, (signed char*)(ws + WS_XN8), (float*)(ws + WS_SX), gw, NGW, lane);
    }
    xcd_barrier(bar);

    {
        unsigned char* ws = WSP; float* out = OUTP;
        bf16* XN = (bf16*)out; bf16* W1T = (bf16*)(ws + WS_W1T);
        for (int s = bx; s < 192; s += G) p1_cumsum(s, out, PTRI(5), (float*)(ws + WS_DP), (float*)(ws + WS_DS), L, tid);
        { LAS float* scr = (LAS float*)(L + wave * TSCR_WAVE);
          for (int it = gw; it < 16 * 48; it += NGW) p1_w8_item(PTRI(10), (const unsigned*)(ws + WS_CTL) + CW_CMAX, (signed char*)(ws + WS_W8), (float*)(ws + WS_SW), it / 48, it % 48, scr, lane);
          asm volatile("s_waitcnt vmcnt(0)" ::: "memory"); __syncthreads();
          if (tid == 0) { __builtin_amdgcn_fence(__ATOMIC_RELEASE, "agent"); asm volatile("s_waitcnt vmcnt(0)" ::: "memory"); __hip_atomic_fetch_add((unsigned*)(ws + WS_CTL) + CW_W8RDY, 1u, __ATOMIC_RELAXED, __HIP_MEMORY_SCOPE_AGENT); } }
        if (bx < 22) { struct OneUnit { int pm, pn; __device__ __forceinline__ bool next(int i, pg8::Unit& u) const { if (i) return false; u.pm = pm; u.pn = pn; u.kc = 0; return true; }
                                        __device__ __forceinline__ void a_ready(const pg8::Unit&) const {} __device__ __forceinline__ void done(const pg8::Unit&) const {} __device__ __forceinline__ void mid(int) const {} };
          pg8::Gemm g{XN, W1T, TOK, NIN, DM, DM}; OneUnit S{TOKP / 256, bx};
          pg8::EpiInProj E{(bf16*)(ws + WS_Q), (bf16*)(ws + WS_K), (bf16*)(ws + WS_V), (bf16*)(ws + WS_U), (bf16*)(ws + WS_QM), (bf16*)(ws + WS_G), out, (unsigned*)(ws + WS_CTL) + CW_NRM};
          pg8::gemm_phase<pg8::EpiInProj, OneUnit, true, true>(L + RING_OFF, g, S, E); }
        { pg8::Gemm g{XN + (size_t)TOK * DM, W1T + (size_t)NIN * DM, NMEMROWS, 1024, DM, DM}; pg8::StaticOrder S; S.init(NMEMROWS, 1024, G, (bx + G - 22) % G);
          pg8::EpiMemKV E{(bf16*)(ws + WS_MK), (bf16*)(ws + WS_MV), out};
          pg8::gemm_phase<pg8::EpiMemKV, pg8::StaticOrder, true, true>(L + RING_OFF, g, S, E); }
        { pg8::Gemm g{XN, W1T, TOKP, 2560, DM, DM}; pg8::QueueOrder S; S.init(TOKP, 2560, bx % 8, (unsigned*)(ws + WS_CTL) + CW_Q1 + 16 * (bx % 8), (volatile LAS int*)(L + LDSCTL_OFF + 528));
          pg8::EpiInProj E{(bf16*)(ws + WS_Q), (bf16*)(ws + WS_K), (bf16*)(ws + WS_V), (bf16*)(ws + WS_U), (bf16*)(ws + WS_QM), (bf16*)(ws + WS_G), out, (unsigned*)(ws + WS_CTL) + CW_NRM};
          pg8::gemm_phase<pg8::EpiInProj, pg8::QueueOrder, true, true>(L + RING_OFF, g, S, E); }
        { if (tid == 0) { unsigned* rdy = (unsigned*)(ws + WS_CTL) + CW_W8RDY;
              for (unsigned sp = 0; __hip_atomic_load(rdy, __ATOMIC_RELAXED, __HIP_MEMORY_SCOPE_AGENT) < (unsigned)G && sp < (1u << 20); ++sp) __builtin_amdgcn_s_sleep(4);
              __builtin_amdgcn_fence(__ATOMIC_ACQUIRE, "agent"); asm volatile("s_waitcnt vmcnt(0)" ::: "memory"); }
          __syncthreads();
          pg8::Gemm g{(const bf16*)(ws + WS_XN8), (const bf16*)(ws + WS_W8), TOKP, 3072, 512, 512}; pg8::QueueOrder S; S.init(TOKP, 3072, bx % 8, (unsigned*)(ws + WS_CTL) + CW_Q2 + 16 * (bx % 8), (volatile LAS int*)(L + LDSCTL_OFF + 544));
          pg8::EpiGates8 E{(unsigned char*)(ws + WS_G), (const float*)(ws + WS_SX), (const float*)(ws + WS_SW), (const LAS unsigned char*)(L + STAB_OFF)};
          pg8::gemm_phase<pg8::EpiGates8, pg8::QueueOrder, true, true, true>(L + RING_OFF, g, S, E); }
        { LAS float* scr = (LAS float*)(L + wave * TSCR_WAVE); bf16 *WOT = (bf16*)(ws + WS_WOT), *WDT = (bf16*)(ws + WS_WDT); const float *w_out = PTRI(19), *w_down = PTRI(22);
          constexpr int I_OUT = 16 * 16, I_DN = 64 * 16; unsigned* q3 = (unsigned*)(ws + WS_CTL) + CW_Q3;
          for (;;) { int it = 0; if (lane == 0) it = (int)__hip_atomic_fetch_add(q3, 1u, __ATOMIC_RELAXED, __HIP_MEMORY_SCOPE_AGENT); it = __builtin_amdgcn_readfirstlane(it);
              if (it >= I_OUT + I_DN) break; int r = it;
              if (r < I_OUT) { const int kb = r / 16, nb = r % 16; p0_transpose_item(w_out, 1024, nb * 64, kb * 64, WOT, 1024, nb * 64, 0, nullptr, scr, lane); continue; } r -= I_OUT;
              { const int kb = r / 16, nb = r % 16; p0_transpose_item(w_down, 1024, nb * 64, kb * 64, WDT, FFP, nb * 64, 0, nullptr, scr, lane); } } }

    }
    xcd_barrier(bar);

    {
        unsigned char* ws = WSP;
        bf16 *Qb = (bf16*)(ws + WS_Q), *Kb = (bf16*)(ws + WS_K), *Vb = (bf16*)(ws + WS_V), *QMb = (bf16*)(ws + WS_QM), *AM = (bf16*)(ws + WS_AM);
        for (int v = vcu; v < 192; v += G) {
            if (v < 128) { const int b = v >> 3, h = v & 7; const size_t r0 = (size_t)(TOKP + b * 16);
                small_attn::unit<64, true>(Qb + r0 * 512 + h * 64, PTRI(3) + ((size_t)b * 2048 * 8 + h) * 64, PTRI(4) + ((size_t)b * 2048 * 8 + h) * 64, Kb + r0 * 512 + h * 64, Vb + r0 * 512 + h * 64,
                                           (const float*)(ws + WS_DS) + (size_t)v * 2064, AM + r0 * 1536 + h * 64, 1.0f, L + RING_OFF); }
            else { const int u = v - 128, b = u >> 2, h = u & 3; const size_t r0 = (size_t)(TOKP + b * 16);
                small_attn::unit<128, false>(QMb + r0 * 512 + h * 128, PTRI(7) + ((size_t)b * 256 * 4 + h) * 128, PTRI(8) + ((size_t)b * 256 * 4 + h) * 128, nullptr, nullptr,
                                             nullptr, AM + r0 * 1536 + 1024 + h * 128, 0.08838834764831845f * 1.4426950408889634f, L + RING_OFF); }
        }
        for (int it = vcu; it < 512; it += G) p2_pool_item(it, (const bf16*)(ws + WS_U), PTRI(6), AM, tid);
        for (int it = 512 + (vcu - 252); it >= 512 && it < TOK / 64; it += G) p2_pool_item(it, (const bf16*)(ws + WS_U), PTRI(6), AM, tid);
        for (int id = 2 * vcu; id < 512; id += 2 * G) { const int bh = id >> 4, b = bh >> 2, h = bh & 3;
            char* kvl = (char*)lds + RING_OFF; char* scl = (char*)lds + MEMSC_OFF; char* stl = (char*)lds + MEMST_OFF;
            dense_body::mem_stage_kv((const dense_body::bf16*)((bf16*)(ws + WS_MK) + (size_t)b * 256 * 512 + h * 128), (const dense_body::bf16*)((bf16*)(ws + WS_MV) + (size_t)b * 256 * 512 + h * 128), kvl);
            for (int k = 0; k < 2; ++k) { const int qblk = (id + k) & 15; const size_t r0 = (size_t)b * 4096 + qblk * 256;
                dense_body::mem_qblock((const dense_body::bf16*)(QMb + r0 * 512 + h * 128), (dense_body::bf16*)(AM + r0 * 1536 + 1024 + h * 128), kvl, scl, stl); }
            __syncthreads(); }
        { volatile LAS int* uq = (volatile LAS int*)(L + LDSCTL_OFF + 512); unsigned* qctr = (unsigned*)(ws + WS_CTL) + CW_QUEUE;
          if (tid == 0) uq[0] = (int)__hip_atomic_fetch_add(qctr, 1u, __ATOMIC_RELAXED, __HIP_MEMORY_SCOPE_AGENT);
          __syncthreads();
          int u = __builtin_amdgcn_readfirstlane(uq[0]);
          while (u < 1024) {
            int z_; asm volatile("v_mov_b32 %0, 0" : "=v"(z_)); int pend = 0;
            if (tid == 0) pend = (int)__hip_atomic_fetch_add(qctr + z_, 1u, __ATOMIC_RELAXED, __HIP_MEMORY_SCOPE_AGENT);
            int p, qb; if (u < 896) { p = u / 14; qb = 2 + u % 14; } else { const int c = u - 896; p = c & 63; qb = 1 - (c >> 6); }
            const int b = p >> 3, h = p & 7; int ts;
            { int ln = lane; asm volatile("" : "+v"(ln));
              const float* dpp = (const float*)(ws + WS_DP) + (size_t)p * 4096; const unsigned* nq = (const unsigned*)(ws + WS_CTL) + CW_NRM + (size_t)p * 2; const unsigned* nk = nq + 128;
              const float qn2 = __uint_as_float(__hip_atomic_load(nq, __ATOMIC_RELAXED, __HIP_MEMORY_SCOPE_AGENT)) + __uint_as_float(__hip_atomic_load(nq + 1, __ATOMIC_RELAXED, __HIP_MEMORY_SCOPE_AGENT));
              const float kn2 = __uint_as_float(__hip_atomic_load(nk, __ATOMIC_RELAXED, __HIP_MEMORY_SCOPE_AGENT)) + __uint_as_float(__hip_atomic_load(nk + 1, __ATOMIC_RELAXED, __HIP_MEMORY_SCOPE_AGENT));
              const float Bq = 1.02f * pg8::C2F * sqrtf(qn2 * kn2); const int ntile = 4 * qb;
              const bool skip = ln < ntile && (2.0f * Bq + (dpp[64 * ln + 63] - dpp[256 * qb]) < -32.0f);
              const unsigned long long msk = __ballot(skip); int first = (int)__builtin_ctzll(~msk); first = first < ntile ? first : ntile;
              ts = __builtin_amdgcn_readfirstlane(first & ~1); }
            attn_body::attn_unit<8>(b, h, qb, ts, (const attn_body::bf16*)Qb, (const attn_body::bf16*)Kb, (const attn_body::bf16*)Vb, (attn_body::bf16*)AM, (const float*)(ws + WS_DP) + (size_t)p * 4096, (char*)lds + RING_OFF);
            if (tid == 0) uq[0] = pend;
            __syncthreads();
            u = __builtin_amdgcn_readfirstlane(uq[0]);
          }
          __syncthreads(); }
    }
    xcd_barrier(bar);

    { unsigned char* ws = WSP; sg_merge(ws, (LAS float*)(L + RING_OFF), tid, vcu, G); __syncthreads();
      pg8::Gemm g{(bf16*)(ws + WS_AM), (bf16*)(ws + WS_WMT), TOKP, DM, 1536, 1536}; pg8::StaticOrder S; S.init(TOKP, DM, G, bx);
      pg8::EpiMerge E{(const unsigned char*)(ws + WS_G), (bf16*)(ws + WS_MM), (const LAS unsigned char*)(L + RTAB_OFF)};
      pg8::gemm_phase<pg8::EpiMerge, pg8::StaticOrder, true, true>(L + RING_OFF, g, S, E); }
    xcd_barrier(bar);

    { unsigned char* ws = WSP; sg_wout(ws, OUTP, PTRI(1), (LAS float*)(L + RING_OFF), tid, vcu, G); __syncthreads();
      pg8::Gemm g{(bf16*)(ws + WS_MM), (bf16*)(ws + WS_WOT), TOKP, DM, DM, DM}; pg8::StaticOrder S; S.init(TOKP, DM, G, bx);
      pg8::EpiWout E{PTRI(0), PTRI(1), OUTP, (bf16*)(ws + WS_HB), (float*)(ws + WS_CTL) + CW_SSQ1};
      pg8::gemm_phase<pg8::EpiWout, pg8::StaticOrder, true, true>(L + RING_OFF, g, S, E); }
    xcd_barrier(bar);

    { unsigned char* ws = WSP; sg_up(ws, (LAS float*)(L + RING_OFF), tid, vcu, G); __syncthreads();
      pg8::Gemm g{(bf16*)(ws + WS_HB), (bf16*)(ws + WS_WUT), TOKP, FF, DM, DM}; pg8::StaticOrder S; S.init(TOKP, FF, G, bx);
      pg8::EpiUp E{(float*)(ws + WS_CTL) + CW_SSQ1, (bf16*)(ws + WS_A2)};
      pg8::gemm_phase<pg8::EpiUp, pg8::StaticOrder, true, true>(L + RING_OFF, g, S, E); }
    xcd_barrier(bar);

    { unsigned char* ws = WSP; sg_down(ws, OUTP, PTRI(23), (LAS float*)(L + RING_OFF), tid, vcu, G); __syncthreads();
      pg8::Gemm g{(bf16*)(ws + WS_A2), (bf16*)(ws + WS_WDT), TOKP, DM, FF, FFP}; pg8::StaticOrder S; S.init(TOKP, DM, G, bx);
      pg8::EpiDown E{OUTP, (const bf16*)(ws + WS_HB), (float*)(ws + WS_CTL) + CW_SSQ2, (unsigned*)(ws + WS_CTL) + CW_CNT, PTRI(23), (const float*)(ws + WS_CTL) + CW_SSQ1};
      pg8::gemm_phase<pg8::EpiDown, pg8::StaticOrder, true, true>(L + RING_OFF, g, S, E); }
}

extern "C" void kernel_launch(void* const* d_in, const int* in_sizes, int n_in, void* d_out, int out_size, void* d_ws, size_t ws_size, hipStream_t stream) {
    static int grid = 0;
    if (grid == 0) {
        if (n_in != 24 || in_sizes[0] != TOKP * DM || (size_t)out_size != pg8::O_END || ws_size < WS_END) {
            fprintf(stderr, "kernel_launch: built for 24 inputs, x_prompt of %d floats, out of %zu floats, >= %zu bytes of workspace; got n_in %d, in0 %d, out %d, ws %zu; nothing launched\n",
                    TOKP * DM, (size_t)pg8::O_END, (size_t)WS_END, n_in, n_in > 0 ? in_sizes[0] : -1, out_size, ws_size); grid = -1; return; }
        int dev = 0, cus = 0, per_cu = 0;
        if (hipGetDevice(&dev) != hipSuccess || hipDeviceGetAttribute(&cus, hipDeviceAttributeMultiprocessorCount, dev) != hipSuccess) { fprintf(stderr, "kernel_launch: hipGetDevice / hipDeviceGetAttribute failed\n"); grid = -1; return; }
        if (hipFuncSetAttribute((const void*)fwd_megakernel, hipFuncAttributeMaxDynamicSharedMemorySize, LDS_BYTES) != hipSuccess) { fprintf(stderr, "kernel_launch: hipFuncSetAttribute failed\n"); grid = -1; return; }
        if (hipOccupancyMaxActiveBlocksPerMultiprocessor(&per_cu, (const void*)fwd_megakernel, NWAVES * 64, LDS_BYTES) != hipSuccess || per_cu < 1) {
            fprintf(stderr, "kernel_launch: occupancy query reports %d workgroups per CU; nothing launched\n", per_cu); (void)hipGetLastError(); grid = -1; return; }
        grid = cus;
        if (grid % 8 != 0) fprintf(stderr, "kernel_launch: note: %d CUs\n", grid);
    }
    if (grid < 0) return;
    if (hipMemsetAsync((char*)d_ws + WS_CTL, 0, CTL_ZERO_BYTES, stream) != hipSuccess) { fprintf(stderr, "kernel_launch: hipMemsetAsync failed\n"); return; }
    Args a{};
    for (int i = 0; i < 24; ++i) a.in[i] = (const float*)d_in[i];
    a.out = (float*)d_out; a.ws = (unsigned char*)d_ws;
    hipLaunchKernelGGL(fwd_megakernel, dim3(grid), dim3(NWAVES * 64), LDS_BYTES, stream, a);
    const hipError_t le = hipPeekAtLastError();
    if (le != hipSuccess) fprintf(stderr, "kernel_launch: launch failed: %s\n", hipGetErrorName(le));
}
```
